# Optimizing an MI355X kernel written in HIP

```python
import math
import jax, jax.numpy as jnp
from jax import lax
import numpy as np


D_MODEL = 1024
BATCH = 4
SEQ = 8192
DEPTH = 4

MIX_WIDTH = 2 * D_MODEL
CONV_WIDTH = MIX_WIDTH // 2
CONV_K = 3
ATTN_HEAD_DIM = 64
ATTN_HEADS = (MIX_WIDTH - CONV_WIDTH) // ATTN_HEAD_DIM
ATTN_WIDTH = ATTN_HEADS * ATTN_HEAD_DIM
DILATED_PATTERNS = ((128, 1), (512, 4), (2048, 16))
ATTN_BLOCK = 128
REL_BUCKETS = 32
REL_MAX_DISTANCE = 2048
HGRN_HEADS = 16
HGRN_KEY_DIM = 128
HGRN_VAL_DIM = MIX_WIDTH // HGRN_HEADS
HGRN_CHUNK = 64
EPS = 1e-6
N_EVEN = (DEPTH + 1) // 2
N_ODD = DEPTH // 2
EVEN_SPLITS = (CONV_WIDTH, CONV_WIDTH, CONV_WIDTH, ATTN_WIDTH, ATTN_WIDTH, ATTN_WIDTH, MIX_WIDTH)
ODD_SPLITS = (HGRN_HEADS * HGRN_KEY_DIM, HGRN_HEADS * HGRN_KEY_DIM, HGRN_HEADS * HGRN_VAL_DIM, MIX_WIDTH)
EVEN_IN = sum(EVEN_SPLITS)
ODD_IN = sum(ODD_SPLITS)

kernel_name = 'hybrid_conv_dilattn_hgrn2_trunk'


def split_cols(t, sizes):
    idx = np.cumsum(sizes)[:-1].tolist()
    return jnp.split(t, idx, axis=-1)


def rms_norm(x, gain):
    xf = x.astype(jnp.float32)
    return xf * lax.rsqrt(jnp.mean(xf * xf, axis=-1, keepdims=True) + EPS) * gain.astype(jnp.float32)


def t5_bucket(distance):
    max_exact = REL_BUCKETS // 2
    scaled = jnp.log(jnp.maximum(distance, max_exact).astype(jnp.float32) / max_exact) / math.log(REL_MAX_DISTANCE / max_exact)
    large = jnp.minimum(max_exact + (scaled * (REL_BUCKETS - max_exact)).astype(jnp.int32), REL_BUCKETS - 1)
    return jnp.where(distance < max_exact, distance, large)


def dilated_window_attention(q, k, v, rel_bias, window, dilation):
    b, h, s, dh = q.shape
    blk = ATTN_BLOCK
    n_back = window // dilation
    assert n_back <= blk
    l_pad = -(-s // (dilation * blk)) * blk
    s_pad = l_pad * dilation
    nb = l_pad // blk

    def to_blocks(t):
        t = jnp.pad(t, ((0, 0), (0, 0), (0, s_pad - s), (0, 0)))
        t = t.reshape(b, h, l_pad, dilation, dh).transpose(0, 1, 3, 2, 4)
        return t.reshape(b, h, dilation, nb, blk, dh)

    def with_prev(t):
        prev = jnp.pad(t[:, :, :, :-1], ((0, 0), (0, 0), (0, 0), (1, 0), (0, 0), (0, 0)))
        return jnp.concatenate([prev, t], axis=4)

    qb = to_blocks(q)
    kk = with_prev(to_blocks(k))
    vv = with_prev(to_blocks(v))
    qi = jnp.arange(blk)[:, None]
    kj = jnp.arange(2 * blk)[None, :]
    delta = blk + qi - kj
    band = (delta >= 0) & (delta <= n_back)
    bucket = t5_bucket(jnp.maximum(delta, 0) * dilation)
    bias = rel_bias.astype(jnp.float32)[bucket].transpose(2, 0, 1)
    not_before_start = (jnp.arange(nb)[:, None, None] > 0) | (kj[None] >= blk)
    mask = band[None] & not_before_start
    logits = jnp.einsum('bhrnqd,bhrnkd->bhrnqk', qb, kk) + bias[None, :, None, None]
    logits = jnp.where(mask, logits, -jnp.inf)
    m = jnp.max(logits, axis=-1, keepdims=True)
    p = jnp.exp(logits - m)
    den = jnp.sum(p, axis=-1, keepdims=True)
    o = jnp.einsum('bhrnqk,bhrnkd->bhrnqd', p, vv) / den
    lse = (m + jnp.log(den))[..., 0]

    def from_blocks(t, tail):
        t = t.reshape((b, h, dilation, l_pad) + tail)
        t = jnp.moveaxis(t, 2, 3).reshape((b, h, s_pad) + tail)
        return t[:, :, :s]

    return from_blocks(o, (dh,)), from_blocks(lse, ())


def conv_attention_mixer(h, w_in, conv_w, q_gain, k_gain, rel_bias, w_out):
    b, s, _ = h.shape
    gate_b, gate_c, xa, q, k, v, z = split_cols(h @ w_in.astype(h.dtype), EVEN_SPLITS)
    u = gate_c * xa
    conv = lax.conv_general_dilated(u, conv_w[:, None, :].astype(u.dtype), window_strides=(1,),
                                    padding=((CONV_K - 1, 0),), dimension_numbers=('NWC', 'WIO', 'NWC'),
                                    feature_group_count=CONV_WIDTH)
    y_conv = gate_b * conv
    def heads(t, gain):
        return rms_norm(t.reshape(b, s, ATTN_HEADS, ATTN_HEAD_DIM), gain).transpose(0, 2, 1, 3)
    qh = heads(q, q_gain) * (ATTN_HEAD_DIM ** -0.5)
    kh = heads(k, k_gain)
    vh = v.astype(jnp.float32).reshape(b, s, ATTN_HEADS, ATTN_HEAD_DIM).transpose(0, 2, 1, 3)
    outs, lses = [], []
    for window, dilation in DILATED_PATTERNS:
        o_p, lse_p = dilated_window_attention(qh, kh, vh, rel_bias, window, dilation)
        outs.append(o_p)
        lses.append(lse_p)
    weights = jax.nn.softmax(jnp.stack(lses), axis=0)
    o = jnp.sum(weights[..., None] * jnp.stack(outs), axis=0)
    y_attn = o.transpose(0, 2, 1, 3).reshape(b, s, ATTN_WIDTH)
    y = jnp.concatenate([y_conv, y_attn.astype(y_conv.dtype)], axis=-1) * jax.nn.silu(z)
    return y @ w_out.astype(y.dtype)


def hgrn2_chunk_scan(q, k, v, log_f):
    b, h, s, dk = q.shape
    dv = v.shape[-1]
    c = HGRN_CHUNK
    nc = s // c

    def chunks(t):
        return t.reshape(b, h, nc, c, t.shape[-1]).transpose(2, 0, 1, 3, 4)

    causal = jnp.tril(jnp.ones((c, c), dtype=bool))

    def step(state, inp):
        qc, kc, vc, gc = inp
        gcum = jnp.cumsum(gc, axis=2)
        o_inter = jnp.einsum('bhtk,bhkv->bhtv', qc * jnp.exp(gcum), state)
        diff = gcum[:, :, :, None, :] - gcum[:, :, None, :, :]
        decay = jnp.exp(jnp.where(causal[:, :, None], diff, -jnp.inf))
        scores = jnp.einsum('bhtk,bhsk,bhtsk->bhts', qc, kc, decay)
        o_intra = jnp.einsum('bhts,bhsv->bhtv', scores, vc)
        g_last = gcum[:, :, -1:, :]
        new_state = state * jnp.exp(g_last[:, :, 0, :, None]) + jnp.einsum('bhsk,bhsv->bhkv', kc * jnp.exp(g_last - gcum), vc)
        return new_state, o_inter + o_intra

    state0 = jnp.zeros((b, h, dk, dv), jnp.float32)
    _, o = lax.scan(step, state0, (chunks(q), chunks(k), chunks(v), chunks(log_f)))
    return o.transpose(1, 2, 0, 3, 4).reshape(b, h, s, dv)


def hgrn2_mixer(h, w_in, lower_bound, o_gain, w_out):
    b, s, _ = h.shape
    q, f_pre, i, z = split_cols(h @ w_in.astype(h.dtype), ODD_SPLITS)
    f_pre = f_pre.astype(jnp.float32)
    lb = lower_bound
    log_f = jnp.logaddexp(jnp.log(lb), jnp.log1p(-lb) + jax.nn.log_sigmoid(f_pre))
    k = (1.0 - lb) * jax.nn.sigmoid(-f_pre)

    def heads(t, dim):
        return t.astype(jnp.float32).reshape(b, s, HGRN_HEADS, dim).transpose(0, 2, 1, 3)

    o = hgrn2_chunk_scan(heads(jax.nn.silu(q), HGRN_KEY_DIM), heads(k, HGRN_KEY_DIM),
                         heads(i, HGRN_VAL_DIM), heads(log_f, HGRN_KEY_DIM))
    o = rms_norm(o.transpose(0, 2, 1, 3), o_gain.reshape(HGRN_HEADS, HGRN_VAL_DIM)).reshape(b, s, MIX_WIDTH)
    y = o * jax.nn.silu(z)
    return y @ w_out.astype(y.dtype)


def setup_inputs(seed: int = 0) -> dict:
    key = jax.random.key(seed)
    ks = jax.random.split(key, 13)
    f32 = jnp.float32
    nrm = jax.random.normal
    return {
        'x': nrm(ks[0], (BATCH, SEQ, D_MODEL), f32),
        'ln_even': 1.0 + 0.1 * nrm(ks[1], (N_EVEN, D_MODEL), f32),
        'w_in_even': nrm(ks[2], (N_EVEN, D_MODEL, EVEN_IN), f32) * D_MODEL ** -0.5,
        'conv_w': nrm(ks[3], (N_EVEN, CONV_K, CONV_WIDTH), f32) * CONV_K ** -0.5,
        'q_gain': 1.0 + 0.1 * nrm(ks[4], (N_EVEN, ATTN_HEAD_DIM), f32),
        'k_gain': 1.0 + 0.1 * nrm(ks[5], (N_EVEN, ATTN_HEAD_DIM), f32),
        'w_out_even': nrm(ks[6], (N_EVEN, MIX_WIDTH, D_MODEL), f32) * MIX_WIDTH ** -0.5,
        'rel_bias': 0.5 * nrm(ks[7], (REL_BUCKETS, ATTN_HEADS), f32),
        'ln_odd': 1.0 + 0.1 * nrm(ks[8], (N_ODD, D_MODEL), f32),
        'w_in_odd': nrm(ks[9], (N_ODD, D_MODEL, ODD_IN), f32) * D_MODEL ** -0.5,
        'lower_bounds': 0.5 * nrm(ks[10], (N_ODD, HGRN_HEADS * HGRN_KEY_DIM), f32),
        'o_gain': 1.0 + 0.1 * nrm(ks[11], (N_ODD, MIX_WIDTH), f32),
        'w_out_odd': nrm(ks[12], (N_ODD, MIX_WIDTH, D_MODEL), f32) * MIX_WIDTH ** -0.5,
    }


def reference(x, ln_even, w_in_even, conv_w, q_gain, k_gain, w_out_even, rel_bias,
              ln_odd, w_in_odd, lower_bounds, o_gain, w_out_odd):
    lbs = jnp.cumsum(jax.nn.softmax(lower_bounds.astype(jnp.float32), axis=0), axis=0)
    lbs = lbs - lbs[0:1]
    for layer in range(DEPTH):
        j = layer // 2
        if layer % 2 == 0:
            hn = rms_norm(x, ln_even[j])
            delta = conv_attention_mixer(hn, w_in_even[j], conv_w[j], q_gain[j], k_gain[j], rel_bias, w_out_even[j])
        else:
            hn = rms_norm(x, ln_odd[j])
            delta = hgrn2_mixer(hn, w_in_odd[j], lbs[j], o_gain[j], w_out_odd[j])
        x = x + delta.astype(x.dtype)
    return x
```

```cpp
#include <hip/hip_runtime.h>
#include <hip/hip_cooperative_groups.h>
#include <cstdio>
#include <cstdint>
namespace cg = cooperative_groups;
namespace pg8 {
#define PG8_LAS __attribute__((address_space(3)))
typedef unsigned short bf16_t;
typedef short bf16x8 __attribute__((ext_vector_type(8)));
typedef float f32x4 __attribute__((ext_vector_type(4)));
typedef unsigned u32x4 __attribute__((ext_vector_type(4)));
constexpr int BM = 256, BK = 64, HALF = 128, HTB = HALF * BK * 2  , STAGE_BYTES = 8 * HTB, NXCD = 8, WGM = 8;

__host__ __device__ __forceinline__ int lds_byte(int r, int c) { const int st = (r >> 4) * 2 + (c >> 5), rr = r & 15, cc = c & 31, ob = rr * 64 + cc * 2; return st * 1024 + (ob ^ (((ob >> 9) & 1) << 5)); }
__host__ __device__ __forceinline__ void stage_rc(int b, int& R, int& C) { const int st = b / 1024, sb = b % 1024, swz = sb ^ (((sb >> 9) & 1) << 5); R = (st >> 1) * 16 + swz / 64; C = (st & 1) * 32 + (swz % 64) / 2; }
__host__ __device__ __forceinline__ int perm32(int rho) { const int n = rho >> 4, i = rho & 15; return 8 * (i >> 2) + 4 * n + (i & 3); }

struct Unit { int pm, pn; };
struct Gemm { const bf16_t* A; const bf16_t* Bt; int M, N, K; };

struct StaticOrder {
    int nM, nN, nwg, G, c;
    __host__ __device__ void init(int M, int N, int G_, int c_) { nM = M / BM; nN = N / BM; nwg = nM * nN; G = G_; c = c_; }
    __host__ __device__ bool next(int i, Unit& u) const {
        const long L = (long)i * G + c; if (L >= nwg) return false;
        int wgid = (int)L; { const int q = nwg / NXCD, r = nwg % NXCD, xcd = wgid % NXCD, off = wgid / NXCD; wgid = (xcd < r ? xcd * (q + 1) : r * (q + 1) + (xcd - r) * q) + off; }
        const int nig = WGM * nN, gid = wgid / nig, fm = gid * WGM, gsz = (nM - fm) < WGM ? (nM - fm) : WGM;
        u.pm = fm + ((wgid % nig) % gsz); u.pn = (wgid % nig) / gsz; return true;
    }
    __device__ __forceinline__ void a_ready(const Unit&) const {}
    __device__ __forceinline__ void done(const Unit&) const {}
};

__device__ __forceinline__ unsigned cvt_pk_bf16(float lo, float hi) { unsigned r; asm volatile("v_cvt_pk_bf16_f32 %0, %1, %2" : "=v"(r) : "v"(lo), "v"(hi)); return r; }
template <class Epi, class Sched, bool ALIGN_EPI = false, bool SP2 = false>
__device__ __forceinline__ void gemm_phase(PG8_LAS unsigned char* lds, const Gemm g, const Sched& S, const Epi& E) {
    int tid_raw = threadIdx.x; asm volatile("" : "+v"(tid_raw)); const int tid = tid_raw, wid = __builtin_amdgcn_readfirstlane(tid >> 6), lane = tid & 63, wr = wid >> 2, wc = wid & 3, fr = lane & 15, fq = lane >> 4;
    const int K = g.K, nt = K / BK;
    unsigned voffA[2], voffB[2];
#pragma unroll
    for (int i = 0; i < 2; ++i) { int R, C; stage_rc(tid * 16 + i * 8192, R, C); const int Rb = Epi::PERM ? ((R & ~31) + perm32(R & 31)) : R;
        voffA[i] = (unsigned)(R * K + C) * 2u; voffB[i] = (unsigned)(Rb * K + C) * 2u; }
    const size_t kstep = (size_t)(BK * 2);
    const size_t hstep = (size_t)HALF * K * 2;
    const size_t tstep = 2 * hstep;
    const unsigned ldsw = (unsigned)wid * 1024u;
    const int aoff = lds_byte(wr * 64 + fr, fq * 8), boff = lds_byte(wc * 32 + fr, fq * 8);
#define PG8_SA(b, h) (((b) * 2 + (h)) * HTB)
#define PG8_SB(b, h) ((4 + (b) * 2 + (h)) * HTB)
#define PG8_STAGE(bufoff, gbase, voff) do { _Pragma("unroll") for (int _i = 0; _i < 2; ++_i) \
        __builtin_amdgcn_global_load_lds((const unsigned*)((const char*)(gbase) + (voff)[_i]), (PG8_LAS unsigned*)(lds + (bufoff) + ldsw + _i * 8192), 16, 0, 0); } while (0)
#define PG8_LDA(dst, b, h) do { _Pragma("unroll") for (int m = 0; m < 4; ++m) _Pragma("unroll") for (int k = 0; k < 2; ++k) dst[m][k] = *(const PG8_LAS bf16x8*)(lds + PG8_SA(b, h) + aoff + m * 2048 + k * 1024); } while (0)
#define PG8_LDB(dst, b, h) do { _Pragma("unroll") for (int n = 0; n < 2; ++n) _Pragma("unroll") for (int k = 0; k < 2; ++k) dst[n][k] = *(const PG8_LAS bf16x8*)(lds + PG8_SB(b, h) + boff + n * 2048 + k * 1024); } while (0)
#define PG8_MMA(ai, bj, At, Bt) do { __builtin_amdgcn_s_setprio(1); _Pragma("unroll") for (int m = 0; m < 4; ++m) _Pragma("unroll") for (int n = 0; n < 2; ++n) _Pragma("unroll") for (int k = 0; k < 2; ++k) \
        acc[ai][bj][m][n] = __builtin_amdgcn_mfma_f32_16x16x32_bf16(Bt[n][k], At[m][k], acc[ai][bj][m][n], 0, 0, 0); __builtin_amdgcn_s_setprio(0); } while (0)
#define PG8_WAIT_V(n) asm volatile("s_waitcnt vmcnt(" #n ")" ::: "memory")
#define PG8_WAIT_L(n) asm volatile("s_waitcnt lgkmcnt(" #n ")" ::: "memory")
#define PG8_BAR __builtin_amdgcn_s_barrier()
#define PG8_SCHED __builtin_amdgcn_sched_barrier(0)
    Unit cur, nxt; int ui = 0;
    if (!S.next(0, cur)) return;
    f32x4 acc[2][2][4][2];
#pragma unroll
    for (int a = 0; a < 2; ++a)
#pragma unroll
        for (int b = 0; b < 2; ++b)
#pragma unroll
            for (int m = 0; m < 4; ++m)
#pragma unroll
                for (int n = 0; n < 2; ++n) acc[a][b][m][n] = (f32x4){0.f, 0.f, 0.f, 0.f};
    bf16x8 At[4][2], B0[2][2], B1[2][2];
    const char* cA = (const char*)g.A + (size_t)cur.pm * tstep; const char* cB = (const char*)g.Bt + (size_t)cur.pn * tstep;
    S.a_ready(cur);
    if constexpr (SP2) {
        PG8_STAGE(PG8_SB(0, 0), cB, voffB); PG8_STAGE(PG8_SB(0, 1), cB + hstep, voffB); PG8_STAGE(PG8_SA(0, 0), cA, voffA); PG8_STAGE(PG8_SA(0, 1), cA + hstep, voffA);
        if (wr == 1) PG8_BAR;
        PG8_WAIT_V(2); PG8_BAR;
        PG8_STAGE(PG8_SB(1, 0), cB + kstep, voffB); PG8_STAGE(PG8_SA(1, 0), cA + kstep, voffA); PG8_STAGE(PG8_SB(1, 1), cB + hstep + kstep, voffB);
        PG8_WAIT_V(6); PG8_BAR;
    } else {
        PG8_STAGE(PG8_SB(0, 0), cB, voffB); PG8_STAGE(PG8_SA(0, 0), cA, voffA); PG8_STAGE(PG8_SB(0, 1), cB + hstep, voffB); PG8_STAGE(PG8_SA(0, 1), cA + hstep, voffA);
        if (wr == 1) PG8_BAR;
        PG8_WAIT_V(4); PG8_BAR;
        PG8_STAGE(PG8_SB(1, 0), cB + kstep, voffB); PG8_STAGE(PG8_SA(1, 0), cA + kstep, voffA); PG8_STAGE(PG8_SB(1, 1), cB + hstep + kstep, voffB);
        PG8_WAIT_V(6); PG8_BAR;
    }
    for (;;) {
        const bool has_next = S.next(ui + 1, nxt);
        const char* nA = has_next ? (const char*)g.A + (size_t)nxt.pm * tstep : cA; const char* nB = has_next ? (const char*)g.Bt + (size_t)nxt.pn * tstep : cB;
        for (int t = 0; t < nt; t += 2) {
            const bool last = (t == nt - 2);
            const char* a1 = cA + (size_t)(t + 1) * kstep;
            const char* a2 = last ? nA : cA + (size_t)(t + 2) * kstep; const char* b2 = last ? nB : cB + (size_t)(t + 2) * kstep;
            const char* a3 = a2 + kstep; const char* b3 = b2 + kstep;
            if (last && has_next) S.a_ready(nxt);
            if constexpr (SP2) {
            PG8_LDB(B0, 0, 0); PG8_LDB(B1, 0, 1); PG8_SCHED; PG8_LDA(At, 0, 0); PG8_STAGE(PG8_SA(1, 1), a1 + hstep, voffA);
            PG8_WAIT_V(8); PG8_WAIT_L(0); PG8_BAR; PG8_MMA(0, 0, At, B0); PG8_MMA(0, 1, At, B1); PG8_BAR; PG8_SCHED;
            PG8_LDA(At, 0, 1); PG8_STAGE(PG8_SB(0, 0), b2, voffB); PG8_STAGE(PG8_SB(0, 1), b2 + hstep, voffB); PG8_STAGE(PG8_SA(0, 0), a2, voffA);
            PG8_WAIT_V(8); PG8_WAIT_L(0); PG8_BAR; PG8_MMA(1, 0, At, B0); PG8_MMA(1, 1, At, B1); PG8_BAR; PG8_SCHED;
            PG8_LDB(B0, 1, 0); PG8_LDB(B1, 1, 1); PG8_SCHED; PG8_LDA(At, 1, 0); PG8_STAGE(PG8_SA(0, 1), a2 + hstep, voffA);
            PG8_WAIT_V(8); PG8_WAIT_L(0); PG8_BAR; PG8_MMA(0, 0, At, B0); PG8_MMA(0, 1, At, B1); PG8_BAR; PG8_SCHED;
            PG8_LDA(At, 1, 1); PG8_STAGE(PG8_SB(1, 0), b3, voffB); PG8_STAGE(PG8_SB(1, 1), b3 + hstep, voffB); PG8_STAGE(PG8_SA(1, 0), a3, voffA);
            PG8_WAIT_V(8); PG8_WAIT_L(0); PG8_BAR; PG8_MMA(1, 0, At, B0); PG8_MMA(1, 1, At, B1); PG8_BAR; PG8_SCHED;
            } else {
            PG8_LDB(B0, 0, 0); PG8_SCHED; PG8_LDA(At, 0, 0); PG8_STAGE(PG8_SA(1, 1), a1 + hstep, voffA);
            PG8_WAIT_L(8); PG8_BAR; PG8_WAIT_L(0); PG8_MMA(0, 0, At, B0); PG8_BAR; PG8_SCHED;
            PG8_LDB(B1, 0, 1); PG8_STAGE(PG8_SB(0, 0), b2, voffB);
            PG8_BAR; PG8_WAIT_L(0); PG8_MMA(0, 1, At, B1); PG8_BAR;
            PG8_LDA(At, 0, 1); PG8_STAGE(PG8_SA(0, 0), a2, voffA);
            PG8_BAR; PG8_WAIT_L(0); PG8_MMA(1, 0, At, B0); PG8_BAR; PG8_SCHED;
            PG8_STAGE(PG8_SB(0, 1), b2 + hstep, voffB);
            PG8_WAIT_V(6); PG8_BAR; PG8_MMA(1, 1, At, B1); PG8_BAR;
            PG8_LDB(B0, 1, 0); PG8_SCHED; PG8_LDA(At, 1, 0); PG8_STAGE(PG8_SA(0, 1), a2 + hstep, voffA);
            PG8_WAIT_L(8); PG8_BAR; PG8_WAIT_L(0); PG8_MMA(0, 0, At, B0); PG8_BAR; PG8_SCHED;
            PG8_LDB(B1, 1, 1); PG8_STAGE(PG8_SB(1, 0), b3, voffB);
            PG8_BAR; PG8_WAIT_L(0); PG8_MMA(0, 1, At, B1); PG8_BAR;
            PG8_LDA(At, 1, 1); PG8_STAGE(PG8_SA(1, 0), a3, voffA);
            PG8_BAR; PG8_WAIT_L(0); PG8_MMA(1, 0, At, B0); PG8_BAR; PG8_SCHED;
            PG8_STAGE(PG8_SB(1, 1), b3 + hstep, voffB);
            PG8_WAIT_V(6); PG8_BAR; PG8_MMA(1, 1, At, B1); PG8_BAR;
            }
        }
        if constexpr (ALIGN_EPI) { if (wr == 0) PG8_BAR; }
        if constexpr (!Epi::AFTER_DRAIN) { E(acc, cur, wr, wc, fr, fq); S.done(cur); }
        if (!has_next) break;
#pragma unroll
        for (int a = 0; a < 2; ++a)
#pragma unroll
            for (int b = 0; b < 2; ++b)
#pragma unroll
                for (int m = 0; m < 4; ++m)
#pragma unroll
                    for (int n = 0; n < 2; ++n) acc[a][b][m][n] = (f32x4){0.f, 0.f, 0.f, 0.f};
        cur = nxt; cA = nA; cB = nB; ++ui;
        if constexpr (ALIGN_EPI) { if (wr == 1) PG8_BAR; }
    }
    PG8_WAIT_V(0);
    if constexpr (!ALIGN_EPI) { if (wr == 0) PG8_BAR; }
    PG8_BAR;
    if constexpr (Epi::AFTER_DRAIN) { E.fused(acc, cur, wr, wc, fr, fq, lds, wid, lane); S.done(cur); }
#undef PG8_SA
#undef PG8_SB
#undef PG8_STAGE
#undef PG8_LDA
#undef PG8_LDB
#undef PG8_MMA
#undef PG8_WAIT_V
#undef PG8_WAIT_L
#undef PG8_BAR
#undef PG8_SCHED
}
}

constexpr int D = 1024, SEQ = 8192, NBATCH = 4, NTOK = NBATCH * SEQ, PW = 8192, MW = 2048;
constexpr float EPS = 1e-6f;
constexpr size_t MiB = 1u << 20;
constexpr size_t WS_WIN = 0, WS_WOUT = 16 * MiB, WS_MISC = 20 * MiB, WS_PROJ = 24 * MiB;
constexpr int LDS_BYTES = 147456;
typedef unsigned short bf16;
typedef unsigned v4u __attribute__((ext_vector_type(4)));
typedef float f32x4 __attribute__((ext_vector_type(4)));
#define LAS __attribute__((address_space(3)))

__device__ __forceinline__ float bf2f(unsigned short b) { return __uint_as_float(((unsigned)b) << 16); }
__device__ __forceinline__ unsigned f2bf(float f) { unsigned u = __float_as_uint(f); return (u + 0x7fffu + ((u >> 16) & 1u)) >> 16; }
__device__ __forceinline__ unsigned pk2(float lo, float hi) { return f2bf(lo) | (f2bf(hi) << 16); }
__device__ __forceinline__ float wave_sum(float v) {
#pragma unroll
    for (int o = 1; o < 64; o <<= 1) v += __shfl_xor(v, o);
    return v;
}
__device__ __forceinline__ float wave_max(float v) {
#pragma unroll
    for (int o = 1; o < 64; o <<= 1) v = fmaxf(v, __shfl_xor(v, o));
    return v;
}
__device__ __forceinline__ float silu_f(float x) { return x / (1.f + __expf(-x)); }
__device__ __forceinline__ void unpack8(const v4u w, float (&f)[8]) {
    f[0] = __uint_as_float(w.x << 16); f[1] = __uint_as_float(w.x & 0xffff0000u);
    f[2] = __uint_as_float(w.y << 16); f[3] = __uint_as_float(w.y & 0xffff0000u);
    f[4] = __uint_as_float(w.z << 16); f[5] = __uint_as_float(w.z & 0xffff0000u);
    f[6] = __uint_as_float(w.w << 16); f[7] = __uint_as_float(w.w & 0xffff0000u);
}

struct EpiProj {
    static constexpr bool PERM = true, AFTER_DRAIN = false;
    pg8::bf16_t* O; int odd; const float* lb;
    __device__ __forceinline__ void operator()(const pg8::f32x4 (&acc)[2][2][4][2], const pg8::Unit& u, int wr, int wc, int fr, int fq) const {
        const int row0 = u.pm * 256 + wr * 64 + fr, col0 = u.pn * 256 + wc * 32 + 8 * fq;
        int act;
        if (!odd) act = (u.pn >= 24) ? 1 : 0; else act = (u.pn < 8) ? 1 : (u.pn < 16 ? 2 : (u.pn < 24 ? 0 : 1));
        pg8::f32x4 lbv[2][2];
#pragma unroll
        for (int bj = 0; bj < 2; ++bj)
#pragma unroll
            for (int n = 0; n < 2; ++n) lbv[bj][n] = (act == 2) ? *(const pg8::f32x4*)(lb + (col0 - 2048) + bj * 128 + 4 * n) : (pg8::f32x4){0.f, 0.f, 0.f, 0.f};
#pragma unroll
        for (int ai = 0; ai < 2; ++ai)
#pragma unroll
            for (int m = 0; m < 4; ++m) { pg8::bf16_t* rowp = O + (size_t)(row0 + ai * 128 + m * 16) * PW + col0;
#pragma unroll
                for (int bj = 0; bj < 2; ++bj) { pg8::f32x4 v0 = acc[ai][bj][m][0], v1 = acc[ai][bj][m][1];
                    if (act == 1) {
#pragma unroll
                        for (int e = 0; e < 4; ++e) { v0[e] = silu_f(v0[e]); v1[e] = silu_f(v1[e]); } }
                    else if (act == 2) {
#pragma unroll
                        for (int e = 0; e < 4; ++e) { const float s0 = 1.f / (1.f + __expf(-v0[e])), s1 = 1.f / (1.f + __expf(-v1[e]));
                            v0[e] = __logf(lbv[bj][0][e] + (1.f - lbv[bj][0][e]) * s0); v1[e] = __logf(lbv[bj][1][e] + (1.f - lbv[bj][1][e]) * s1); } }
                    pg8::u32x4 w; w.x = pg8::cvt_pk_bf16(v0[0], v0[1]); w.y = pg8::cvt_pk_bf16(v0[2], v0[3]); w.z = pg8::cvt_pk_bf16(v1[0], v1[1]); w.w = pg8::cvt_pk_bf16(v1[2], v1[3]);
                    *(pg8::u32x4*)(rowp + bj * 128) = w; } }
    }
};
struct EpiRes {
    static constexpr bool PERM = false, AFTER_DRAIN = false;
    const float* base; float* out;
    __device__ __forceinline__ void operator()(const pg8::f32x4 (&acc)[2][2][4][2], const pg8::Unit& u, int wr, int wc, int fr, int fq) const {
        const int row0 = u.pm * 256 + wr * 64 + fr, col0 = u.pn * 256 + wc * 32 + 4 * fq;
#pragma unroll
        for (int ai = 0; ai < 2; ++ai)
#pragma unroll
            for (int m = 0; m < 4; ++m) { const size_t off = (size_t)(row0 + ai * 128 + m * 16) * D + col0;
#pragma unroll
                for (int bj = 0; bj < 2; ++bj)
#pragma unroll
                    for (int n = 0; n < 2; ++n) { const pg8::f32x4 b = *(const pg8::f32x4*)(base + off + bj * 128 + n * 16);
                        *(pg8::f32x4*)(out + off + bj * 128 + n * 16) = b + acc[ai][bj][m][n]; } }
    }
};

__device__ __forceinline__ void transpose_item(const float* W, int K, int N, const float* gain, bf16* WT, LAS float* scr, int item, int lane) {
    const int nblk = N / 32, kb = item / nblk, nb = item % nblk, k0 = 64 * kb, n0 = 32 * nb;
#pragma unroll 8
    for (int i = 0; i < 32; ++i) { const int kk = 2 * i + (lane >> 5); float w = W[(size_t)(k0 + kk) * N + n0 + (lane & 31)]; if (gain) w *= gain[k0 + kk]; scr[kk * 33 + (lane & 31)] = w; }
    asm volatile("s_waitcnt lgkmcnt(0)" ::: "memory");
    const int c = lane & 7;
#pragma unroll
    for (int j = 0; j < 4; ++j) { const int n = (lane >> 3) + 8 * j; const LAS float* s = scr + (8 * c) * 33 + n;
        v4u o; o.x = pk2(s[0 * 33], s[1 * 33]); o.y = pk2(s[2 * 33], s[3 * 33]); o.z = pk2(s[4 * 33], s[5 * 33]); o.w = pk2(s[6 * 33], s[7 * 33]);
        *(v4u*)(WT + (size_t)(n0 + n) * K + k0 + 8 * c) = o; }
    asm volatile("s_waitcnt lgkmcnt(0)" ::: "memory");
}
__device__ __forceinline__ void norm_rows(const float* x, bf16* xn, int nrows, int gw, int ngw, int lane) {
    for (int m = gw; m < nrows; m += ngw) {
        const f32x4* xr = (const f32x4*)(x + (size_t)m * D) + lane;
        f32x4 v[4]; float s = 0.f;
#pragma unroll
        for (int j = 0; j < 4; ++j) { v[j] = xr[64 * j]; s += (v[j].x * v[j].x + v[j].y * v[j].y) + (v[j].z * v[j].z + v[j].w * v[j].w); }
        const float rstd = rsqrtf(wave_sum(s) * (1.f / D) + EPS);
        unsigned long long* o8 = (unsigned long long*)(xn + (size_t)m * D) + lane;
#pragma unroll
        for (int j = 0; j < 4; ++j) o8[64 * j] = (unsigned long long)pk2(v[j].x * rstd, v[j].y * rstd) | ((unsigned long long)pk2(v[j].z * rstd, v[j].w * rstd) << 32);
    }
}

__device__ __forceinline__ void attn_scalar(const bf16* proj, bf16* y, int TOKG, const float* qgain, const float* kgain, const float* rel_bias,
                                            unsigned char* lds, int tid, int lane, int wave, int gw, int ngw) {
    int* btab = (int*)lds;
    float* wq = (float*)(lds + 2048 + wave * 2304);
    float* wp = wq + 64;
    for (int e = tid; e < 448; e += 512) {
        int bk = -1;
        if (e < 387) { const int p = e / 129, jj = e - 129 * p, dist = jj << (2 * p);
            if (dist < 16) bk = dist; else { const float sc = logf((float)dist / 16.f) / logf(128.f); int lg = 16 + (int)(sc * 16.f); bk = lg < 31 ? lg : 31; } }
        btab[e] = bk;
    }
    __syncthreads();
    const float qgl = qgain[lane] * 0.125f, kgl = kgain[lane];
    const int nitems = TOKG * 16;
    for (int it = gw; it < nitems; it += ngw) {
        const int t = it & (SEQ - 1), bh = it >> 13, h = bh & 15, bl = bh >> 4;
        const size_t rowb = (size_t)bl * SEQ;
        const bf16* prow = proj + (rowb + t) * PW;
        const float q = bf2f(prow[3072 + h * 64 + lane]);
        const float ss = wave_sum(q * q);
        wq[lane] = q * rsqrtf(ss * (1.f / 64.f) + EPS) * qgl * kgl;
        asm volatile("s_waitcnt lgkmcnt(0)" ::: "memory");
        float lg[7]; float mx = -INFINITY;
#pragma unroll
        for (int r = 0; r < 7; ++r) {
            const int e = lane + 64 * r; const int bk = btab[e];
            const int p = e / 129, jj = e - 129 * p; const int tk = t - (jj << (2 * p));
            float l = -INFINITY;
            if (bk >= 0 && tk >= 0) {
                const v4u* kr = (const v4u*)(proj + (rowb + tk) * PW + 4096 + h * 64);
                float dot = 0.f, ks = 0.f;
#pragma unroll
                for (int c8 = 0; c8 < 8; ++c8) { float f[8]; unpack8(kr[c8], f);
#pragma unroll
                    for (int i = 0; i < 8; ++i) { dot += wq[c8 * 8 + i] * f[i]; ks += f[i] * f[i]; } }
                l = dot * rsqrtf(ks * (1.f / 64.f) + EPS) + rel_bias[bk * 16 + h];
            }
            lg[r] = l; mx = fmaxf(mx, l);
        }
        mx = wave_max(mx);
        float sum = 0.f;
#pragma unroll
        for (int r = 0; r < 7; ++r) { const float pe = (lg[r] == -INFINITY) ? 0.f : __expf(lg[r] - mx); wp[lane + 64 * r] = pe; sum += pe; }
        sum = wave_sum(sum);
        asm volatile("s_waitcnt lgkmcnt(0)" ::: "memory");
        float o = 0.f;
        const bf16* vbase = proj + rowb * PW + 5120 + h * 64 + lane;
#pragma unroll
        for (int p = 0; p < 3; ++p) {
#pragma unroll 8
            for (int jj = 0; jj <= 128; ++jj) { int tk = t - (jj << (2 * p)); const float pe = wp[p * 129 + jj]; if (tk < 0) tk = t;
                o += pe * bf2f(vbase[(size_t)tk * PW]); }
        }
        const float z = bf2f(prow[6144 + 1024 + h * 64 + lane]);
        y[(rowb + t) * MW + 1024 + h * 64 + lane] = (bf16)f2bf(o / sum * z);
    }
}
__device__ __forceinline__ void conv_scalar(const bf16* proj, bf16* y, int TOKG, const float* convw, int lane, int gw, int ngw) {
    for (int it = gw; it < TOKG; it += ngw) {
        const int t = it & (SEQ - 1); const bf16* prow = proj + (size_t)it * PW;
#pragma unroll
        for (int i = 0; i < 2; ++i) { const int c0 = lane * 8 + 512 * i;
            float acc[8] = {0.f, 0.f, 0.f, 0.f, 0.f, 0.f, 0.f, 0.f};
#pragma unroll
            for (int dt = 0; dt < 3; ++dt) { const int tt = t - 2 + dt;
                if (tt >= 0) { const bf16* pr = prow - (size_t)(2 - dt) * PW; float gc[8], xa[8];
                    unpack8(*(const v4u*)(pr + 1024 + c0), gc); unpack8(*(const v4u*)(pr + 2048 + c0), xa);
#pragma unroll
                    for (int e = 0; e < 8; ++e) acc[e] += convw[dt * 1024 + c0 + e] * (gc[e] * xa[e]); } }
            float gb[8], z[8]; unpack8(*(const v4u*)(prow + c0), gb); unpack8(*(const v4u*)(prow + 6144 + c0), z);
            v4u o; o.x = pk2(gb[0] * acc[0] * z[0], gb[1] * acc[1] * z[1]); o.y = pk2(gb[2] * acc[2] * z[2], gb[3] * acc[3] * z[3]);
            o.z = pk2(gb[4] * acc[4] * z[4], gb[5] * acc[5] * z[5]); o.w = pk2(gb[6] * acc[6] * z[6], gb[7] * acc[7] * z[7]);
            *(v4u*)(y + (size_t)it * MW + c0) = o; }
    }
}

__device__ __forceinline__ void hgrn_scalar(const bf16* proj, bf16* y, int TOKG, const float* ogain, unsigned char* lds, int tid, int lane, int wave, int bid, int G) {
    float* sq = (float*)lds; float* sf = sq + 4096; float* sk = sf + 4096; float* sv = sk + 4096; float* sop = sv + 4096;
    const int nseq = (TOKG / SEQ) * 16;
    const int v = tid & 127, kq = tid >> 7;
    for (int s = bid; s < nseq; s += G) {
        const int bl = s >> 4, h = s & 15; const size_t rowb = (size_t)bl * SEQ;
        float S[32];
#pragma unroll
        for (int i = 0; i < 32; ++i) S[i] = 0.f;
        const float og0 = ogain[h * 128 + lane], og1 = ogain[h * 128 + 64 + lane];
        for (int t0 = 0; t0 < SEQ; t0 += 32) {
#pragma unroll
            for (int i = 0; i < 8; ++i) { const int idx = tid + 512 * i, tt = idx >> 7, col = idx & 127; const bf16* prow = proj + (rowb + t0 + tt) * PW + h * 128 + col;
                sq[idx] = bf2f(prow[0]); const float f = __expf(bf2f(prow[2048])); sf[idx] = f; sk[idx] = 1.f - f; sv[idx] = bf2f(prow[4096]); }
            __syncthreads();
            for (int tt = 0; tt < 32; ++tt) {
                const float vv = sv[tt * 128 + v]; float acc = 0.f;
                const f32x4* pf = (const f32x4*)(sf + tt * 128 + kq * 32); const f32x4* pk = (const f32x4*)(sk + tt * 128 + kq * 32); const f32x4* pq = (const f32x4*)(sq + tt * 128 + kq * 32);
#pragma unroll
                for (int i4 = 0; i4 < 8; ++i4) { const f32x4 f = pf[i4], k = pk[i4], q = pq[i4];
#pragma unroll
                    for (int e = 0; e < 4; ++e) { S[i4 * 4 + e] = f[e] * S[i4 * 4 + e] + k[e] * vv; acc += q[e] * S[i4 * 4 + e]; } }
                sop[(kq * 32 + tt) * 128 + v] = acc;
            }
            __syncthreads();
#pragma unroll
            for (int i2 = 0; i2 < 4; ++i2) { const int tt = wave + 8 * i2;
                float o0 = 0.f, o1 = 0.f;
#pragma unroll
                for (int k4 = 0; k4 < 4; ++k4) { o0 += sop[(k4 * 32 + tt) * 128 + lane]; o1 += sop[(k4 * 32 + tt) * 128 + 64 + lane]; }
                const float rstd = rsqrtf(wave_sum(o0 * o0 + o1 * o1) * (1.f / 128.f) + EPS);
                const bf16* prow = proj + (rowb + t0 + tt) * PW + 6144 + h * 128;
                bf16* yr = y + (rowb + t0 + tt) * MW + h * 128;
                yr[lane] = (bf16)f2bf(o0 * rstd * og0 * bf2f(prow[lane])); yr[64 + lane] = (bf16)f2bf(o1 * rstd * og1 * bf2f(prow[64 + lane])); }
            __syncthreads();
        }
    }
}

__device__ __forceinline__ unsigned long long ldptr(LAS unsigned long long* tab, int i) { asm volatile("" ::: "memory"); const unsigned long long v = tab[i];
    const unsigned lo = __builtin_amdgcn_readfirstlane((unsigned)v), hi = __builtin_amdgcn_readfirstlane((unsigned)(v >> 32)); return ((unsigned long long)hi << 32) | lo; }
struct Args { const float* in[13]; float* out; unsigned char* ws; int ngroups; int step; };
__global__ void __launch_bounds__(512, 2) fwd(Args a) {
    extern __shared__ __attribute__((aligned(16))) unsigned char lds[];
    cg::grid_group grid = cg::this_grid();
    LAS unsigned long long* ptab = (LAS unsigned long long*)((LAS unsigned char*)lds + 131072 + 1024);
    if (threadIdx.x == 0) {
#pragma unroll
        for (int i = 0; i < 13; ++i) ptab[i] = (unsigned long long)a.in[i];
        ptab[13] = (unsigned long long)a.out; ptab[14] = (unsigned long long)a.ws; ptab[15] = (unsigned long long)a.ngroups; }
    __syncthreads();
#define ARGP(i) ((const float*)ldptr(ptab, (i)))
    const int NG = (int)ldptr(ptab, 15);
    const int step_ = __builtin_amdgcn_readfirstlane(a.step);
    { const int layer = step_ / NG;
    int tid_raw = threadIdx.x; asm volatile("" : "+v"(tid_raw));
    const int tid = tid_raw, lane = tid & 63, wave = __builtin_amdgcn_readfirstlane(tid >> 6);
    const int G = gridDim.x, bid = blockIdx.x, gw = bid * 8 + wave, ngw = G * 8;
    const int TOKG = NTOK / NG;
    unsigned char* wsb = (unsigned char*)ldptr(ptab, 14);
    bf16* Wt_in = (bf16*)(wsb + WS_WIN); bf16* Wt_out = (bf16*)(wsb + WS_WOUT);
    float* lbtab = (float*)(wsb + WS_MISC);
    bf16* proj = (bf16*)(wsb + WS_PROJ);
    bf16* ybuf = (bf16*)(wsb + WS_PROJ + (size_t)TOKG * (PW * 2));
    bf16* xn = (bf16*)(wsb + WS_PROJ + (size_t)TOKG * (PW * 2 + MW * 2));
        const int j = layer >> 1; const bool even = !(layer & 1);
        const float* w_in = (even ? ARGP(2) : ARGP(9)) + (size_t)j * D * PW;
        const float* ln = (even ? ARGP(1) : ARGP(8)) + (size_t)j * D;
        const float* w_out = (even ? ARGP(6) : ARGP(12)) + (size_t)j * MW * D;
        if (step_ == layer * NG) {
            LAS float* scr = (LAS float*)((LAS unsigned char*)lds + wave * 16384);
            constexpr int I_IN = (D / 64) * (PW / 32), I_OUT = (MW / 64) * (D / 32);
            for (int it = gw; it < I_IN + I_OUT; it += ngw) {
                if (it < I_IN) transpose_item(w_in, D, PW, ln, Wt_in, scr, it, lane);
                else transpose_item(w_out, MW, D, nullptr, Wt_out, scr, it - I_IN, lane);
            }
            if (!even && bid == 0) { const float* lbp = ARGP(10);
                for (int c = tid; c < 2048; c += 512) lbtab[c] = (j == 0) ? 0.f : 1.f / (1.f + expf(lbp[c] - lbp[2048 + c])); }
        }
        const float* xsrc = (layer == 0) ? ARGP(0) : ARGP(13);
        { const int g = step_ - layer * NG;
            const size_t row0 = (size_t)g * TOKG;
            norm_rows(xsrc + row0 * D, xn, TOKG, gw, ngw, lane);
            grid.sync();
            { pg8::Gemm gm{xn, Wt_in, TOKG, PW, D}; pg8::StaticOrder S; S.init(TOKG, PW, G, bid); EpiProj E{proj, even ? 0 : 1, lbtab};
              pg8::gemm_phase<EpiProj, pg8::StaticOrder, true, true>((PG8_LAS unsigned char*)lds, gm, S, E); }
            grid.sync();
            if (even) {
                attn_scalar(proj, ybuf, TOKG, ARGP(4) + j * 64, ARGP(5) + j * 64, ARGP(7), lds, tid, lane, wave, gw, ngw);
                conv_scalar(proj, ybuf, TOKG, ARGP(3) + j * 3 * 1024, lane, gw, ngw);
            } else {
                hgrn_scalar(proj, ybuf, TOKG, ARGP(11) + j * MW, lds, tid, lane, wave, bid, G);
            }
            grid.sync();
            { pg8::Gemm gm{ybuf, Wt_out, TOKG, D, MW}; pg8::StaticOrder S; S.init(TOKG, D, G, bid); EpiRes E{xsrc + row0 * D, (float*)ARGP(13) + row0 * D};
              pg8::gemm_phase<EpiRes, pg8::StaticOrder, true, true>((PG8_LAS unsigned char*)lds, gm, S, E); }
            grid.sync();
        }
    }
}

extern "C" void kernel_launch(void* const* d_in, const int* in_sizes, int n_in, void* d_out, int out_size, void* d_ws, size_t ws_size, hipStream_t stream) {
    static int grid = 0;
    if (grid == 0) {
        int dev = 0, cus = 0, per_cu = 0;
        if (hipGetDevice(&dev) != hipSuccess || hipDeviceGetAttribute(&cus, hipDeviceAttributeMultiprocessorCount, dev) != hipSuccess) { fprintf(stderr, "kernel_launch: device query failed\n"); grid = -1; return; }
        if (hipFuncSetAttribute((const void*)fwd, hipFuncAttributeMaxDynamicSharedMemorySize, LDS_BYTES) != hipSuccess) { fprintf(stderr, "kernel_launch: hipFuncSetAttribute failed\n"); grid = -1; return; }
        if (hipOccupancyMaxActiveBlocksPerMultiprocessor(&per_cu, (const void*)fwd, 512, LDS_BYTES) != hipSuccess || per_cu < 1) fprintf(stderr, "kernel_launch: occupancy query reports %d\n", per_cu);
        (void)hipGetLastError();
        grid = cus;
    }
    if (grid < 0) return;
    Args a{};
    for (int i = 0; i < 13; ++i) a.in[i] = (const float*)d_in[i];
    a.out = (float*)d_out; a.ws = (unsigned char*)d_ws;
    a.ngroups = (ws_size >= (size_t)472 * MiB) ? 2 : 4;
    for (int s = 0; s < 4 * a.ngroups; ++s) {
        a.step = s;
        void* args[] = {&a};
        hipError_t e = hipLaunchCooperativeKernel((const void*)fwd, dim3(grid), dim3(512), args, LDS_BYTES, stream);
        if (e != hipSuccess) { fprintf(stderr, "kernel_launch: cooperative launch failed: %s (grid %d)\n", hipGetErrorString(e), grid); break; }
    }
}
```

```cpp
#include <hip/hip_runtime.h>
#include <hip/hip_cooperative_groups.h>
#include <cstdio>
#include <cstdint>
namespace cg = cooperative_groups;
namespace pg8 {
#define PG8_LAS __attribute__((address_space(3)))
typedef unsigned short bf16_t;
typedef short bf16x8 __attribute__((ext_vector_type(8)));
typedef float f32x4 __attribute__((ext_vector_type(4)));
typedef unsigned u32x4 __attribute__((ext_vector_type(4)));
constexpr int BM = 256, BK = 64, HALF = 128, HTB = HALF * BK * 2  , STAGE_BYTES = 8 * HTB, NXCD = 8, WGM = 8;

__host__ __device__ __forceinline__ int lds_byte(int r, int c) { const int st = (r >> 4) * 2 + (c >> 5), rr = r & 15, cc = c & 31, ob = rr * 64 + cc * 2; return st * 1024 + (ob ^ (((ob >> 9) & 1) << 5)); }
__host__ __device__ __forceinline__ void stage_rc(int b, int& R, int& C) { const int st = b / 1024, sb = b % 1024, swz = sb ^ (((sb >> 9) & 1) << 5); R = (st >> 1) * 16 + swz / 64; C = (st & 1) * 32 + (swz % 64) / 2; }
__host__ __device__ __forceinline__ int perm32(int rho) { const int n = rho >> 4, i = rho & 15; return 8 * (i >> 2) + 4 * n + (i & 3); }

struct Unit { int pm, pn; };
struct Gemm { const bf16_t* A; const bf16_t* Bt; int M, N, K; };

struct StaticOrder {
    int nM, nN, nwg, G, c;
    __host__ __device__ void init(int M, int N, int G_, int c_) { nM = M / BM; nN = N / BM; nwg = nM * nN; G = G_; c = c_; }
    __host__ __device__ bool next(int i, Unit& u) const {
        const long L = (long)i * G + c; if (L >= nwg) return false;
        int wgid = (int)L; { const int q = nwg / NXCD, r = nwg % NXCD, xcd = wgid % NXCD, off = wgid / NXCD; wgid = (xcd < r ? xcd * (q + 1) : r * (q + 1) + (xcd - r) * q) + off; }
        const int nig = WGM * nN, gid = wgid / nig, fm = gid * WGM, gsz = (nM - fm) < WGM ? (nM - fm) : WGM;
        u.pm = fm + ((wgid % nig) % gsz); u.pn = (wgid % nig) / gsz; return true;
    }
    __device__ __forceinline__ void a_ready(const Unit&) const {}
    __device__ __forceinline__ void done(const Unit&) const {}
};

__device__ __forceinline__ unsigned cvt_pk_bf16(float lo, float hi) { unsigned r; asm volatile("v_cvt_pk_bf16_f32 %0, %1, %2" : "=v"(r) : "v"(lo), "v"(hi)); return r; }
template <class Epi, class Sched, bool ALIGN_EPI = false, bool SP2 = false>
__device__ __forceinline__ void gemm_phase(PG8_LAS unsigned char* lds, const Gemm g, const Sched& S, const Epi& E) {
    int tid_raw = threadIdx.x; asm volatile("" : "+v"(tid_raw)); const int tid = tid_raw, wid = __builtin_amdgcn_readfirstlane(tid >> 6), lane = tid & 63, wr = wid >> 2, wc = wid & 3, fr = lane & 15, fq = lane >> 4;
    const int K = g.K, nt = K / BK;
    unsigned voffA[2], voffB[2];
#pragma unroll
    for (int i = 0; i < 2; ++i) { int R, C; stage_rc(tid * 16 + i * 8192, R, C); const int Rb = Epi::PERM ? ((R & ~31) + perm32(R & 31)) : R;
        voffA[i] = (unsigned)(R * K + C) * 2u; voffB[i] = (unsigned)(Rb * K + C) * 2u; }
    const size_t kstep = (size_t)(BK * 2);
    const size_t hstep = (size_t)HALF * K * 2;
    const size_t tstep = 2 * hstep;
    const unsigned ldsw = (unsigned)wid * 1024u;
    const int aoff = lds_byte(wr * 64 + fr, fq * 8), boff = lds_byte(wc * 32 + fr, fq * 8);
#define PG8_SA(b, h) (((b) * 2 + (h)) * HTB)
#define PG8_SB(b, h) ((4 + (b) * 2 + (h)) * HTB)
#define PG8_STAGE(bufoff, gbase, voff) do { _Pragma("unroll") for (int _i = 0; _i < 2; ++_i) \
        __builtin_amdgcn_global_load_lds((const unsigned*)((const char*)(gbase) + (voff)[_i]), (PG8_LAS unsigned*)(lds + (bufoff) + ldsw + _i * 8192), 16, 0, 0); } while (0)
#define PG8_LDA(dst, b, h) do { _Pragma("unroll") for (int m = 0; m < 4; ++m) _Pragma("unroll") for (int k = 0; k < 2; ++k) dst[m][k] = *(const PG8_LAS bf16x8*)(lds + PG8_SA(b, h) + aoff + m * 2048 + k * 1024); } while (0)
#define PG8_LDB(dst, b, h) do { _Pragma("unroll") for (int n = 0; n < 2; ++n) _Pragma("unroll") for (int k = 0; k < 2; ++k) dst[n][k] = *(const PG8_LAS bf16x8*)(lds + PG8_SB(b, h) + boff + n * 2048 + k * 1024); } while (0)
#define PG8_MMA(ai, bj, At, Bt) do { __builtin_amdgcn_s_setprio(1); _Pragma("unroll") for (int m = 0; m < 4; ++m) _Pragma("unroll") for (int n = 0; n < 2; ++n) _Pragma("unroll") for (int k = 0; k < 2; ++k) \
        acc[ai][bj][m][n] = __builtin_amdgcn_mfma_f32_16x16x32_bf16(Bt[n][k], At[m][k], acc[ai][bj][m][n], 0, 0, 0); __builtin_amdgcn_s_setprio(0); } while (0)
#define PG8_WAIT_V(n) asm volatile("s_waitcnt vmcnt(" #n ")" ::: "memory")
#define PG8_WAIT_L(n) asm volatile("s_waitcnt lgkmcnt(" #n ")" ::: "memory")
#define PG8_BAR __builtin_amdgcn_s_barrier()
#define PG8_SCHED __builtin_amdgcn_sched_barrier(0)
    Unit cur, nxt; int ui = 0;
    if (!S.next(0, cur)) return;
    f32x4 acc[2][2][4][2];
#pragma unroll
    for (int a = 0; a < 2; ++a)
#pragma unroll
        for (int b = 0; b < 2; ++b)
#pragma unroll
            for (int m = 0; m < 4; ++m)
#pragma unroll
                for (int n = 0; n < 2; ++n) acc[a][b][m][n] = (f32x4){0.f, 0.f, 0.f, 0.f};
    bf16x8 At[4][2], B0[2][2], B1[2][2];
    const char* cA = (const char*)g.A + (size_t)cur.pm * tstep; const char* cB = (const char*)g.Bt + (size_t)cur.pn * tstep;
    S.a_ready(cur);
    if constexpr (SP2) {
        PG8_STAGE(PG8_SB(0, 0), cB, voffB); PG8_STAGE(PG8_SB(0, 1), cB + hstep, voffB); PG8_STAGE(PG8_SA(0, 0), cA, voffA); PG8_STAGE(PG8_SA(0, 1), cA + hstep, voffA);
        if (wr == 1) PG8_BAR;
        PG8_WAIT_V(2); PG8_BAR;
        PG8_STAGE(PG8_SB(1, 0), cB + kstep, voffB); PG8_STAGE(PG8_SA(1, 0), cA + kstep, voffA); PG8_STAGE(PG8_SB(1, 1), cB + hstep + kstep, voffB);
        PG8_WAIT_V(6); PG8_BAR;
    } else {
        PG8_STAGE(PG8_SB(0, 0), cB, voffB); PG8_STAGE(PG8_SA(0, 0), cA, voffA); PG8_STAGE(PG8_SB(0, 1), cB + hstep, voffB); PG8_STAGE(PG8_SA(0, 1), cA + hstep, voffA);
        if (wr == 1) PG8_BAR;
        PG8_WAIT_V(4); PG8_BAR;
        PG8_STAGE(PG8_SB(1, 0), cB + kstep, voffB); PG8_STAGE(PG8_SA(1, 0), cA + kstep, voffA); PG8_STAGE(PG8_SB(1, 1), cB + hstep + kstep, voffB);
        PG8_WAIT_V(6); PG8_BAR;
    }
    for (;;) {
        const bool has_next = S.next(ui + 1, nxt);
        const char* nA = has_next ? (const char*)g.A + (size_t)nxt.pm * tstep : cA; const char* nB = has_next ? (const char*)g.Bt + (size_t)nxt.pn * tstep : cB;
        for (int t = 0; t < nt; t += 2) {
            const bool last = (t == nt - 2);
            const char* a1 = cA + (size_t)(t + 1) * kstep;
            const char* a2 = last ? nA : cA + (size_t)(t + 2) * kstep; const char* b2 = last ? nB : cB + (size_t)(t + 2) * kstep;
            const char* a3 = a2 + kstep; const char* b3 = b2 + kstep;
            if (last && has_next) S.a_ready(nxt);
            if constexpr (SP2) {
            PG8_LDB(B0, 0, 0); PG8_LDB(B1, 0, 1); PG8_SCHED; PG8_LDA(At, 0, 0); PG8_STAGE(PG8_SA(1, 1), a1 + hstep, voffA);
            PG8_WAIT_V(8); PG8_WAIT_L(0); PG8_BAR; PG8_MMA(0, 0, At, B0); PG8_MMA(0, 1, At, B1); PG8_BAR; PG8_SCHED;
            PG8_LDA(At, 0, 1); PG8_STAGE(PG8_SB(0, 0), b2, voffB); PG8_STAGE(PG8_SB(0, 1), b2 + hstep, voffB); PG8_STAGE(PG8_SA(0, 0), a2, voffA);
            PG8_WAIT_V(8); PG8_WAIT_L(0); PG8_BAR; PG8_MMA(1, 0, At, B0); PG8_MMA(1, 1, At, B1); PG8_BAR; PG8_SCHED;
            PG8_LDB(B0, 1, 0); PG8_LDB(B1, 1, 1); PG8_SCHED; PG8_LDA(At, 1, 0); PG8_STAGE(PG8_SA(0, 1), a2 + hstep, voffA);
            PG8_WAIT_V(8); PG8_WAIT_L(0); PG8_BAR; PG8_MMA(0, 0, At, B0); PG8_MMA(0, 1, At, B1); PG8_BAR; PG8_SCHED;
            PG8_LDA(At, 1, 1); PG8_STAGE(PG8_SB(1, 0), b3, voffB); PG8_STAGE(PG8_SB(1, 1), b3 + hstep, voffB); PG8_STAGE(PG8_SA(1, 0), a3, voffA);
            PG8_WAIT_V(8); PG8_WAIT_L(0); PG8_BAR; PG8_MMA(1, 0, At, B0); PG8_MMA(1, 1, At, B1); PG8_BAR; PG8_SCHED;
            } else {
            PG8_LDB(B0, 0, 0); PG8_SCHED; PG8_LDA(At, 0, 0); PG8_STAGE(PG8_SA(1, 1), a1 + hstep, voffA);
            PG8_WAIT_L(8); PG8_BAR; PG8_WAIT_L(0); PG8_MMA(0, 0, At, B0); PG8_BAR; PG8_SCHED;
            PG8_LDB(B1, 0, 1); PG8_STAGE(PG8_SB(0, 0), b2, voffB);
            PG8_BAR; PG8_WAIT_L(0); PG8_MMA(0, 1, At, B1); PG8_BAR;
            PG8_LDA(At, 0, 1); PG8_STAGE(PG8_SA(0, 0), a2, voffA);
            PG8_BAR; PG8_WAIT_L(0); PG8_MMA(1, 0, At, B0); PG8_BAR; PG8_SCHED;
            PG8_STAGE(PG8_SB(0, 1), b2 + hstep, voffB);
            PG8_WAIT_V(6); PG8_BAR; PG8_MMA(1, 1, At, B1); PG8_BAR;
            PG8_LDB(B0, 1, 0); PG8_SCHED; PG8_LDA(At, 1, 0); PG8_STAGE(PG8_SA(0, 1), a2 + hstep, voffA);
            PG8_WAIT_L(8); PG8_BAR; PG8_WAIT_L(0); PG8_MMA(0, 0, At, B0); PG8_BAR; PG8_SCHED;
            PG8_LDB(B1, 1, 1); PG8_STAGE(PG8_SB(1, 0), b3, voffB);
            PG8_BAR; PG8_WAIT_L(0); PG8_MMA(0, 1, At, B1); PG8_BAR;
            PG8_LDA(At, 1, 1); PG8_STAGE(PG8_SA(1, 0), a3, voffA);
            PG8_BAR; PG8_WAIT_L(0); PG8_MMA(1, 0, At, B0); PG8_BAR; PG8_SCHED;
            PG8_STAGE(PG8_SB(1, 1), b3 + hstep, voffB);
            PG8_WAIT_V(6); PG8_BAR; PG8_MMA(1, 1, At, B1); PG8_BAR;
            }
        }
        if constexpr (ALIGN_EPI) { if (wr == 0) PG8_BAR; }
        if constexpr (!Epi::AFTER_DRAIN) { E(acc, cur, wr, wc, fr, fq); S.done(cur); }
        if (!has_next) break;
#pragma unroll
        for (int a = 0; a < 2; ++a)
#pragma unroll
            for (int b = 0; b < 2; ++b)
#pragma unroll
                for (int m = 0; m < 4; ++m)
#pragma unroll
                    for (int n = 0; n < 2; ++n) acc[a][b][m][n] = (f32x4){0.f, 0.f, 0.f, 0.f};
        cur = nxt; cA = nA; cB = nB; ++ui;
        if constexpr (ALIGN_EPI) { if (wr == 1) PG8_BAR; }
    }
    PG8_WAIT_V(0);
    if constexpr (!ALIGN_EPI) { if (wr == 0) PG8_BAR; }
    PG8_BAR;
    if constexpr (Epi::AFTER_DRAIN) { E.fused(acc, cur, wr, wc, fr, fq, lds, wid, lane); S.done(cur); }
#undef PG8_SA
#undef PG8_SB
#undef PG8_STAGE
#undef PG8_LDA
#undef PG8_LDB
#undef PG8_MMA
#undef PG8_WAIT_V
#undef PG8_WAIT_L
#undef PG8_BAR
#undef PG8_SCHED
}
}

constexpr int D = 1024, SEQ = 8192, NBATCH = 4, NTOK = NBATCH * SEQ, PW = 8192, MW = 2048;
constexpr float EPS = 1e-6f;
constexpr size_t MiB = 1u << 20;
constexpr size_t WS_WIN = 0, WS_WOUT = 16 * MiB, WS_MISC = 20 * MiB, WS_PROJ = 24 * MiB;
constexpr int LDS_BYTES = 147456;
typedef unsigned short bf16;
typedef unsigned v4u __attribute__((ext_vector_type(4)));
typedef float f32x4 __attribute__((ext_vector_type(4)));
#define LAS __attribute__((address_space(3)))

__device__ __forceinline__ float bf2f(unsigned short b) { return __uint_as_float(((unsigned)b) << 16); }
__device__ __forceinline__ unsigned f2bf(float f) { unsigned u = __float_as_uint(f); return (u + 0x7fffu + ((u >> 16) & 1u)) >> 16; }
__device__ __forceinline__ unsigned pk2(float lo, float hi) { return f2bf(lo) | (f2bf(hi) << 16); }
__device__ __forceinline__ float wave_sum(float v) {
#pragma unroll
    for (int o = 1; o < 64; o <<= 1) v += __shfl_xor(v, o);
    return v;
}
__device__ __forceinline__ float wave_max(float v) {
#pragma unroll
    for (int o = 1; o < 64; o <<= 1) v = fmaxf(v, __shfl_xor(v, o));
    return v;
}
__device__ __forceinline__ float silu_f(float x) { return x / (1.f + __expf(-x)); }
__device__ __forceinline__ void unpack8(const v4u w, float (&f)[8]) {
    f[0] = __uint_as_float(w.x << 16); f[1] = __uint_as_float(w.x & 0xffff0000u);
    f[2] = __uint_as_float(w.y << 16); f[3] = __uint_as_float(w.y & 0xffff0000u);
    f[4] = __uint_as_float(w.z << 16); f[5] = __uint_as_float(w.z & 0xffff0000u);
    f[6] = __uint_as_float(w.w << 16); f[7] = __uint_as_float(w.w & 0xffff0000u);
}

struct EpiProj {
    static constexpr bool PERM = true, AFTER_DRAIN = false;
    pg8::bf16_t* O; int odd; const float* lb;
    __device__ __forceinline__ void operator()(const pg8::f32x4 (&acc)[2][2][4][2], const pg8::Unit& u, int wr, int wc, int fr, int fq) const {
        const int row0 = u.pm * 256 + wr * 64 + fr, col0 = u.pn * 256 + wc * 32 + 8 * fq;
        int act;
        if (!odd) act = (u.pn >= 24) ? 1 : 0; else act = (u.pn < 8) ? 1 : (u.pn < 16 ? 2 : (u.pn < 24 ? 0 : 1));
        pg8::f32x4 lbv[2][2];
#pragma unroll
        for (int bj = 0; bj < 2; ++bj)
#pragma unroll
            for (int n = 0; n < 2; ++n) lbv[bj][n] = (act == 2) ? *(const pg8::f32x4*)(lb + (col0 - 2048) + bj * 128 + 4 * n) : (pg8::f32x4){0.f, 0.f, 0.f, 0.f};
#pragma unroll
        for (int ai = 0; ai < 2; ++ai)
#pragma unroll
            for (int m = 0; m < 4; ++m) { pg8::bf16_t* rowp = O + (size_t)(row0 + ai * 128 + m * 16) * PW + col0;
#pragma unroll
                for (int bj = 0; bj < 2; ++bj) { pg8::f32x4 v0 = acc[ai][bj][m][0], v1 = acc[ai][bj][m][1];
                    if (act == 1) {
#pragma unroll
                        for (int e = 0; e < 4; ++e) { v0[e] = silu_f(v0[e]); v1[e] = silu_f(v1[e]); } }
                    else if (act == 2) {
#pragma unroll
                        for (int e = 0; e < 4; ++e) { const float s0 = 1.f / (1.f + __expf(-v0[e])), s1 = 1.f / (1.f + __expf(-v1[e]));
                            v0[e] = __logf(lbv[bj][0][e] + (1.f - lbv[bj][0][e]) * s0); v1[e] = __logf(lbv[bj][1][e] + (1.f - lbv[bj][1][e]) * s1); } }
                    pg8::u32x4 w; w.x = pg8::cvt_pk_bf16(v0[0], v0[1]); w.y = pg8::cvt_pk_bf16(v0[2], v0[3]); w.z = pg8::cvt_pk_bf16(v1[0], v1[1]); w.w = pg8::cvt_pk_bf16(v1[2], v1[3]);
                    *(pg8::u32x4*)(rowp + bj * 128) = w; } }
    }
};
struct EpiRes {
    static constexpr bool PERM = false, AFTER_DRAIN = false;
    const float* base; float* out;
    __device__ __forceinline__ void operator()(const pg8::f32x4 (&acc)[2][2][4][2], const pg8::Unit& u, int wr, int wc, int fr, int fq) const {
        const int row0 = u.pm * 256 + wr * 64 + fr, col0 = u.pn * 256 + wc * 32 + 4 * fq;
#pragma unroll
        for (int ai = 0; ai < 2; ++ai)
#pragma unroll
            for (int m = 0; m < 4; ++m) { const size_t off = (size_t)(row0 + ai * 128 + m * 16) * D + col0;
#pragma unroll
                for (int bj = 0; bj < 2; ++bj)
#pragma unroll
                    for (int n = 0; n < 2; ++n) { const pg8::f32x4 b = *(const pg8::f32x4*)(base + off + bj * 128 + n * 16);
                        *(pg8::f32x4*)(out + off + bj * 128 + n * 16) = b + acc[ai][bj][m][n]; } }
    }
};

__device__ __forceinline__ void transpose_item(const float* W, int K, int N, const float* gain, bf16* WT, LAS float* scr, int item, int lane) {
    const int nblk = N / 32, kb = item / nblk, nb = item % nblk, k0 = 64 * kb, n0 = 32 * nb;
#pragma unroll 8
    for (int i = 0; i < 32; ++i) { const int kk = 2 * i + (lane >> 5); float w = W[(size_t)(k0 + kk) * N + n0 + (lane & 31)]; if (gain) w *= gain[k0 + kk]; scr[kk * 33 + (lane & 31)] = w; }
    asm volatile("s_waitcnt lgkmcnt(0)" ::: "memory");
    const int c = lane & 7;
#pragma unroll
    for (int j = 0; j < 4; ++j) { const int n = (lane >> 3) + 8 * j; const LAS float* s = scr + (8 * c) * 33 + n;
        v4u o; o.x = pk2(s[0 * 33], s[1 * 33]); o.y = pk2(s[2 * 33], s[3 * 33]); o.z = pk2(s[4 * 33], s[5 * 33]); o.w = pk2(s[6 * 33], s[7 * 33]);
        *(v4u*)(WT + (size_t)(n0 + n) * K + k0 + 8 * c) = o; }
    asm volatile("s_waitcnt lgkmcnt(0)" ::: "memory");
}
__device__ __forceinline__ void norm_rows(const float* x, bf16* xn, int nrows, int gw, int ngw, int lane) {
    for (int m = gw; m < nrows; m += ngw) {
        const f32x4* xr = (const f32x4*)(x + (size_t)m * D) + lane;
        f32x4 v[4]; float s = 0.f;
#pragma unroll
        for (int j = 0; j < 4; ++j) { v[j] = xr[64 * j]; s += (v[j].x * v[j].x + v[j].y * v[j].y) + (v[j].z * v[j].z + v[j].w * v[j].w); }
        const float rstd = rsqrtf(wave_sum(s) * (1.f / D) + EPS);
        unsigned long long* o8 = (unsigned long long*)(xn + (size_t)m * D) + lane;
#pragma unroll
        for (int j = 0; j < 4; ++j) o8[64 * j] = (unsigned long long)pk2(v[j].x * rstd, v[j].y * rstd) | ((unsigned long long)pk2(v[j].z * rstd, v[j].w * rstd) << 32);
    }
}

__device__ __forceinline__ void attn_scalar(const bf16* proj, bf16* y, int TOKG, const float* qgain, const float* kgain, const float* rel_bias,
                                            unsigned char* lds, int tid, int lane, int wave, int gw, int ngw) {
    int* btab = (int*)lds;
    float* wq = (float*)(lds + 2048 + wave * 2304);
    float* wp = wq + 64;
    for (int e = tid; e < 448; e += 512) {
        int bk = -1;
        if (e < 387) { const int p = e / 129, jj = e - 129 * p, dist = jj << (2 * p);
            if (dist < 16) bk = dist; else { const float sc = logf((float)dist / 16.f) / logf(128.f); int lg = 16 + (int)(sc * 16.f); bk = lg < 31 ? lg : 31; } }
        btab[e] = bk;
    }
    __syncthreads();
    const float qgl = qgain[lane] * 0.125f, kgl = kgain[lane];
    const int nitems = TOKG * 16;
    for (int it = gw; it < nitems; it += ngw) {
        const int t = it & (SEQ - 1), bh = it >> 13, h = bh & 15, bl = bh >> 4;
        const size_t rowb = (size_t)bl * SEQ;
        const bf16* prow = proj + (rowb + t) * PW;
        const float q = bf2f(prow[3072 + h * 64 + lane]);
        const float ss = wave_sum(q * q);
        wq[lane] = q * rsqrtf(ss * (1.f / 64.f) + EPS) * qgl * kgl;
        asm volatile("s_waitcnt lgkmcnt(0)" ::: "memory");
        float lg[7]; float mx = -INFINITY;
#pragma unroll
        for (int r = 0; r < 7; ++r) {
            const int e = lane + 64 * r; const int bk = btab[e];
            const int p = e / 129, jj = e - 129 * p; const int tk = t - (jj << (2 * p));
            float l = -INFINITY;
            if (bk >= 0 && tk >= 0) {
                const v4u* kr = (const v4u*)(proj + (rowb + tk) * PW + 4096 + h * 64);
                float dot = 0.f, ks = 0.f;
#pragma unroll
                for (int c8 = 0; c8 < 8; ++c8) { float f[8]; unpack8(kr[c8], f);
#pragma unroll
                    for (int i = 0; i < 8; ++i) { dot += wq[c8 * 8 + i] * f[i]; ks += f[i] * f[i]; } }
                l = dot * rsqrtf(ks * (1.f / 64.f) + EPS) + rel_bias[bk * 16 + h];
            }
            lg[r] = l; mx = fmaxf(mx, l);
        }
        mx = wave_max(mx);
        float sum = 0.f;
#pragma unroll
        for (int r = 0; r < 7; ++r) { const float pe = (lg[r] == -INFINITY) ? 0.f : __expf(lg[r] - mx); wp[lane + 64 * r] = pe; sum += pe; }
        sum = wave_sum(sum);
        asm volatile("s_waitcnt lgkmcnt(0)" ::: "memory");
        float o = 0.f;
        const bf16* vbase = proj + rowb * PW + 5120 + h * 64 + lane;
#pragma unroll
        for (int p = 0; p < 3; ++p) {
#pragma unroll 8
            for (int jj = 0; jj <= 128; ++jj) { int tk = t - (jj << (2 * p)); const float pe = wp[p * 129 + jj]; if (tk < 0) tk = t;
                o += pe * bf2f(vbase[(size_t)tk * PW]); }
        }
        const float z = bf2f(prow[6144 + 1024 + h * 64 + lane]);
        y[(rowb + t) * MW + 1024 + h * 64 + lane] = (bf16)f2bf(o / sum * z);
    }
}
__device__ __forceinline__ void conv_scalar(const bf16* proj, bf16* y, int TOKG, const float* convw, int lane, int gw, int ngw) {
    for (int it = gw; it < TOKG; it += ngw) {
        const int t = it & (SEQ - 1); const bf16* prow = proj + (size_t)it * PW;
#pragma unroll
        for (int i = 0; i < 2; ++i) { const int c0 = lane * 8 + 512 * i;
            float acc[8] = {0.f, 0.f, 0.f, 0.f, 0.f, 0.f, 0.f, 0.f};
#pragma unroll
            for (int dt = 0; dt < 3; ++dt) { const int tt = t - 2 + dt;
                if (tt >= 0) { const bf16* pr = prow - (size_t)(2 - dt) * PW; float gc[8], xa[8];
                    unpack8(*(const v4u*)(pr + 1024 + c0), gc); unpack8(*(const v4u*)(pr + 2048 + c0), xa);
#pragma unroll
                    for (int e = 0; e < 8; ++e) acc[e] += convw[dt * 1024 + c0 + e] * (gc[e] * xa[e]); } }
            float gb[8], z[8]; unpack8(*(const v4u*)(prow + c0), gb); unpack8(*(const v4u*)(prow + 6144 + c0), z);
            v4u o; o.x = pk2(gb[0] * acc[0] * z[0], gb[1] * acc[1] * z[1]); o.y = pk2(gb[2] * acc[2] * z[2], gb[3] * acc[3] * z[3]);
            o.z = pk2(gb[4] * acc[4] * z[4], gb[5] * acc[5] * z[5]); o.w = pk2(gb[6] * acc[6] * z[6], gb[7] * acc[7] * z[7]);
            *(v4u*)(y + (size_t)it * MW + c0) = o; }
    }
}

__device__ __forceinline__ void hgrn_scalar(const bf16* proj, bf16* y, int TOKG, const float* ogain, unsigned char* lds, int tid, int lane, int wave, int bid, int G) {
    float* sq = (float*)lds; float* sf = sq + 4096; float* sk = sf + 4096; float* sv = sk + 4096; float* sop = sv + 4096;
    const int nseq = (TOKG / SEQ) * 16;
    const int v = tid & 127, kq = tid >> 7;
    for (int s = bid; s < nseq; s += G) {
        const int bl = s >> 4, h = s & 15; const size_t rowb = (size_t)bl * SEQ;
        float S[32];
#pragma unroll
        for (int i = 0; i < 32; ++i) S[i] = 0.f;
        const float og0 = ogain[h * 128 + lane], og1 = ogain[h * 128 + 64 + lane];
        for (int t0 = 0; t0 < SEQ; t0 += 32) {
#pragma unroll
            for (int i = 0; i < 8; ++i) { const int idx = tid + 512 * i, tt = idx >> 7, col = idx & 127; const bf16* prow = proj + (rowb + t0 + tt) * PW + h * 128 + col;
                sq[idx] = bf2f(prow[0]); const float f = __expf(bf2f(prow[2048])); sf[idx] = f; sk[idx] = 1.f - f; sv[idx] = bf2f(prow[4096]); }
            __syncthreads();
            for (int tt = 0; tt < 32; ++tt) {
                const float vv = sv[tt * 128 + v]; float acc = 0.f;
                const f32x4* pf = (const f32x4*)(sf + tt * 128 + kq * 32); const f32x4* pk = (const f32x4*)(sk + tt * 128 + kq * 32); const f32x4* pq = (const f32x4*)(sq + tt * 128 + kq * 32);
#pragma unroll
                for (int i4 = 0; i4 < 8; ++i4) { const f32x4 f = pf[i4], k = pk[i4], q = pq[i4];
#pragma unroll
                    for (int e = 0; e < 4; ++e) { S[i4 * 4 + e] = f[e] * S[i4 * 4 + e] + k[e] * vv; acc += q[e] * S[i4 * 4 + e]; } }
                sop[(kq * 32 + tt) * 128 + v] = acc;
            }
            __syncthreads();
#pragma unroll
            for (int i2 = 0; i2 < 4; ++i2) { const int tt = wave + 8 * i2;
                float o0 = 0.f, o1 = 0.f;
#pragma unroll
                for (int k4 = 0; k4 < 4; ++k4) { o0 += sop[(k4 * 32 + tt) * 128 + lane]; o1 += sop[(k4 * 32 + tt) * 128 + 64 + lane]; }
                const float rstd = rsqrtf(wave_sum(o0 * o0 + o1 * o1) * (1.f / 128.f) + EPS);
                const bf16* prow = proj + (rowb + t0 + tt) * PW + 6144 + h * 128;
                bf16* yr = y + (rowb + t0 + tt) * MW + h * 128;
                yr[lane] = (bf16)f2bf(o0 * rstd * og0 * bf2f(prow[lane])); yr[64 + lane] = (bf16)f2bf(o1 * rstd * og1 * bf2f(prow[64 + lane])); }
            __syncthreads();
        }
    }
}

__device__ __forceinline__ unsigned long long ldptr(LAS unsigned long long* tab, int i) { asm volatile("" ::: "memory"); const unsigned long long v = tab[i];
    const unsigned lo = __builtin_amdgcn_readfirstlane((unsigned)v), hi = __builtin_amdgcn_readfirstlane((unsigned)(v >> 32)); return ((unsigned long long)hi << 32) | lo; }
struct Args { const float* in[13]; float* out; unsigned char* ws; int ngroups; int pad; };
struct Ctx { int layer, g, NG, TOKG, j, even, tid, lane, wave, G, bid, gw, ngw; unsigned char* wsb; bf16 *Wt_in, *Wt_out, *proj, *ybuf, *xn; float* lbtab; size_t row0; };
__device__ __forceinline__ Ctx load_ctx(LAS unsigned long long* ptab) {
    Ctx c; const int step = (int)ldptr(ptab, 16); c.NG = (int)ldptr(ptab, 15); c.layer = step / c.NG; c.g = step - c.layer * c.NG; c.TOKG = NTOK / c.NG; c.j = c.layer >> 1; c.even = !(c.layer & 1);
    int tid_raw = threadIdx.x; asm volatile("" : "+v"(tid_raw)); c.tid = tid_raw; c.lane = c.tid & 63; c.wave = __builtin_amdgcn_readfirstlane(c.tid >> 6);
    c.G = gridDim.x; c.bid = blockIdx.x; c.gw = c.bid * 8 + c.wave; c.ngw = c.G * 8;
    c.wsb = (unsigned char*)ldptr(ptab, 14);
    c.Wt_in = (bf16*)(c.wsb + WS_WIN); c.Wt_out = (bf16*)(c.wsb + WS_WOUT); c.lbtab = (float*)(c.wsb + WS_MISC); c.proj = (bf16*)(c.wsb + WS_PROJ);
    c.ybuf = (bf16*)(c.wsb + WS_PROJ + (size_t)c.TOKG * (PW * 2)); c.xn = (bf16*)(c.wsb + WS_PROJ + (size_t)c.TOKG * (PW * 2 + MW * 2));
    c.row0 = (size_t)c.g * c.TOKG; return c;
}
#define ARGP(i) ((const float*)ldptr(ptab, (i)))
__global__ void __launch_bounds__(512, 2) fwd(Args a) {
    extern __shared__ __attribute__((aligned(16))) unsigned char lds[];
    cg::grid_group grid = cg::this_grid();
    LAS unsigned long long* ptab = (LAS unsigned long long*)((LAS unsigned char*)lds + 131072 + 1024);
    if (threadIdx.x == 0) {
#pragma unroll
        for (int i = 0; i < 13; ++i) ptab[i] = (unsigned long long)a.in[i];
        ptab[13] = (unsigned long long)a.out; ptab[14] = (unsigned long long)a.ws; ptab[15] = (unsigned long long)a.ngroups; ptab[16] = 0ull; }
    __syncthreads();
    for (;;) {
        {
            const Ctx c = load_ctx(ptab);
            if (c.g == 0) {
                const float* w_in = (c.even ? ARGP(2) : ARGP(9)) + (size_t)c.j * D * PW;
                const float* ln = (c.even ? ARGP(1) : ARGP(8)) + (size_t)c.j * D;
                const float* w_out = (c.even ? ARGP(6) : ARGP(12)) + (size_t)c.j * MW * D;
                LAS float* scr = (LAS float*)((LAS unsigned char*)lds + c.wave * 16384);
                constexpr int I_IN = (D / 64) * (PW / 32), I_OUT = (MW / 64) * (D / 32);
                for (int it = c.gw; it < I_IN + I_OUT; it += c.ngw) {
                    if (it < I_IN) transpose_item(w_in, D, PW, ln, c.Wt_in, scr, it, c.lane);
                    else transpose_item(w_out, MW, D, nullptr, c.Wt_out, scr, it - I_IN, c.lane);
                }
                if (!c.even && c.bid == 0) { const float* lbp = ARGP(10);
                    for (int col = c.tid; col < 2048; col += 512) c.lbtab[col] = (c.j == 0) ? 0.f : 1.f / (1.f + expf(lbp[col] - lbp[2048 + col])); }
            }
            const float* xsrc = (c.layer == 0) ? ARGP(0) : ARGP(13);
            norm_rows(xsrc + c.row0 * D, c.xn, c.TOKG, c.gw, c.ngw, c.lane);
        }
        grid.sync();
        {
            const Ctx c = load_ctx(ptab);
            pg8::Gemm gm{c.xn, c.Wt_in, c.TOKG, PW, D}; pg8::StaticOrder S; S.init(c.TOKG, PW, c.G, c.bid); EpiProj E{c.proj, c.even ? 0 : 1, c.lbtab};
            pg8::gemm_phase<EpiProj, pg8::StaticOrder, true, true>((PG8_LAS unsigned char*)lds, gm, S, E);
        }
        grid.sync();
        {
            const Ctx c = load_ctx(ptab);
            if (c.even) {
                attn_scalar(c.proj, c.ybuf, c.TOKG, ARGP(4) + c.j * 64, ARGP(5) + c.j * 64, ARGP(7), lds, c.tid, c.lane, c.wave, c.gw, c.ngw);
                conv_scalar(c.proj, c.ybuf, c.TOKG, ARGP(3) + c.j * 3 * 1024, c.lane, c.gw, c.ngw);
            } else {
                hgrn_scalar(c.proj, c.ybuf, c.TOKG, ARGP(11) + c.j * MW, lds, c.tid, c.lane, c.wave, c.bid, c.G);
            }
        }
        grid.sync();
        {
            const Ctx c = load_ctx(ptab);
            const float* xsrc = (c.layer == 0) ? ARGP(0) : ARGP(13);
            pg8::Gemm gm{c.ybuf, c.Wt_out, c.TOKG, D, MW}; pg8::StaticOrder S; S.init(c.TOKG, D, c.G, c.bid); EpiRes E{xsrc + c.row0 * D, (float*)ARGP(13) + c.row0 * D};
            pg8::gemm_phase<EpiRes, pg8::StaticOrder, true, true>((PG8_LAS unsigned char*)lds, gm, S, E);
        }
        grid.sync();
        const int step = (int)ldptr(ptab, 16), nsteps = 4 * (int)ldptr(ptab, 15);
        __syncthreads();
        if (threadIdx.x == 0) ptab[16] = (unsigned long long)(step + 1);
        __syncthreads();
        if (step + 1 >= nsteps) break;
    }
}

extern "C" void kernel_launch(void* const* d_in, const int* in_sizes, int n_in, void* d_out, int out_size, void* d_ws, size_t ws_size, hipStream_t stream) {
    static int grid = 0;
    if (grid == 0) {
        int dev = 0, cus = 0, per_cu = 0;
        if (hipGetDevice(&dev) != hipSuccess || hipDeviceGetAttribute(&cus, hipDeviceAttributeMultiprocessorCount, dev) != hipSuccess) { fprintf(stderr, "kernel_launch: device query failed\n"); grid = -1; return; }
        if (hipFuncSetAttribute((const void*)fwd, hipFuncAttributeMaxDynamicSharedMemorySize, LDS_BYTES) != hipSuccess) { fprintf(stderr, "kernel_launch: hipFuncSetAttribute failed\n"); grid = -1; return; }
        if (hipOccupancyMaxActiveBlocksPerMultiprocessor(&per_cu, (const void*)fwd, 512, LDS_BYTES) != hipSuccess || per_cu < 1) fprintf(stderr, "kernel_launch: occupancy query reports %d\n", per_cu);
        (void)hipGetLastError();
        grid = cus;
    }
    if (grid < 0) return;
    Args a{};
    for (int i = 0; i < 13; ++i) a.in[i] = (const float*)d_in[i];
    a.out = (float*)d_out; a.ws = (unsigned char*)d_ws;
    a.ngroups = (ws_size >= (size_t)472 * MiB) ? 2 : 4;
    void* args[] = {&a};
    hipError_t e = hipLaunchCooperativeKernel((const void*)fwd, dim3(grid), dim3(512), args, LDS_BYTES, stream);
    if (e != hipSuccess) fprintf(stderr, "kernel_launch: cooperative launch failed: %s (grid %d)\n", hipGetErrorString(e), grid);
}
```

```cpp
#include <hip/hip_runtime.h>
#include <hip/hip_cooperative_groups.h>
#include <cstdio>
#include <cstdint>
namespace cg = cooperative_groups;
namespace pg8 {
#define PG8_LAS __attribute__((address_space(3)))
typedef unsigned short bf16_t;
typedef short bf16x8 __attribute__((ext_vector_type(8)));
typedef float f32x4 __attribute__((ext_vector_type(4)));
typedef unsigned u32x4 __attribute__((ext_vector_type(4)));
constexpr int BM = 256, BK = 64, HALF = 128, HTB = HALF * BK * 2  , STAGE_BYTES = 8 * HTB, NXCD = 8, WGM = 8;

__host__ __device__ __forceinline__ int lds_byte(int r, int c) { const int st = (r >> 4) * 2 + (c >> 5), rr = r & 15, cc = c & 31, ob = rr * 64 + cc * 2; return st * 1024 + (ob ^ (((ob >> 9) & 1) << 5)); }
__host__ __device__ __forceinline__ void stage_rc(int b, int& R, int& C) { const int st = b / 1024, sb = b % 1024, swz = sb ^ (((sb >> 9) & 1) << 5); R = (st >> 1) * 16 + swz / 64; C = (st & 1) * 32 + (swz % 64) / 2; }
__host__ __device__ __forceinline__ int perm32(int rho) { const int n = rho >> 4, i = rho & 15; return 8 * (i >> 2) + 4 * n + (i & 3); }

struct Unit { int pm, pn; };
struct Gemm { const bf16_t* A; const bf16_t* Bt; int M, N, K; };

struct StaticOrder {
    int nM, nN, nwg, G, c;
    __host__ __device__ void init(int M, int N, int G_, int c_) { nM = M / BM; nN = N / BM; nwg = nM * nN; G = G_; c = c_; }
    __host__ __device__ bool next(int i, Unit& u) const {
        const long L = (long)i * G + c; if (L >= nwg) return false;
        int wgid = (int)L; { const int q = nwg / NXCD, r = nwg % NXCD, xcd = wgid % NXCD, off = wgid / NXCD; wgid = (xcd < r ? xcd * (q + 1) : r * (q + 1) + (xcd - r) * q) + off; }
        const int nig = WGM * nN, gid = wgid / nig, fm = gid * WGM, gsz = (nM - fm) < WGM ? (nM - fm) : WGM;
        u.pm = fm + ((wgid % nig) % gsz); u.pn = (wgid % nig) / gsz; return true;
    }
    __device__ __forceinline__ void a_ready(const Unit&) const {}
    __device__ __forceinline__ void done(const Unit&) const {}
};

__device__ __forceinline__ unsigned cvt_pk_bf16(float lo, float hi) { unsigned r; asm volatile("v_cvt_pk_bf16_f32 %0, %1, %2" : "=v"(r) : "v"(lo), "v"(hi)); return r; }
template <class Epi, class Sched, bool ALIGN_EPI = false, bool SP2 = false>
__device__ __forceinline__ void gemm_phase(PG8_LAS unsigned char* lds, const Gemm g, const Sched& S, const Epi& E) {
    int tid_raw = threadIdx.x; asm volatile("" : "+v"(tid_raw)); const int tid = tid_raw, wid = __builtin_amdgcn_readfirstlane(tid >> 6), lane = tid & 63, wr = wid >> 2, wc = wid & 3, fr = lane & 15, fq = lane >> 4;
    const int K = g.K, nt = K / BK;
    unsigned voffA[2], voffB[2];
#pragma unroll
    for (int i = 0; i < 2; ++i) { int R, C; stage_rc(tid * 16 + i * 8192, R, C); const int Rb = Epi::PERM ? ((R & ~31) + perm32(R & 31)) : R;
        voffA[i] = (unsigned)(R * K + C) * 2u; voffB[i] = (unsigned)(Rb * K + C) * 2u; }
    const size_t kstep = (size_t)(BK * 2);
    const size_t hstep = (size_t)HALF * K * 2;
    const size_t tstep = 2 * hstep;
    const unsigned ldsw = (unsigned)wid * 1024u;
    const int aoff = lds_byte(wr * 64 + fr, fq * 8), boff = lds_byte(wc * 32 + fr, fq * 8);
#define PG8_SA(b, h) (((b) * 2 + (h)) * HTB)
#define PG8_SB(b, h) ((4 + (b) * 2 + (h)) * HTB)
#define PG8_STAGE(bufoff, gbase, voff) do { _Pragma("unroll") for (int _i = 0; _i < 2; ++_i) \
        __builtin_amdgcn_global_load_lds((const unsigned*)((const char*)(gbase) + (voff)[_i]), (PG8_LAS unsigned*)(lds + (bufoff) + ldsw + _i * 8192), 16, 0, 0); } while (0)
#define PG8_LDA(dst, b, h) do { _Pragma("unroll") for (int m = 0; m < 4; ++m) _Pragma("unroll") for (int k = 0; k < 2; ++k) dst[m][k] = *(const PG8_LAS bf16x8*)(lds + PG8_SA(b, h) + aoff + m * 2048 + k * 1024); } while (0)
#define PG8_LDB(dst, b, h) do { _Pragma("unroll") for (int n = 0; n < 2; ++n) _Pragma("unroll") for (int k = 0; k < 2; ++k) dst[n][k] = *(const PG8_LAS bf16x8*)(lds + PG8_SB(b, h) + boff + n * 2048 + k * 1024); } while (0)
#define PG8_MMA(ai, bj, At, Bt) do { __builtin_amdgcn_s_setprio(1); _Pragma("unroll") for (int m = 0; m < 4; ++m) _Pragma("unroll") for (int n = 0; n < 2; ++n) _Pragma("unroll") for (int k = 0; k < 2; ++k) \
        acc[ai][bj][m][n] = __builtin_amdgcn_mfma_f32_16x16x32_bf16(Bt[n][k], At[m][k], acc[ai][bj][m][n], 0, 0, 0); __builtin_amdgcn_s_setprio(0); } while (0)
#define PG8_WAIT_V(n) asm volatile("s_waitcnt vmcnt(" #n ")" ::: "memory")
#define PG8_WAIT_L(n) asm volatile("s_waitcnt lgkmcnt(" #n ")" ::: "memory")
#define PG8_BAR __builtin_amdgcn_s_barrier()
#define PG8_SCHED __builtin_amdgcn_sched_barrier(0)
    Unit cur, nxt; int ui = 0;
    if (!S.next(0, cur)) return;
    f32x4 acc[2][2][4][2];
#pragma unroll
    for (int a = 0; a < 2; ++a)
#pragma unroll
        for (int b = 0; b < 2; ++b)
#pragma unroll
            for (int m = 0; m < 4; ++m)
#pragma unroll
                for (int n = 0; n < 2; ++n) acc[a][b][m][n] = (f32x4){0.f, 0.f, 0.f, 0.f};
    bf16x8 At[4][2], B0[2][2], B1[2][2];
    const char* cA = (const char*)g.A + (size_t)cur.pm * tstep; const char* cB = (const char*)g.Bt + (size_t)cur.pn * tstep;
    S.a_ready(cur);
    if constexpr (SP2) {
        PG8_STAGE(PG8_SB(0, 0), cB, voffB); PG8_STAGE(PG8_SB(0, 1), cB + hstep, voffB); PG8_STAGE(PG8_SA(0, 0), cA, voffA); PG8_STAGE(PG8_SA(0, 1), cA + hstep, voffA);
        if (wr == 1) PG8_BAR;
        PG8_WAIT_V(2); PG8_BAR;
        PG8_STAGE(PG8_SB(1, 0), cB + kstep, voffB); PG8_STAGE(PG8_SA(1, 0), cA + kstep, voffA); PG8_STAGE(PG8_SB(1, 1), cB + hstep + kstep, voffB);
        PG8_WAIT_V(6); PG8_BAR;
    } else {
        PG8_STAGE(PG8_SB(0, 0), cB, voffB); PG8_STAGE(PG8_SA(0, 0), cA, voffA); PG8_STAGE(PG8_SB(0, 1), cB + hstep, voffB); PG8_STAGE(PG8_SA(0, 1), cA + hstep, voffA);
        if (wr == 1) PG8_BAR;
        PG8_WAIT_V(4); PG8_BAR;
        PG8_STAGE(PG8_SB(1, 0), cB + kstep, voffB); PG8_STAGE(PG8_SA(1, 0), cA + kstep, voffA); PG8_STAGE(PG8_SB(1, 1), cB + hstep + kstep, voffB);
        PG8_WAIT_V(6); PG8_BAR;
    }
    for (;;) {
        const bool has_next = S.next(ui + 1, nxt);
        const char* nA = has_next ? (const char*)g.A + (size_t)nxt.pm * tstep : cA; const char* nB = has_next ? (const char*)g.Bt + (size_t)nxt.pn * tstep : cB;
        for (int t = 0; t < nt; t += 2) {
            const bool last = (t == nt - 2);
            const char* a1 = cA + (size_t)(t + 1) * kstep;
            const char* a2 = last ? nA : cA + (size_t)(t + 2) * kstep; const char* b2 = last ? nB : cB + (size_t)(t + 2) * kstep;
            const char* a3 = a2 + kstep; const char* b3 = b2 + kstep;
            if (last && has_next) S.a_ready(nxt);
            if constexpr (SP2) {
            PG8_LDB(B0, 0, 0); PG8_LDB(B1, 0, 1); PG8_SCHED; PG8_LDA(At, 0, 0); PG8_STAGE(PG8_SA(1, 1), a1 + hstep, voffA);
            PG8_WAIT_V(8); PG8_WAIT_L(0); PG8_BAR; PG8_MMA(0, 0, At, B0); PG8_MMA(0, 1, At, B1); PG8_BAR; PG8_SCHED;
            PG8_LDA(At, 0, 1); PG8_STAGE(PG8_SB(0, 0), b2, voffB); PG8_STAGE(PG8_SB(0, 1), b2 + hstep, voffB); PG8_STAGE(PG8_SA(0, 0), a2, voffA);
            PG8_WAIT_V(8); PG8_WAIT_L(0); PG8_BAR; PG8_MMA(1, 0, At, B0); PG8_MMA(1, 1, At, B1); PG8_BAR; PG8_SCHED;
            PG8_LDB(B0, 1, 0); PG8_LDB(B1, 1, 1); PG8_SCHED; PG8_LDA(At, 1, 0); PG8_STAGE(PG8_SA(0, 1), a2 + hstep, voffA);
            PG8_WAIT_V(8); PG8_WAIT_L(0); PG8_BAR; PG8_MMA(0, 0, At, B0); PG8_MMA(0, 1, At, B1); PG8_BAR; PG8_SCHED;
            PG8_LDA(At, 1, 1); PG8_STAGE(PG8_SB(1, 0), b3, voffB); PG8_STAGE(PG8_SB(1, 1), b3 + hstep, voffB); PG8_STAGE(PG8_SA(1, 0), a3, voffA);
            PG8_WAIT_V(8); PG8_WAIT_L(0); PG8_BAR; PG8_MMA(1, 0, At, B0); PG8_MMA(1, 1, At, B1); PG8_BAR; PG8_SCHED;
            } else {
            PG8_LDB(B0, 0, 0); PG8_SCHED; PG8_LDA(At, 0, 0); PG8_STAGE(PG8_SA(1, 1), a1 + hstep, voffA);
            PG8_WAIT_L(8); PG8_BAR; PG8_WAIT_L(0); PG8_MMA(0, 0, At, B0); PG8_BAR; PG8_SCHED;
            PG8_LDB(B1, 0, 1); PG8_STAGE(PG8_SB(0, 0), b2, voffB);
            PG8_BAR; PG8_WAIT_L(0); PG8_MMA(0, 1, At, B1); PG8_BAR;
            PG8_LDA(At, 0, 1); PG8_STAGE(PG8_SA(0, 0), a2, voffA);
            PG8_BAR; PG8_WAIT_L(0); PG8_MMA(1, 0, At, B0); PG8_BAR; PG8_SCHED;
            PG8_STAGE(PG8_SB(0, 1), b2 + hstep, voffB);
            PG8_WAIT_V(6); PG8_BAR; PG8_MMA(1, 1, At, B1); PG8_BAR;
            PG8_LDB(B0, 1, 0); PG8_SCHED; PG8_LDA(At, 1, 0); PG8_STAGE(PG8_SA(0, 1), a2 + hstep, voffA);
            PG8_WAIT_L(8); PG8_BAR; PG8_WAIT_L(0); PG8_MMA(0, 0, At, B0); PG8_BAR; PG8_SCHED;
            PG8_LDB(B1, 1, 1); PG8_STAGE(PG8_SB(1, 0), b3, voffB);
            PG8_BAR; PG8_WAIT_L(0); PG8_MMA(0, 1, At, B1); PG8_BAR;
            PG8_LDA(At, 1, 1); PG8_STAGE(PG8_SA(1, 0), a3, voffA);
            PG8_BAR; PG8_WAIT_L(0); PG8_MMA(1, 0, At, B0); PG8_BAR; PG8_SCHED;
            PG8_STAGE(PG8_SB(1, 1), b3 + hstep, voffB);
            PG8_WAIT_V(6); PG8_BAR; PG8_MMA(1, 1, At, B1); PG8_BAR;
            }
        }
        if constexpr (ALIGN_EPI) { if (wr == 0) PG8_BAR; }
        if constexpr (!Epi::AFTER_DRAIN) { E(acc, cur, wr, wc, fr, fq); S.done(cur); }
        if (!has_next) break;
#pragma unroll
        for (int a = 0; a < 2; ++a)
#pragma unroll
            for (int b = 0; b < 2; ++b)
#pragma unroll
                for (int m = 0; m < 4; ++m)
#pragma unroll
                    for (int n = 0; n < 2; ++n) acc[a][b][m][n] = (f32x4){0.f, 0.f, 0.f, 0.f};
        cur = nxt; cA = nA; cB = nB; ++ui;
        if constexpr (ALIGN_EPI) { if (wr == 1) PG8_BAR; }
    }
    PG8_WAIT_V(0);
    if constexpr (!ALIGN_EPI) { if (wr == 0) PG8_BAR; }
    PG8_BAR;
    if constexpr (Epi::AFTER_DRAIN) { E.fused(acc, cur, wr, wc, fr, fq, lds, wid, lane); S.done(cur); }
#undef PG8_SA
#undef PG8_SB
#undef PG8_STAGE
#undef PG8_LDA
#undef PG8_LDB
#undef PG8_MMA
#undef PG8_WAIT_V
#undef PG8_WAIT_L
#undef PG8_BAR
#undef PG8_SCHED
}
}

constexpr int D = 1024, SEQ = 8192, NBATCH = 4, NTOK = NBATCH * SEQ, PW = 8192, MW = 2048;
constexpr float EPS = 1e-6f;
constexpr size_t MiB = 1u << 20;
constexpr size_t WS_WIN = 0, WS_WOUT = 16 * MiB, WS_MISC = 20 * MiB, WS_PROJ = 24 * MiB;
constexpr int LDS_BYTES = 147456;
typedef unsigned short bf16;
typedef unsigned v4u __attribute__((ext_vector_type(4)));
typedef float f32x4 __attribute__((ext_vector_type(4)));
#define LAS __attribute__((address_space(3)))

__device__ __forceinline__ float bf2f(unsigned short b) { return __uint_as_float(((unsigned)b) << 16); }
__device__ __forceinline__ unsigned f2bf(float f) { unsigned u = __float_as_uint(f); return (u + 0x7fffu + ((u >> 16) & 1u)) >> 16; }
__device__ __forceinline__ unsigned pk2(float lo, float hi) { return f2bf(lo) | (f2bf(hi) << 16); }
__device__ __forceinline__ float wave_sum(float v) {
#pragma unroll
    for (int o = 1; o < 64; o <<= 1) v += __shfl_xor(v, o);
    return v;
}
__device__ __forceinline__ float wave_max(float v) {
#pragma unroll
    for (int o = 1; o < 64; o <<= 1) v = fmaxf(v, __shfl_xor(v, o));
    return v;
}
__device__ __forceinline__ float silu_f(float x) { return x / (1.f + __expf(-x)); }
__device__ __forceinline__ void unpack8(const v4u w, float (&f)[8]) {
    f[0] = __uint_as_float(w.x << 16); f[1] = __uint_as_float(w.x & 0xffff0000u);
    f[2] = __uint_as_float(w.y << 16); f[3] = __uint_as_float(w.y & 0xffff0000u);
    f[4] = __uint_as_float(w.z << 16); f[5] = __uint_as_float(w.z & 0xffff0000u);
    f[6] = __uint_as_float(w.w << 16); f[7] = __uint_as_float(w.w & 0xffff0000u);
}

struct EpiProj {
    static constexpr bool PERM = true, AFTER_DRAIN = false;
    pg8::bf16_t* O; int odd; const float* lb;
    __device__ __forceinline__ void operator()(const pg8::f32x4 (&acc)[2][2][4][2], const pg8::Unit& u, int wr, int wc, int fr, int fq) const {
        const int row0 = u.pm * 256 + wr * 64 + fr, col0 = u.pn * 256 + wc * 32 + 8 * fq;
        int act;
        if (!odd) act = (u.pn >= 24) ? 1 : 0; else act = (u.pn < 8) ? 1 : (u.pn < 16 ? 2 : (u.pn < 24 ? 0 : 1));
        pg8::f32x4 lbv[2][2];
#pragma unroll
        for (int bj = 0; bj < 2; ++bj)
#pragma unroll
            for (int n = 0; n < 2; ++n) lbv[bj][n] = (act == 2) ? *(const pg8::f32x4*)(lb + (col0 - 2048) + bj * 128 + 4 * n) : (pg8::f32x4){0.f, 0.f, 0.f, 0.f};
#pragma unroll
        for (int ai = 0; ai < 2; ++ai)
#pragma unroll
            for (int m = 0; m < 4; ++m) { pg8::bf16_t* rowp = O + (size_t)(row0 + ai * 128 + m * 16) * PW + col0;
#pragma unroll
                for (int bj = 0; bj < 2; ++bj) { pg8::f32x4 v0 = acc[ai][bj][m][0], v1 = acc[ai][bj][m][1];
                    if (act == 1) {
#pragma unroll
                        for (int e = 0; e < 4; ++e) { v0[e] = silu_f(v0[e]); v1[e] = silu_f(v1[e]); } }
                    else if (act == 2) {
#pragma unroll
                        for (int e = 0; e < 4; ++e) { const float s0 = 1.f / (1.f + __expf(-v0[e])), s1 = 1.f / (1.f + __expf(-v1[e]));
                            v0[e] = __logf(lbv[bj][0][e] + (1.f - lbv[bj][0][e]) * s0); v1[e] = __logf(lbv[bj][1][e] + (1.f - lbv[bj][1][e]) * s1); } }
                    pg8::u32x4 w; w.x = pg8::cvt_pk_bf16(v0[0], v0[1]); w.y = pg8::cvt_pk_bf16(v0[2], v0[3]); w.z = pg8::cvt_pk_bf16(v1[0], v1[1]); w.w = pg8::cvt_pk_bf16(v1[2], v1[3]);
                    *(pg8::u32x4*)(rowp + bj * 128) = w; } }
    }
};
struct EpiRes {
    static constexpr bool PERM = false, AFTER_DRAIN = false;
    const float* base; float* out;
    __device__ __forceinline__ void operator()(const pg8::f32x4 (&acc)[2][2][4][2], const pg8::Unit& u, int wr, int wc, int fr, int fq) const {
        const int row0 = u.pm * 256 + wr * 64 + fr, col0 = u.pn * 256 + wc * 32 + 4 * fq;
#pragma unroll
        for (int ai = 0; ai < 2; ++ai)
#pragma unroll
            for (int m = 0; m < 4; ++m) { const size_t off = (size_t)(row0 + ai * 128 + m * 16) * D + col0;
#pragma unroll
                for (int bj = 0; bj < 2; ++bj)
#pragma unroll
                    for (int n = 0; n < 2; ++n) { const pg8::f32x4 b = *(const pg8::f32x4*)(base + off + bj * 128 + n * 16);
                        *(pg8::f32x4*)(out + off + bj * 128 + n * 16) = b + acc[ai][bj][m][n]; } }
    }
};

__device__ __forceinline__ void transpose_item(const float* W, int K, int N, const float* gain, bf16* WT, LAS float* scr, int item, int lane) {
    const int nblk = N / 32, kb = item / nblk, nb = item % nblk, k0 = 64 * kb, n0 = 32 * nb;
#pragma unroll 8
    for (int i = 0; i < 32; ++i) { const int kk = 2 * i + (lane >> 5); float w = W[(size_t)(k0 + kk) * N + n0 + (lane & 31)]; if (gain) w *= gain[k0 + kk]; scr[kk * 33 + (lane & 31)] = w; }
    asm volatile("s_waitcnt lgkmcnt(0)" ::: "memory");
    const int c = lane & 7;
#pragma unroll
    for (int j = 0; j < 4; ++j) { const int n = (lane >> 3) + 8 * j; const LAS float* s = scr + (8 * c) * 33 + n;
        v4u o; o.x = pk2(s[0 * 33], s[1 * 33]); o.y = pk2(s[2 * 33], s[3 * 33]); o.z = pk2(s[4 * 33], s[5 * 33]); o.w = pk2(s[6 * 33], s[7 * 33]);
        *(v4u*)(WT + (size_t)(n0 + n) * K + k0 + 8 * c) = o; }
    asm volatile("s_waitcnt lgkmcnt(0)" ::: "memory");
}
__device__ __forceinline__ void norm_rows(const float* x, bf16* xn, int nrows, int gw, int ngw, int lane) {
    for (int m = gw; m < nrows; m += ngw) {
        const f32x4* xr = (const f32x4*)(x + (size_t)m * D) + lane;
        f32x4 v[4]; float s = 0.f;
#pragma unroll
        for (int j = 0; j < 4; ++j) { v[j] = xr[64 * j]; s += (v[j].x * v[j].x + v[j].y * v[j].y) + (v[j].z * v[j].z + v[j].w * v[j].w); }
        const float rstd = rsqrtf(wave_sum(s) * (1.f / D) + EPS);
        unsigned long long* o8 = (unsigned long long*)(xn + (size_t)m * D) + lane;
#pragma unroll
        for (int j = 0; j < 4; ++j) o8[64 * j] = (unsigned long long)pk2(v[j].x * rstd, v[j].y * rstd) | ((unsigned long long)pk2(v[j].z * rstd, v[j].w * rstd) << 32);
    }
}

__device__ __forceinline__ void attn_scalar(const bf16* proj, bf16* y, int TOKG, const float* qgain, const float* kgain, const float* rel_bias,
                                            unsigned char* lds, int tid, int lane, int wave, int gw, int ngw) {
    int* btab = (int*)lds;
    float* wq = (float*)(lds + 2048 + wave * 2304);
    float* wp = wq + 64;
    for (int e = tid; e < 448; e += 512) {
        int bk = -1;
        if (e < 387) { const int p = e / 129, jj = e - 129 * p, dist = jj << (2 * p);
            if (dist < 16) bk = dist; else { const float sc = logf((float)dist / 16.f) / logf(128.f); int lg = 16 + (int)(sc * 16.f); bk = lg < 31 ? lg : 31; } }
        btab[e] = bk;
    }
    __syncthreads();
    const float qgl = qgain[lane] * 0.125f, kgl = kgain[lane];
    const int nitems = TOKG * 16;
    for (int it = gw; it < nitems; it += ngw) {
        const int t = it & (SEQ - 1), bh = it >> 13, h = bh & 15, bl = bh >> 4;
        const size_t rowb = (size_t)bl * SEQ;
        const bf16* prow = proj + (rowb + t) * PW;
        const float q = bf2f(prow[3072 + h * 64 + lane]);
        const float ss = wave_sum(q * q);
        wq[lane] = q * rsqrtf(ss * (1.f / 64.f) + EPS) * qgl * kgl;
        asm volatile("s_waitcnt lgkmcnt(0)" ::: "memory");
        float lg[7]; float mx = -INFINITY;
#pragma unroll
        for (int r = 0; r < 7; ++r) {
            const int e = lane + 64 * r; const int bk = btab[e];
            const int p = e / 129, jj = e - 129 * p; const int tk = t - (jj << (2 * p));
            float l = -INFINITY;
            if (bk >= 0 && tk >= 0) {
                const v4u* kr = (const v4u*)(proj + (rowb + tk) * PW + 4096 + h * 64);
                float dot = 0.f, ks = 0.f;
#pragma unroll
                for (int c8 = 0; c8 < 8; ++c8) { float f[8]; unpack8(kr[c8], f);
#pragma unroll
                    for (int i = 0; i < 8; ++i) { dot += wq[c8 * 8 + i] * f[i]; ks += f[i] * f[i]; } }
                l = dot * rsqrtf(ks * (1.f / 64.f) + EPS) + rel_bias[bk * 16 + h];
            }
            lg[r] = l; mx = fmaxf(mx, l);
        }
        mx = wave_max(mx);
        float sum = 0.f;
#pragma unroll
        for (int r = 0; r < 7; ++r) { const float pe = (lg[r] == -INFINITY) ? 0.f : __expf(lg[r] - mx); wp[lane + 64 * r] = pe; sum += pe; }
        sum = wave_sum(sum);
        asm volatile("s_waitcnt lgkmcnt(0)" ::: "memory");
        float o = 0.f;
        const bf16* vbase = proj + rowb * PW + 5120 + h * 64 + lane;
#pragma unroll
        for (int p = 0; p < 3; ++p) {
#pragma unroll 8
            for (int jj = 0; jj <= 128; ++jj) { int tk = t - (jj << (2 * p)); const float pe = wp[p * 129 + jj]; if (tk < 0) tk = t;
                o += pe * bf2f(vbase[(size_t)tk * PW]); }
        }
        const float z = bf2f(prow[6144 + 1024 + h * 64 + lane]);
        y[(rowb + t) * MW + 1024 + h * 64 + lane] = (bf16)f2bf(o / sum * z);
    }
}
__device__ __forceinline__ void conv_scalar(const bf16* proj, bf16* y, int TOKG, const float* convw, int lane, int gw, int ngw) {
    for (int it = gw; it < TOKG; it += ngw) {
        const int t = it & (SEQ - 1); const bf16* prow = proj + (size_t)it * PW;
#pragma unroll
        for (int i = 0; i < 2; ++i) { const int c0 = lane * 8 + 512 * i;
            float acc[8] = {0.f, 0.f, 0.f, 0.f, 0.f, 0.f, 0.f, 0.f};
#pragma unroll
            for (int dt = 0; dt < 3; ++dt) { const int tt = t - 2 + dt;
                if (tt >= 0) { const bf16* pr = prow - (size_t)(2 - dt) * PW; float gc[8], xa[8];
                    unpack8(*(const v4u*)(pr + 1024 + c0), gc); unpack8(*(const v4u*)(pr + 2048 + c0), xa);
#pragma unroll
                    for (int e = 0; e < 8; ++e) acc[e] += convw[dt * 1024 + c0 + e] * (gc[e] * xa[e]); } }
            float gb[8], z[8]; unpack8(*(const v4u*)(prow + c0), gb); unpack8(*(const v4u*)(prow + 6144 + c0), z);
            v4u o; o.x = pk2(gb[0] * acc[0] * z[0], gb[1] * acc[1] * z[1]); o.y = pk2(gb[2] * acc[2] * z[2], gb[3] * acc[3] * z[3]);
            o.z = pk2(gb[4] * acc[4] * z[4], gb[5] * acc[5] * z[5]); o.w = pk2(gb[6] * acc[6] * z[6], gb[7] * acc[7] * z[7]);
            *(v4u*)(y + (size_t)it * MW + c0) = o; }
    }
}


typedef short bf16x8 __attribute__((ext_vector_type(8)));
typedef float f32x16 __attribute__((ext_vector_type(16)));
typedef __bf16 bf16x2_t __attribute__((ext_vector_type(2)));
typedef float f32x2_t __attribute__((ext_vector_type(2)));
typedef unsigned v2u __attribute__((ext_vector_type(2)));
__device__ __forceinline__ unsigned pkbf(float lo, float hi) { const f32x2_t v = {lo, hi}; const bf16x2_t b = __builtin_convertvector(v, bf16x2_t); return __builtin_bit_cast(unsigned, b); }
constexpr int ATT_KS = 0, ATT_KSTR = 144, ATT_VT = 384 * 144, ATT_VSTR = 776, ATT_BIAS = ATT_VT + 64 * 776;
__device__ __forceinline__ void attn_mfma(const bf16* proj, bf16* part, float* lse, int TOKG, const float* qgain, const float* kgain, const float* rel_bias,
                                          unsigned char* lds, int tid, int lane, int wave, int bid, int G) {
    LAS unsigned char* L = (LAS unsigned char*)lds;
    const int nunits = (TOKG / SEQ) * 16 * 96;
    const int c = lane & 31, hh = lane >> 5, c8 = tid & 7;
    float kg[8];
#pragma unroll
    for (int e = 0; e < 8; ++e) kg[e] = kgain[c8 * 8 + e];
    for (int u = bid; u < nunits; u += G) {
        const int i = u & 31, pbh = u >> 5, p = pbh % 3, bh = pbh / 3, h = bh & 15, bl = bh >> 4;
        const int dsh = 2 * p, d = 1 << dsh, r = i & (d - 1), qb = i >> dsh, m0 = qb * 256;
        const size_t rowb = (size_t)bl * SEQ;
        __syncthreads();
        if (tid < 129) { const int dist = tid << dsh; int bk;
            if (dist < 16) bk = dist; else { const float scl = logf((float)dist / 16.f) / logf(128.f); const int lg = 16 + (int)(scl * 16.f); bk = lg < 31 ? lg : 31; }
            ((LAS float*)(L + ATT_BIAS))[tid] = rel_bias[bk * 16 + h]; }
#pragma unroll 2
        for (int it = 0; it < 6; ++it) {
            const int kk = (tid + 512 * it) >> 3, m = m0 - 128 + kk;
            v4u kw = {0u, 0u, 0u, 0u}, vw = {0u, 0u, 0u, 0u};
            if (m >= 0) { const bf16* rp = proj + (rowb + ((size_t)m << dsh) + r) * PW + h * 64 + c8 * 8; kw = *(const v4u*)(rp + 4096); vw = *(const v4u*)(rp + 5120); }
            float f[8]; unpack8(kw, f); float ss = 0.f;
#pragma unroll
            for (int e = 0; e < 8; ++e) ss += f[e] * f[e];
            ss += __shfl_xor(ss, 1); ss += __shfl_xor(ss, 2); ss += __shfl_xor(ss, 4);
            const float rs = rsqrtf(ss * (1.f / 64.f) + EPS);
            v4u ko; ko.x = pkbf(f[0] * rs * kg[0], f[1] * rs * kg[1]); ko.y = pkbf(f[2] * rs * kg[2], f[3] * rs * kg[3]); ko.z = pkbf(f[4] * rs * kg[4], f[5] * rs * kg[5]); ko.w = pkbf(f[6] * rs * kg[6], f[7] * rs * kg[7]);
            *(LAS v4u*)(L + ATT_KS + kk * ATT_KSTR + c8 * 16) = ko;
            LAS unsigned short* vt = (LAS unsigned short*)(L + ATT_VT + (c8 * 8) * ATT_VSTR + kk * 2);
            vt[0 * (ATT_VSTR / 2)] = (unsigned short)(vw.x & 0xffffu); vt[1 * (ATT_VSTR / 2)] = (unsigned short)(vw.x >> 16);
            vt[2 * (ATT_VSTR / 2)] = (unsigned short)(vw.y & 0xffffu); vt[3 * (ATT_VSTR / 2)] = (unsigned short)(vw.y >> 16);
            vt[4 * (ATT_VSTR / 2)] = (unsigned short)(vw.z & 0xffffu); vt[5 * (ATT_VSTR / 2)] = (unsigned short)(vw.z >> 16);
            vt[6 * (ATT_VSTR / 2)] = (unsigned short)(vw.w & 0xffffu); vt[7 * (ATT_VSTR / 2)] = (unsigned short)(vw.w >> 16);
        }
        const size_t orow = rowb + ((size_t)(m0 + 32 * wave + c) << dsh) + r;
        bf16x8 qf[4];
        { const bf16* qp = proj + orow * PW + 3072 + h * 64 + 8 * hh; float qv[4][8]; float ss = 0.f;
#pragma unroll
            for (int s = 0; s < 4; ++s) { unpack8(*(const v4u*)(qp + 16 * s), qv[s]);
#pragma unroll
                for (int e = 0; e < 8; ++e) ss += qv[s][e] * qv[s][e]; }
            ss += __shfl_xor(ss, 32);
            const float rs = rsqrtf(ss * (1.f / 64.f) + EPS) * 0.125f;
#pragma unroll
            for (int s = 0; s < 4; ++s) { const f32x4 g0 = *(const f32x4*)(qgain + 16 * s + 8 * hh), g1 = *(const f32x4*)(qgain + 16 * s + 8 * hh + 4);
                v4u w; w.x = pkbf(qv[s][0] * rs * g0.x, qv[s][1] * rs * g0.y); w.y = pkbf(qv[s][2] * rs * g0.z, qv[s][3] * rs * g0.w);
                w.z = pkbf(qv[s][4] * rs * g1.x, qv[s][5] * rs * g1.y); w.w = pkbf(qv[s][6] * rs * g1.z, qv[s][7] * rs * g1.w); qf[s] = __builtin_bit_cast(bf16x8, w); } }
        __syncthreads();
        f32x16 sc[5];
#pragma unroll
        for (int j = 0; j < 5; ++j) {
#pragma unroll
            for (int e = 0; e < 16; ++e) sc[j][e] = 0.f;
#pragma unroll
            for (int s = 0; s < 4; ++s) { const bf16x8 kf = *(const LAS bf16x8*)(L + ATT_KS + (32 * wave + 32 * j + c) * ATT_KSTR + (16 * s + 8 * hh) * 2);
                sc[j] = __builtin_amdgcn_mfma_f32_32x32x16_bf16(kf, qf[s], sc[j], 0, 0, 0); } }
        const LAS float* bl_ = (const LAS float*)(L + ATT_BIAS);
        float mx = -INFINITY;
#pragma unroll
        for (int j = 0; j < 5; ++j)
#pragma unroll
            for (int e = 0; e < 16; ++e) { const int row = (e & 3) + 8 * (e >> 2) + 4 * hh, delta = c + 128 - 32 * j - row, kpos = m0 - 128 + 32 * wave + 32 * j + row;
                const bool ok = (delta >= 0) && (delta <= 128) && (kpos >= 0); const int di = delta < 0 ? 0 : (delta > 128 ? 128 : delta);
                const float v = ok ? sc[j][e] + bl_[di] : -INFINITY; sc[j][e] = v; mx = fmaxf(mx, v); }
        mx = fmaxf(mx, __shfl_xor(mx, 32));
        float l = 0.f;
#pragma unroll
        for (int j = 0; j < 5; ++j)
#pragma unroll
            for (int e = 0; e < 16; ++e) { const float pe = __expf(sc[j][e] - mx); sc[j][e] = pe; l += pe; }
        l += __shfl_xor(l, 32);
        f32x16 o[2];
#pragma unroll
        for (int e = 0; e < 16; ++e) { o[0][e] = 0.f; o[1][e] = 0.f; }
#pragma unroll
        for (int j = 0; j < 5; ++j)
#pragma unroll
            for (int s2 = 0; s2 < 2; ++s2) {
                v4u pw; pw.x = pkbf(sc[j][8 * s2 + 0], sc[j][8 * s2 + 1]); pw.y = pkbf(sc[j][8 * s2 + 2], sc[j][8 * s2 + 3]); pw.z = pkbf(sc[j][8 * s2 + 4], sc[j][8 * s2 + 5]); pw.w = pkbf(sc[j][8 * s2 + 6], sc[j][8 * s2 + 7]);
                const bf16x8 pf = __builtin_bit_cast(bf16x8, pw);
                const int kb = 32 * wave + 32 * j + 16 * s2 + 4 * hh;
#pragma unroll
                for (int dt = 0; dt < 2; ++dt) { const LAS unsigned char* vp = L + ATT_VT + (32 * dt + c) * ATT_VSTR + kb * 2;
                    const v2u lo = *(const LAS v2u*)vp, hi = *(const LAS v2u*)(vp + 16);
                    v4u vw4; vw4.x = lo.x; vw4.y = lo.y; vw4.z = hi.x; vw4.w = hi.y;
                    o[dt] = __builtin_amdgcn_mfma_f32_32x32x16_bf16(__builtin_bit_cast(bf16x8, vw4), pf, o[dt], 0, 0, 0); } }
        const float inv = 1.f / l;
        bf16* op = part + ((size_t)p * TOKG + orow) * 1024 + h * 64 + 4 * hh;
#pragma unroll
        for (int dt = 0; dt < 2; ++dt)
#pragma unroll
            for (int g4 = 0; g4 < 4; ++g4) { v2u w; w.x = pkbf(o[dt][4 * g4] * inv, o[dt][4 * g4 + 1] * inv); w.y = pkbf(o[dt][4 * g4 + 2] * inv, o[dt][4 * g4 + 3] * inv);
                *(v2u*)(op + 32 * dt + 8 * g4) = w; }
        if (hh == 0) lse[((size_t)p * TOKG + orow) * 16 + h] = mx + __logf(l);
    }
}
__device__ __forceinline__ void merge_conv(const bf16* proj, const bf16* part, const float* lse, bf16* y, int TOKG, const float* convw, int lane, int gw, int ngw) {
    for (int it = gw; it < TOKG; it += ngw) {
        const int t = it & (SEQ - 1); const bf16* prow = proj + (size_t)it * PW;
#pragma unroll
        for (int i = 0; i < 2; ++i) { const int c0 = lane * 8 + 512 * i;
            float acc[8] = {0.f, 0.f, 0.f, 0.f, 0.f, 0.f, 0.f, 0.f};
#pragma unroll
            for (int dt = 0; dt < 3; ++dt) { const int tt = t - 2 + dt;
                if (tt >= 0) { const bf16* pr = prow - (size_t)(2 - dt) * PW; float gc[8], xa[8];
                    unpack8(*(const v4u*)(pr + 1024 + c0), gc); unpack8(*(const v4u*)(pr + 2048 + c0), xa);
#pragma unroll
                    for (int e = 0; e < 8; ++e) acc[e] += convw[dt * 1024 + c0 + e] * (gc[e] * xa[e]); } }
            float gb[8], z[8]; unpack8(*(const v4u*)(prow + c0), gb); unpack8(*(const v4u*)(prow + 6144 + c0), z);
            v4u o; o.x = pk2(gb[0] * acc[0] * z[0], gb[1] * acc[1] * z[1]); o.y = pk2(gb[2] * acc[2] * z[2], gb[3] * acc[3] * z[3]);
            o.z = pk2(gb[4] * acc[4] * z[4], gb[5] * acc[5] * z[5]); o.w = pk2(gb[6] * acc[6] * z[6], gb[7] * acc[7] * z[7]);
            *(v4u*)(y + (size_t)it * MW + c0) = o; }
#pragma unroll
        for (int i = 0; i < 2; ++i) { const int c0 = lane * 8 + 512 * i, h = c0 >> 6;
            const float l0 = lse[((size_t)0 * TOKG + it) * 16 + h], l1 = lse[((size_t)1 * TOKG + it) * 16 + h], l2 = lse[((size_t)2 * TOKG + it) * 16 + h];
            const float mx = fmaxf(l0, fmaxf(l1, l2)); float w0 = __expf(l0 - mx), w1 = __expf(l1 - mx), w2 = __expf(l2 - mx); const float inv = 1.f / (w0 + w1 + w2); w0 *= inv; w1 *= inv; w2 *= inv;
            float a0[8], a1[8], a2[8], z[8];
            unpack8(*(const v4u*)(part + ((size_t)0 * TOKG + it) * 1024 + c0), a0); unpack8(*(const v4u*)(part + ((size_t)1 * TOKG + it) * 1024 + c0), a1); unpack8(*(const v4u*)(part + ((size_t)2 * TOKG + it) * 1024 + c0), a2);
            unpack8(*(const v4u*)(prow + 6144 + 1024 + c0), z);
            float r[8];
#pragma unroll
            for (int e = 0; e < 8; ++e) r[e] = (w0 * a0[e] + w1 * a1[e] + w2 * a2[e]) * z[e];
            v4u o; o.x = pk2(r[0], r[1]); o.y = pk2(r[2], r[3]); o.z = pk2(r[4], r[5]); o.w = pk2(r[6], r[7]);
            *(v4u*)(y + (size_t)it * MW + 1024 + c0) = o; }
    }
}

__device__ __forceinline__ void hgrn_scalar(const bf16* proj, bf16* y, int TOKG, const float* ogain, unsigned char* lds, int tid, int lane, int wave, int bid, int G) {
    float* sq = (float*)lds; float* sf = sq + 4096; float* sk = sf + 4096; float* sv = sk + 4096; float* sop = sv + 4096;
    const int nseq = (TOKG / SEQ) * 16;
    const int v = tid & 127, kq = tid >> 7;
    for (int s = bid; s < nseq; s += G) {
        const int bl = s >> 4, h = s & 15; const size_t rowb = (size_t)bl * SEQ;
        float S[32];
#pragma unroll
        for (int i = 0; i < 32; ++i) S[i] = 0.f;
        const float og0 = ogain[h * 128 + lane], og1 = ogain[h * 128 + 64 + lane];
        for (int t0 = 0; t0 < SEQ; t0 += 32) {
#pragma unroll
            for (int i = 0; i < 8; ++i) { const int idx = tid + 512 * i, tt = idx >> 7, col = idx & 127; const bf16* prow = proj + (rowb + t0 + tt) * PW + h * 128 + col;
                sq[idx] = bf2f(prow[0]); const float f = __expf(bf2f(prow[2048])); sf[idx] = f; sk[idx] = 1.f - f; sv[idx] = bf2f(prow[4096]); }
            __syncthreads();
            for (int tt = 0; tt < 32; ++tt) {
                const float vv = sv[tt * 128 + v]; float acc = 0.f;
                const f32x4* pf = (const f32x4*)(sf + tt * 128 + kq * 32); const f32x4* pk = (const f32x4*)(sk + tt * 128 + kq * 32); const f32x4* pq = (const f32x4*)(sq + tt * 128 + kq * 32);
#pragma unroll
                for (int i4 = 0; i4 < 8; ++i4) { const f32x4 f = pf[i4], k = pk[i4], q = pq[i4];
#pragma unroll
                    for (int e = 0; e < 4; ++e) { S[i4 * 4 + e] = f[e] * S[i4 * 4 + e] + k[e] * vv; acc += q[e] * S[i4 * 4 + e]; } }
                sop[(kq * 32 + tt) * 128 + v] = acc;
            }
            __syncthreads();
#pragma unroll
            for (int i2 = 0; i2 < 4; ++i2) { const int tt = wave + 8 * i2;
                float o0 = 0.f, o1 = 0.f;
#pragma unroll
                for (int k4 = 0; k4 < 4; ++k4) { o0 += sop[(k4 * 32 + tt) * 128 + lane]; o1 += sop[(k4 * 32 + tt) * 128 + 64 + lane]; }
                const float rstd = rsqrtf(wave_sum(o0 * o0 + o1 * o1) * (1.f / 128.f) + EPS);
                const bf16* prow = proj + (rowb + t0 + tt) * PW + 6144 + h * 128;
                bf16* yr = y + (rowb + t0 + tt) * MW + h * 128;
                yr[lane] = (bf16)f2bf(o0 * rstd * og0 * bf2f(prow[lane])); yr[64 + lane] = (bf16)f2bf(o1 * rstd * og1 * bf2f(prow[64 + lane])); }
            __syncthreads();
        }
    }
}

__device__ __forceinline__ unsigned long long ldptr(LAS unsigned long long* tab, int i) { asm volatile("" ::: "memory"); const unsigned long long v = tab[i];
    const unsigned lo = __builtin_amdgcn_readfirstlane((unsigned)v), hi = __builtin_amdgcn_readfirstlane((unsigned)(v >> 32)); return ((unsigned long long)hi << 32) | lo; }
struct Args { const float* in[13]; float* out; unsigned char* ws; int ngroups; int pad; };
struct Ctx { int layer, g, NG, TOKG, j, even, tid, lane, wave, G, bid, gw, ngw; unsigned char* wsb; bf16 *Wt_in, *Wt_out, *proj, *ybuf, *xn; float* lbtab; size_t row0; };
__device__ __forceinline__ Ctx load_ctx(LAS unsigned long long* ptab) {
    Ctx c; const int step = (int)ldptr(ptab, 16); c.NG = (int)ldptr(ptab, 15); c.layer = step / c.NG; c.g = step - c.layer * c.NG; c.TOKG = NTOK / c.NG; c.j = c.layer >> 1; c.even = !(c.layer & 1);
    int tid_raw = threadIdx.x; asm volatile("" : "+v"(tid_raw)); c.tid = tid_raw; c.lane = c.tid & 63; c.wave = __builtin_amdgcn_readfirstlane(c.tid >> 6);
    c.G = gridDim.x; c.bid = blockIdx.x; c.gw = c.bid * 8 + c.wave; c.ngw = c.G * 8;
    c.wsb = (unsigned char*)ldptr(ptab, 14);
    c.Wt_in = (bf16*)(c.wsb + WS_WIN); c.Wt_out = (bf16*)(c.wsb + WS_WOUT); c.lbtab = (float*)(c.wsb + WS_MISC); c.proj = (bf16*)(c.wsb + WS_PROJ);
    c.ybuf = (bf16*)(c.wsb + WS_PROJ + (size_t)c.TOKG * (PW * 2)); c.xn = (bf16*)(c.wsb + WS_PROJ + (size_t)c.TOKG * (PW * 2 + MW * 2));
    c.row0 = (size_t)c.g * c.TOKG; return c;
}
#define ARGP(i) ((const float*)ldptr(ptab, (i)))
__global__ void __launch_bounds__(512, 2) fwd(Args a) {
    extern __shared__ __attribute__((aligned(16))) unsigned char lds[];
    cg::grid_group grid = cg::this_grid();
    LAS unsigned long long* ptab = (LAS unsigned long long*)((LAS unsigned char*)lds + 131072 + 1024);
    if (threadIdx.x == 0) {
#pragma unroll
        for (int i = 0; i < 13; ++i) ptab[i] = (unsigned long long)a.in[i];
        ptab[13] = (unsigned long long)a.out; ptab[14] = (unsigned long long)a.ws; ptab[15] = (unsigned long long)a.ngroups; ptab[16] = 0ull; }
    __syncthreads();
    for (;;) {
        {
            const Ctx c = load_ctx(ptab);
            if (c.g == 0) {
                const float* w_in = (c.even ? ARGP(2) : ARGP(9)) + (size_t)c.j * D * PW;
                const float* ln = (c.even ? ARGP(1) : ARGP(8)) + (size_t)c.j * D;
                const float* w_out = (c.even ? ARGP(6) : ARGP(12)) + (size_t)c.j * MW * D;
                LAS float* scr = (LAS float*)((LAS unsigned char*)lds + c.wave * 16384);
                constexpr int I_IN = (D / 64) * (PW / 32), I_OUT = (MW / 64) * (D / 32);
                for (int it = c.gw; it < I_IN + I_OUT; it += c.ngw) {
                    if (it < I_IN) transpose_item(w_in, D, PW, ln, c.Wt_in, scr, it, c.lane);
                    else transpose_item(w_out, MW, D, nullptr, c.Wt_out, scr, it - I_IN, c.lane);
                }
                if (!c.even && c.bid == 0) { const float* lbp = ARGP(10);
                    for (int col = c.tid; col < 2048; col += 512) c.lbtab[col] = (c.j == 0) ? 0.f : 1.f / (1.f + expf(lbp[col] - lbp[2048 + col])); }
            }
            const float* xsrc = (c.layer == 0) ? ARGP(0) : ARGP(13);
            norm_rows(xsrc + c.row0 * D, c.xn, c.TOKG, c.gw, c.ngw, c.lane);
        }
        grid.sync();
        {
            const Ctx c = load_ctx(ptab);
            pg8::Gemm gm{c.xn, c.Wt_in, c.TOKG, PW, D}; pg8::StaticOrder S; S.init(c.TOKG, PW, c.G, c.bid); EpiProj E{c.proj, c.even ? 0 : 1, c.lbtab};
            pg8::gemm_phase<EpiProj, pg8::StaticOrder, true, true>((PG8_LAS unsigned char*)lds, gm, S, E);
        }
        grid.sync();
        {
            const Ctx c = load_ctx(ptab);
            if (c.even) {
                attn_mfma(c.proj, c.xn, (float*)(c.xn + (size_t)c.TOKG * 3072), c.TOKG, ARGP(4) + c.j * 64, ARGP(5) + c.j * 64, ARGP(7), lds, c.tid, c.lane, c.wave, c.bid, c.G);
            } else {
                hgrn_scalar(c.proj, c.ybuf, c.TOKG, ARGP(11) + c.j * MW, lds, c.tid, c.lane, c.wave, c.bid, c.G);
            }
        }
        grid.sync();
        {
            const Ctx c = load_ctx(ptab);
            if (c.even) merge_conv(c.proj, c.xn, (const float*)(c.xn + (size_t)c.TOKG * 3072), c.ybuf, c.TOKG, ARGP(3) + c.j * 3 * 1024, c.lane, c.gw, c.ngw);
        }
        grid.sync();
        {
            const Ctx c = load_ctx(ptab);
            const float* xsrc = (c.layer == 0) ? ARGP(0) : ARGP(13);
            pg8::Gemm gm{c.ybuf, c.Wt_out, c.TOKG, D, MW}; pg8::StaticOrder S; S.init(c.TOKG, D, c.G, c.bid); EpiRes E{xsrc + c.row0 * D, (float*)ARGP(13) + c.row0 * D};
            pg8::gemm_phase<EpiRes, pg8::StaticOrder, true, true>((PG8_LAS unsigned char*)lds, gm, S, E);
        }
        grid.sync();
        const int step = (int)ldptr(ptab, 16), nsteps = 4 * (int)ldptr(ptab, 15);
        __syncthreads();
        if (threadIdx.x == 0) ptab[16] = (unsigned long long)(step + 1);
        __syncthreads();
        if (step + 1 >= nsteps) break;
    }
}

extern "C" void kernel_launch(void* const* d_in, const int* in_sizes, int n_in, void* d_out, int out_size, void* d_ws, size_t ws_size, hipStream_t stream) {
    static int grid = 0;
    if (grid == 0) {
        int dev = 0, cus = 0, per_cu = 0;
        if (hipGetDevice(&dev) != hipSuccess || hipDeviceGetAttribute(&cus, hipDeviceAttributeMultiprocessorCount, dev) != hipSuccess) { fprintf(stderr, "kernel_launch: device query failed\n"); grid = -1; return; }
        if (hipFuncSetAttribute((const void*)fwd, hipFuncAttributeMaxDynamicSharedMemorySize, LDS_BYTES) != hipSuccess) { fprintf(stderr, "kernel_launch: hipFuncSetAttribute failed\n"); grid = -1; return; }
        if (hipOccupancyMaxActiveBlocksPerMultiprocessor(&per_cu, (const void*)fwd, 512, LDS_BYTES) != hipSuccess || per_cu < 1) fprintf(stderr, "kernel_launch: occupancy query reports %d\n", per_cu);
        (void)hipGetLastError();
        grid = cus;
    }
    if (grid < 0) return;
    Args a{};
    for (int i = 0; i < 13; ++i) a.in[i] = (const float*)d_in[i];
    a.out = (float*)d_out; a.ws = (unsigned char*)d_ws;
    a.ngroups = (ws_size >= (size_t)472 * MiB) ? 2 : 4;
    void* args[] = {&a};
    hipError_t e = hipLaunchCooperativeKernel((const void*)fwd, dim3(grid), dim3(512), args, LDS_BYTES, stream);
    if (e != hipSuccess) fprintf(stderr, "kernel_launch: cooperative launch failed: %s (grid %d)\n", hipGetErrorString(e), grid);
}
```

```cpp
#include <hip/hip_runtime.h>
#include <hip/hip_cooperative_groups.h>
#include <cstdio>
#include <cstdint>
namespace cg = cooperative_groups;
namespace pg8 {
#define PG8_LAS __attribute__((address_space(3)))
typedef unsigned short bf16_t;
typedef short bf16x8 __attribute__((ext_vector_type(8)));
typedef float f32x4 __attribute__((ext_vector_type(4)));
typedef unsigned u32x4 __attribute__((ext_vector_type(4)));
constexpr int BM = 256, BK = 64, HALF = 128, HTB = HALF * BK * 2  , STAGE_BYTES = 8 * HTB, NXCD = 8, WGM = 8;

__host__ __device__ __forceinline__ int lds_byte(int r, int c) { const int st = (r >> 4) * 2 + (c >> 5), rr = r & 15, cc = c & 31, ob = rr * 64 + cc * 2; return st * 1024 + (ob ^ (((ob >> 9) & 1) << 5)); }
__host__ __device__ __forceinline__ void stage_rc(int b, int& R, int& C) { const int st = b / 1024, sb = b % 1024, swz = sb ^ (((sb >> 9) & 1) << 5); R = (st >> 1) * 16 + swz / 64; C = (st & 1) * 32 + (swz % 64) / 2; }
__host__ __device__ __forceinline__ int perm32(int rho) { const int n = rho >> 4, i = rho & 15; return 8 * (i >> 2) + 4 * n + (i & 3); }

struct Unit { int pm, pn; };
struct Gemm { const bf16_t* A; const bf16_t* Bt; int M, N, K; };

struct StaticOrder {
    int nM, nN, nwg, G, c;
    __host__ __device__ void init(int M, int N, int G_, int c_) { nM = M / BM; nN = N / BM; nwg = nM * nN; G = G_; c = c_; }
    __host__ __device__ bool next(int i, Unit& u) const {
        const long L = (long)i * G + c; if (L >= nwg) return false;
        int wgid = (int)L; { const int q = nwg / NXCD, r = nwg % NXCD, xcd = wgid % NXCD, off = wgid / NXCD; wgid = (xcd < r ? xcd * (q + 1) : r * (q + 1) + (xcd - r) * q) + off; }
        const int nig = WGM * nN, gid = wgid / nig, fm = gid * WGM, gsz = (nM - fm) < WGM ? (nM - fm) : WGM;
        u.pm = fm + ((wgid % nig) % gsz); u.pn = (wgid % nig) / gsz; return true;
    }
    __device__ __forceinline__ void a_ready(const Unit&) const {}
    __device__ __forceinline__ void done(const Unit&) const {}
};

__device__ __forceinline__ unsigned cvt_pk_bf16(float lo, float hi) { unsigned r; asm volatile("v_cvt_pk_bf16_f32 %0, %1, %2" : "=v"(r) : "v"(lo), "v"(hi)); return r; }
template <class Epi, class Sched, bool ALIGN_EPI = false, bool SP2 = false>
__device__ __forceinline__ void gemm_phase(PG8_LAS unsigned char* lds, const Gemm g, const Sched& S, const Epi& E) {
    int tid_raw = threadIdx.x; asm volatile("" : "+v"(tid_raw)); const int tid = tid_raw, wid = __builtin_amdgcn_readfirstlane(tid >> 6), lane = tid & 63, wr = wid >> 2, wc = wid & 3, fr = lane & 15, fq = lane >> 4;
    const int K = g.K, nt = K / BK;
    unsigned voffA[2], voffB[2];
#pragma unroll
    for (int i = 0; i < 2; ++i) { int R, C; stage_rc(tid * 16 + i * 8192, R, C); const int Rb = Epi::PERM ? ((R & ~31) + perm32(R & 31)) : R;
        voffA[i] = (unsigned)(R * K + C) * 2u; voffB[i] = (unsigned)(Rb * K + C) * 2u; }
    const size_t kstep = (size_t)(BK * 2);
    const size_t hstep = (size_t)HALF * K * 2;
    const size_t tstep = 2 * hstep;
    const unsigned ldsw = (unsigned)wid * 1024u;
    const int aoff = lds_byte(wr * 64 + fr, fq * 8), boff = lds_byte(wc * 32 + fr, fq * 8);
#define PG8_SA(b, h) (((b) * 2 + (h)) * HTB)
#define PG8_SB(b, h) ((4 + (b) * 2 + (h)) * HTB)
#define PG8_STAGE(bufoff, gbase, voff) do { _Pragma("unroll") for (int _i = 0; _i < 2; ++_i) \
        __builtin_amdgcn_global_load_lds((const unsigned*)((const char*)(gbase) + (voff)[_i]), (PG8_LAS unsigned*)(lds + (bufoff) + ldsw + _i * 8192), 16, 0, 0); } while (0)
#define PG8_LDA(dst, b, h) do { _Pragma("unroll") for (int m = 0; m < 4; ++m) _Pragma("unroll") for (int k = 0; k < 2; ++k) dst[m][k] = *(const PG8_LAS bf16x8*)(lds + PG8_SA(b, h) + aoff + m * 2048 + k * 1024); } while (0)
#define PG8_LDB(dst, b, h) do { _Pragma("unroll") for (int n = 0; n < 2; ++n) _Pragma("unroll") for (int k = 0; k < 2; ++k) dst[n][k] = *(const PG8_LAS bf16x8*)(lds + PG8_SB(b, h) + boff + n * 2048 + k * 1024); } while (0)
#define PG8_MMA(ai, bj, At, Bt) do { __builtin_amdgcn_s_setprio(1); _Pragma("unroll") for (int m = 0; m < 4; ++m) _Pragma("unroll") for (int n = 0; n < 2; ++n) _Pragma("unroll") for (int k = 0; k < 2; ++k) \
        acc[ai][bj][m][n] = __builtin_amdgcn_mfma_f32_16x16x32_bf16(Bt[n][k], At[m][k], acc[ai][bj][m][n], 0, 0, 0); __builtin_amdgcn_s_setprio(0); } while (0)
#define PG8_WAIT_V(n) asm volatile("s_waitcnt vmcnt(" #n ")" ::: "memory")
#define PG8_WAIT_L(n) asm volatile("s_waitcnt lgkmcnt(" #n ")" ::: "memory")
#define PG8_BAR __builtin_amdgcn_s_barrier()
#define PG8_SCHED __builtin_amdgcn_sched_barrier(0)
    Unit cur, nxt; int ui = 0;
    if (!S.next(0, cur)) return;
    f32x4 acc[2][2][4][2];
#pragma unroll
    for (int a = 0; a < 2; ++a)
#pragma unroll
        for (int b = 0; b < 2; ++b)
#pragma unroll
            for (int m = 0; m < 4; ++m)
#pragma unroll
                for (int n = 0; n < 2; ++n) acc[a][b][m][n] = (f32x4){0.f, 0.f, 0.f, 0.f};
    bf16x8 At[4][2], B0[2][2], B1[2][2];
    const char* cA = (const char*)g.A + (size_t)cur.pm * tstep; const char* cB = (const char*)g.Bt + (size_t)cur.pn * tstep;
    S.a_ready(cur);
    if constexpr (SP2) {
        PG8_STAGE(PG8_SB(0, 0), cB, voffB); PG8_STAGE(PG8_SB(0, 1), cB + hstep, voffB); PG8_STAGE(PG8_SA(0, 0), cA, voffA); PG8_STAGE(PG8_SA(0, 1), cA + hstep, voffA);
        if (wr == 1) PG8_BAR;
        PG8_WAIT_V(2); PG8_BAR;
        PG8_STAGE(PG8_SB(1, 0), cB + kstep, voffB); PG8_STAGE(PG8_SA(1, 0), cA + kstep, voffA); PG8_STAGE(PG8_SB(1, 1), cB + hstep + kstep, voffB);
        PG8_WAIT_V(6); PG8_BAR;
    } else {
        PG8_STAGE(PG8_SB(0, 0), cB, voffB); PG8_STAGE(PG8_SA(0, 0), cA, voffA); PG8_STAGE(PG8_SB(0, 1), cB + hstep, voffB); PG8_STAGE(PG8_SA(0, 1), cA + hstep, voffA);
        if (wr == 1) PG8_BAR;
        PG8_WAIT_V(4); PG8_BAR;
        PG8_STAGE(PG8_SB(1, 0), cB + kstep, voffB); PG8_STAGE(PG8_SA(1, 0), cA + kstep, voffA); PG8_STAGE(PG8_SB(1, 1), cB + hstep + kstep, voffB);
        PG8_WAIT_V(6); PG8_BAR;
    }
    for (;;) {
        const bool has_next = S.next(ui + 1, nxt);
        const char* nA = has_next ? (const char*)g.A + (size_t)nxt.pm * tstep : cA; const char* nB = has_next ? (const char*)g.Bt + (size_t)nxt.pn * tstep : cB;
        for (int t = 0; t < nt; t += 2) {
            const bool last = (t == nt - 2);
            const char* a1 = cA + (size_t)(t + 1) * kstep;
            const char* a2 = last ? nA : cA + (size_t)(t + 2) * kstep; const char* b2 = last ? nB : cB + (size_t)(t + 2) * kstep;
            const char* a3 = a2 + kstep; const char* b3 = b2 + kstep;
            if (last && has_next) S.a_ready(nxt);
            if constexpr (SP2) {
            PG8_LDB(B0, 0, 0); PG8_LDB(B1, 0, 1); PG8_SCHED; PG8_LDA(At, 0, 0); PG8_STAGE(PG8_SA(1, 1), a1 + hstep, voffA);
            PG8_WAIT_V(8); PG8_WAIT_L(0); PG8_BAR; PG8_MMA(0, 0, At, B0); PG8_MMA(0, 1, At, B1); PG8_BAR; PG8_SCHED;
            PG8_LDA(At, 0, 1); PG8_STAGE(PG8_SB(0, 0), b2, voffB); PG8_STAGE(PG8_SB(0, 1), b2 + hstep, voffB); PG8_STAGE(PG8_SA(0, 0), a2, voffA);
            PG8_WAIT_V(8); PG8_WAIT_L(0); PG8_BAR; PG8_MMA(1, 0, At, B0); PG8_MMA(1, 1, At, B1); PG8_BAR; PG8_SCHED;
            PG8_LDB(B0, 1, 0); PG8_LDB(B1, 1, 1); PG8_SCHED; PG8_LDA(At, 1, 0); PG8_STAGE(PG8_SA(0, 1), a2 + hstep, voffA);
            PG8_WAIT_V(8); PG8_WAIT_L(0); PG8_BAR; PG8_MMA(0, 0, At, B0); PG8_MMA(0, 1, At, B1); PG8_BAR; PG8_SCHED;
            PG8_LDA(At, 1, 1); PG8_STAGE(PG8_SB(1, 0), b3, voffB); PG8_STAGE(PG8_SB(1, 1), b3 + hstep, voffB); PG8_STAGE(PG8_SA(1, 0), a3, voffA);
            PG8_WAIT_V(8); PG8_WAIT_L(0); PG8_BAR; PG8_MMA(1, 0, At, B0); PG8_MMA(1, 1, At, B1); PG8_BAR; PG8_SCHED;
            } else {
            PG8_LDB(B0, 0, 0); PG8_SCHED; PG8_LDA(At, 0, 0); PG8_STAGE(PG8_SA(1, 1), a1 + hstep, voffA);
            PG8_WAIT_L(8); PG8_BAR; PG8_WAIT_L(0); PG8_MMA(0, 0, At, B0); PG8_BAR; PG8_SCHED;
            PG8_LDB(B1, 0, 1); PG8_STAGE(PG8_SB(0, 0), b2, voffB);
            PG8_BAR; PG8_WAIT_L(0); PG8_MMA(0, 1, At, B1); PG8_BAR;
            PG8_LDA(At, 0, 1); PG8_STAGE(PG8_SA(0, 0), a2, voffA);
            PG8_BAR; PG8_WAIT_L(0); PG8_MMA(1, 0, At, B0); PG8_BAR; PG8_SCHED;
            PG8_STAGE(PG8_SB(0, 1), b2 + hstep, voffB);
            PG8_WAIT_V(6); PG8_BAR; PG8_MMA(1, 1, At, B1); PG8_BAR;
            PG8_LDB(B0, 1, 0); PG8_SCHED; PG8_LDA(At, 1, 0); PG8_STAGE(PG8_SA(0, 1), a2 + hstep, voffA);
            PG8_WAIT_L(8); PG8_BAR; PG8_WAIT_L(0); PG8_MMA(0, 0, At, B0); PG8_BAR; PG8_SCHED;
            PG8_LDB(B1, 1, 1); PG8_STAGE(PG8_SB(1, 0), b3, voffB);
            PG8_BAR; PG8_WAIT_L(0); PG8_MMA(0, 1, At, B1); PG8_BAR;
            PG8_LDA(At, 1, 1); PG8_STAGE(PG8_SA(1, 0), a3, voffA);
            PG8_BAR; PG8_WAIT_L(0); PG8_MMA(1, 0, At, B0); PG8_BAR; PG8_SCHED;
            PG8_STAGE(PG8_SB(1, 1), b3 + hstep, voffB);
            PG8_WAIT_V(6); PG8_BAR; PG8_MMA(1, 1, At, B1); PG8_BAR;
            }
        }
        if constexpr (ALIGN_EPI) { if (wr == 0) PG8_BAR; }
        if constexpr (!Epi::AFTER_DRAIN) { E(acc, cur, wr, wc, fr, fq); S.done(cur); }
        if (!has_next) break;
#pragma unroll
        for (int a = 0; a < 2; ++a)
#pragma unroll
            for (int b = 0; b < 2; ++b)
#pragma unroll
                for (int m = 0; m < 4; ++m)
#pragma unroll
                    for (int n = 0; n < 2; ++n) acc[a][b][m][n] = (f32x4){0.f, 0.f, 0.f, 0.f};
        cur = nxt; cA = nA; cB = nB; ++ui;
        if constexpr (ALIGN_EPI) { if (wr == 1) PG8_BAR; }
    }
    PG8_WAIT_V(0);
    if constexpr (!ALIGN_EPI) { if (wr == 0) PG8_BAR; }
    PG8_BAR;
    if constexpr (Epi::AFTER_DRAIN) { E.fused(acc, cur, wr, wc, fr, fq, lds, wid, lane); S.done(cur); }
#undef PG8_SA
#undef PG8_SB
#undef PG8_STAGE
#undef PG8_LDA
#undef PG8_LDB
#undef PG8_MMA
#undef PG8_WAIT_V
#undef PG8_WAIT_L
#undef PG8_BAR
#undef PG8_SCHED
}
}

constexpr int D = 1024, SEQ = 8192, NBATCH = 4, NTOK = NBATCH * SEQ, PW = 8192, MW = 2048;
constexpr float EPS = 1e-6f;
constexpr size_t MiB = 1u << 20;
constexpr size_t WS_WIN = 0, WS_WOUT = 16 * MiB, WS_MISC = 20 * MiB, WS_PROJ = 24 * MiB;
constexpr int LDS_BYTES = 147456;
typedef unsigned short bf16;
typedef unsigned v4u __attribute__((ext_vector_type(4)));
typedef float f32x4 __attribute__((ext_vector_type(4)));
#define LAS __attribute__((address_space(3)))

__device__ __forceinline__ float bf2f(unsigned short b) { return __uint_as_float(((unsigned)b) << 16); }
__device__ __forceinline__ unsigned f2bf(float f) { unsigned u = __float_as_uint(f); return (u + 0x7fffu + ((u >> 16) & 1u)) >> 16; }
__device__ __forceinline__ unsigned pk2(float lo, float hi) { return f2bf(lo) | (f2bf(hi) << 16); }
__device__ __forceinline__ float wave_sum(float v) {
#pragma unroll
    for (int o = 1; o < 64; o <<= 1) v += __shfl_xor(v, o);
    return v;
}
__device__ __forceinline__ float wave_max(float v) {
#pragma unroll
    for (int o = 1; o < 64; o <<= 1) v = fmaxf(v, __shfl_xor(v, o));
    return v;
}
__device__ __forceinline__ float silu_f(float x) { return x / (1.f + __expf(-x)); }
__device__ __forceinline__ void unpack8(const v4u w, float (&f)[8]) {
    f[0] = __uint_as_float(w.x << 16); f[1] = __uint_as_float(w.x & 0xffff0000u);
    f[2] = __uint_as_float(w.y << 16); f[3] = __uint_as_float(w.y & 0xffff0000u);
    f[4] = __uint_as_float(w.z << 16); f[5] = __uint_as_float(w.z & 0xffff0000u);
    f[6] = __uint_as_float(w.w << 16); f[7] = __uint_as_float(w.w & 0xffff0000u);
}

struct EpiProj {
    static constexpr bool PERM = true, AFTER_DRAIN = false;
    pg8::bf16_t* O; int odd; const float* lb;
    __device__ __forceinline__ void operator()(const pg8::f32x4 (&acc)[2][2][4][2], const pg8::Unit& u, int wr, int wc, int fr, int fq) const {
        const int row0 = u.pm * 256 + wr * 64 + fr, col0 = u.pn * 256 + wc * 32 + 8 * fq;
        int act;
        if (!odd) act = (u.pn >= 24) ? 1 : 0; else act = (u.pn < 8) ? 1 : (u.pn < 16 ? 2 : (u.pn < 24 ? 0 : 1));
        pg8::f32x4 lbv[2][2];
#pragma unroll
        for (int bj = 0; bj < 2; ++bj)
#pragma unroll
            for (int n = 0; n < 2; ++n) lbv[bj][n] = (act == 2) ? *(const pg8::f32x4*)(lb + (col0 - 2048) + bj * 128 + 4 * n) : (pg8::f32x4){0.f, 0.f, 0.f, 0.f};
#pragma unroll
        for (int ai = 0; ai < 2; ++ai)
#pragma unroll
            for (int m = 0; m < 4; ++m) { pg8::bf16_t* rowp = O + (size_t)(row0 + ai * 128 + m * 16) * PW + col0;
#pragma unroll
                for (int bj = 0; bj < 2; ++bj) { pg8::f32x4 v0 = acc[ai][bj][m][0], v1 = acc[ai][bj][m][1];
                    if (act == 1) {
#pragma unroll
                        for (int e = 0; e < 4; ++e) { v0[e] = silu_f(v0[e]); v1[e] = silu_f(v1[e]); } }
                    else if (act == 2) {
#pragma unroll
                        for (int e = 0; e < 4; ++e) { const float s0 = 1.f / (1.f + __expf(-v0[e])), s1 = 1.f / (1.f + __expf(-v1[e]));
                            v0[e] = __logf(lbv[bj][0][e] + (1.f - lbv[bj][0][e]) * s0); v1[e] = __logf(lbv[bj][1][e] + (1.f - lbv[bj][1][e]) * s1); } }
                    pg8::u32x4 w; w.x = pg8::cvt_pk_bf16(v0[0], v0[1]); w.y = pg8::cvt_pk_bf16(v0[2], v0[3]); w.z = pg8::cvt_pk_bf16(v1[0], v1[1]); w.w = pg8::cvt_pk_bf16(v1[2], v1[3]);
                    *(pg8::u32x4*)(rowp + bj * 128) = w; } }
    }
};
struct EpiRes {
    static constexpr bool PERM = false, AFTER_DRAIN = false;
    const float* base; float* out;
    __device__ __forceinline__ void operator()(const pg8::f32x4 (&acc)[2][2][4][2], const pg8::Unit& u, int wr, int wc, int fr, int fq) const {
        const int row0 = u.pm * 256 + wr * 64 + fr, col0 = u.pn * 256 + wc * 32 + 4 * fq;
#pragma unroll
        for (int ai = 0; ai < 2; ++ai)
#pragma unroll
            for (int m = 0; m < 4; ++m) { const size_t off = (size_t)(row0 + ai * 128 + m * 16) * D + col0;
#pragma unroll
                for (int bj = 0; bj < 2; ++bj)
#pragma unroll
                    for (int n = 0; n < 2; ++n) { const pg8::f32x4 b = *(const pg8::f32x4*)(base + off + bj * 128 + n * 16);
                        *(pg8::f32x4*)(out + off + bj * 128 + n * 16) = b + acc[ai][bj][m][n]; } }
    }
};

__device__ __forceinline__ void transpose_item(const float* W, int K, int N, const float* gain, bf16* WT, LAS float* scr, int item, int lane) {
    const int nblk = N / 32, kb = item / nblk, nb = item % nblk, k0 = 64 * kb, n0 = 32 * nb;
#pragma unroll 8
    for (int i = 0; i < 32; ++i) { const int kk = 2 * i + (lane >> 5); float w = W[(size_t)(k0 + kk) * N + n0 + (lane & 31)]; if (gain) w *= gain[k0 + kk]; scr[kk * 33 + (lane & 31)] = w; }
    asm volatile("s_waitcnt lgkmcnt(0)" ::: "memory");
    const int c = lane & 7;
#pragma unroll
    for (int j = 0; j < 4; ++j) { const int n = (lane >> 3) + 8 * j; const LAS float* s = scr + (8 * c) * 33 + n;
        v4u o; o.x = pk2(s[0 * 33], s[1 * 33]); o.y = pk2(s[2 * 33], s[3 * 33]); o.z = pk2(s[4 * 33], s[5 * 33]); o.w = pk2(s[6 * 33], s[7 * 33]);
        *(v4u*)(WT + (size_t)(n0 + n) * K + k0 + 8 * c) = o; }
    asm volatile("s_waitcnt lgkmcnt(0)" ::: "memory");
}
__device__ __forceinline__ void norm_rows(const float* x, bf16* xn, int nrows, int gw, int ngw, int lane) {
    for (int m = gw; m < nrows; m += ngw) {
        const f32x4* xr = (const f32x4*)(x + (size_t)m * D) + lane;
        f32x4 v[4]; float s = 0.f;
#pragma unroll
        for (int j = 0; j < 4; ++j) { v[j] = xr[64 * j]; s += (v[j].x * v[j].x + v[j].y * v[j].y) + (v[j].z * v[j].z + v[j].w * v[j].w); }
        const float rstd = rsqrtf(wave_sum(s) * (1.f / D) + EPS);
        unsigned long long* o8 = (unsigned long long*)(xn + (size_t)m * D) + lane;
#pragma unroll
        for (int j = 0; j < 4; ++j) o8[64 * j] = (unsigned long long)pk2(v[j].x * rstd, v[j].y * rstd) | ((unsigned long long)pk2(v[j].z * rstd, v[j].w * rstd) << 32);
    }
}

__device__ __forceinline__ void attn_scalar(const bf16* proj, bf16* y, int TOKG, const float* qgain, const float* kgain, const float* rel_bias,
                                            unsigned char* lds, int tid, int lane, int wave, int gw, int ngw) {
    int* btab = (int*)lds;
    float* wq = (float*)(lds + 2048 + wave * 2304);
    float* wp = wq + 64;
    for (int e = tid; e < 448; e += 512) {
        int bk = -1;
        if (e < 387) { const int p = e / 129, jj = e - 129 * p, dist = jj << (2 * p);
            if (dist < 16) bk = dist; else { const float sc = logf((float)dist / 16.f) / logf(128.f); int lg = 16 + (int)(sc * 16.f); bk = lg < 31 ? lg : 31; } }
        btab[e] = bk;
    }
    __syncthreads();
    const float qgl = qgain[lane] * 0.125f, kgl = kgain[lane];
    const int nitems = TOKG * 16;
    for (int it = gw; it < nitems; it += ngw) {
        const int t = it & (SEQ - 1), bh = it >> 13, h = bh & 15, bl = bh >> 4;
        const size_t rowb = (size_t)bl * SEQ;
        const bf16* prow = proj + (rowb + t) * PW;
        const float q = bf2f(prow[3072 + h * 64 + lane]);
        const float ss = wave_sum(q * q);
        wq[lane] = q * rsqrtf(ss * (1.f / 64.f) + EPS) * qgl * kgl;
        asm volatile("s_waitcnt lgkmcnt(0)" ::: "memory");
        float lg[7]; float mx = -INFINITY;
#pragma unroll
        for (int r = 0; r < 7; ++r) {
            const int e = lane + 64 * r; const int bk = btab[e];
            const int p = e / 129, jj = e - 129 * p; const int tk = t - (jj << (2 * p));
            float l = -INFINITY;
            if (bk >= 0 && tk >= 0) {
                const v4u* kr = (const v4u*)(proj + (rowb + tk) * PW + 4096 + h * 64);
                float dot = 0.f, ks = 0.f;
#pragma unroll
                for (int c8 = 0; c8 < 8; ++c8) { float f[8]; unpack8(kr[c8], f);
#pragma unroll
                    for (int i = 0; i < 8; ++i) { dot += wq[c8 * 8 + i] * f[i]; ks += f[i] * f[i]; } }
                l = dot * rsqrtf(ks * (1.f / 64.f) + EPS) + rel_bias[bk * 16 + h];
            }
            lg[r] = l; mx = fmaxf(mx, l);
        }
        mx = wave_max(mx);
        float sum = 0.f;
#pragma unroll
        for (int r = 0; r < 7; ++r) { const float pe = (lg[r] == -INFINITY) ? 0.f : __expf(lg[r] - mx); wp[lane + 64 * r] = pe; sum += pe; }
        sum = wave_sum(sum);
        asm volatile("s_waitcnt lgkmcnt(0)" ::: "memory");
        float o = 0.f;
        const bf16* vbase = proj + rowb * PW + 5120 + h * 64 + lane;
#pragma unroll
        for (int p = 0; p < 3; ++p) {
#pragma unroll 8
            for (int jj = 0; jj <= 128; ++jj) { int tk = t - (jj << (2 * p)); const float pe = wp[p * 129 + jj]; if (tk < 0) tk = t;
                o += pe * bf2f(vbase[(size_t)tk * PW]); }
        }
        const float z = bf2f(prow[6144 + 1024 + h * 64 + lane]);
        y[(rowb + t) * MW + 1024 + h * 64 + lane] = (bf16)f2bf(o / sum * z);
    }
}
__device__ __forceinline__ void conv_scalar(const bf16* proj, bf16* y, int TOKG, const float* convw, int lane, int gw, int ngw) {
    for (int it = gw; it < TOKG; it += ngw) {
        const int t = it & (SEQ - 1); const bf16* prow = proj + (size_t)it * PW;
#pragma unroll
        for (int i = 0; i < 2; ++i) { const int c0 = lane * 8 + 512 * i;
            float acc[8] = {0.f, 0.f, 0.f, 0.f, 0.f, 0.f, 0.f, 0.f};
#pragma unroll
            for (int dt = 0; dt < 3; ++dt) { const int tt = t - 2 + dt;
                if (tt >= 0) { const bf16* pr = prow - (size_t)(2 - dt) * PW; float gc[8], xa[8];
                    unpack8(*(const v4u*)(pr + 1024 + c0), gc); unpack8(*(const v4u*)(pr + 2048 + c0), xa);
#pragma unroll
                    for (int e = 0; e < 8; ++e) acc[e] += convw[dt * 1024 + c0 + e] * (gc[e] * xa[e]); } }
            float gb[8], z[8]; unpack8(*(const v4u*)(prow + c0), gb); unpack8(*(const v4u*)(prow + 6144 + c0), z);
            v4u o; o.x = pk2(gb[0] * acc[0] * z[0], gb[1] * acc[1] * z[1]); o.y = pk2(gb[2] * acc[2] * z[2], gb[3] * acc[3] * z[3]);
            o.z = pk2(gb[4] * acc[4] * z[4], gb[5] * acc[5] * z[5]); o.w = pk2(gb[6] * acc[6] * z[6], gb[7] * acc[7] * z[7]);
            *(v4u*)(y + (size_t)it * MW + c0) = o; }
    }
}


typedef short bf16x8 __attribute__((ext_vector_type(8)));
typedef float f32x16 __attribute__((ext_vector_type(16)));
typedef __bf16 bf16x2_t __attribute__((ext_vector_type(2)));
typedef float f32x2_t __attribute__((ext_vector_type(2)));
typedef unsigned v2u __attribute__((ext_vector_type(2)));
__device__ __forceinline__ unsigned pkbf(float lo, float hi) { const f32x2_t v = {lo, hi}; const bf16x2_t b = __builtin_convertvector(v, bf16x2_t); return __builtin_bit_cast(unsigned, b); }
constexpr int ATT_KS = 0, ATT_KSTR = 144, ATT_VT = 384 * 144, ATT_VSTR = 776, ATT_BIAS = ATT_VT + 64 * 776;
__device__ __forceinline__ void attn_mfma(const bf16* proj, bf16* part, float* lse, int TOKG, const float* qgain, const float* kgain, const float* rel_bias,
                                          unsigned char* lds, int tid, int lane, int wave, int bid, int G) {
    LAS unsigned char* L = (LAS unsigned char*)lds;
    const int nunits = (TOKG / SEQ) * 16 * 96;
    const int c = lane & 31, hh = lane >> 5, c8 = tid & 7;
    float kg[8];
#pragma unroll
    for (int e = 0; e < 8; ++e) kg[e] = kgain[c8 * 8 + e];
    for (int u = bid; u < nunits; u += G) {
        const int i = u & 31, pbh = u >> 5, p = pbh % 3, bh = pbh / 3, h = bh & 15, bl = bh >> 4;
        const int dsh = 2 * p, d = 1 << dsh, r = i & (d - 1), qb = i >> dsh, m0 = qb * 256;
        const size_t rowb = (size_t)bl * SEQ;
        __syncthreads();
        if (tid < 129) { const int dist = tid << dsh; int bk;
            if (dist < 16) bk = dist; else { const float scl = logf((float)dist / 16.f) / logf(128.f); const int lg = 16 + (int)(scl * 16.f); bk = lg < 31 ? lg : 31; }
            ((LAS float*)(L + ATT_BIAS))[tid] = rel_bias[bk * 16 + h]; }
#pragma unroll 2
        for (int it = 0; it < 6; ++it) {
            const int kk = (tid + 512 * it) >> 3, m = m0 - 128 + kk;
            v4u kw = {0u, 0u, 0u, 0u}, vw = {0u, 0u, 0u, 0u};
            if (m >= 0) { const bf16* rp = proj + (rowb + ((size_t)m << dsh) + r) * PW + h * 64 + c8 * 8; kw = *(const v4u*)(rp + 4096); vw = *(const v4u*)(rp + 5120); }
            float f[8]; unpack8(kw, f); float ss = 0.f;
#pragma unroll
            for (int e = 0; e < 8; ++e) ss += f[e] * f[e];
            ss += __shfl_xor(ss, 1); ss += __shfl_xor(ss, 2); ss += __shfl_xor(ss, 4);
            const float rs = rsqrtf(ss * (1.f / 64.f) + EPS);
            v4u ko; ko.x = pkbf(f[0] * rs * kg[0], f[1] * rs * kg[1]); ko.y = pkbf(f[2] * rs * kg[2], f[3] * rs * kg[3]); ko.z = pkbf(f[4] * rs * kg[4], f[5] * rs * kg[5]); ko.w = pkbf(f[6] * rs * kg[6], f[7] * rs * kg[7]);
            *(LAS v4u*)(L + ATT_KS + kk * ATT_KSTR + c8 * 16) = ko;
            LAS unsigned short* vt = (LAS unsigned short*)(L + ATT_VT + (c8 * 8) * ATT_VSTR + kk * 2);
            vt[0 * (ATT_VSTR / 2)] = (unsigned short)(vw.x & 0xffffu); vt[1 * (ATT_VSTR / 2)] = (unsigned short)(vw.x >> 16);
            vt[2 * (ATT_VSTR / 2)] = (unsigned short)(vw.y & 0xffffu); vt[3 * (ATT_VSTR / 2)] = (unsigned short)(vw.y >> 16);
            vt[4 * (ATT_VSTR / 2)] = (unsigned short)(vw.z & 0xffffu); vt[5 * (ATT_VSTR / 2)] = (unsigned short)(vw.z >> 16);
            vt[6 * (ATT_VSTR / 2)] = (unsigned short)(vw.w & 0xffffu); vt[7 * (ATT_VSTR / 2)] = (unsigned short)(vw.w >> 16);
        }
        const size_t orow = rowb + ((size_t)(m0 + 32 * wave + c) << dsh) + r;
        bf16x8 qf[4];
        { const bf16* qp = proj + orow * PW + 3072 + h * 64 + 8 * hh; float qv[4][8]; float ss = 0.f;
#pragma unroll
            for (int s = 0; s < 4; ++s) { unpack8(*(const v4u*)(qp + 16 * s), qv[s]);
#pragma unroll
                for (int e = 0; e < 8; ++e) ss += qv[s][e] * qv[s][e]; }
            ss += __shfl_xor(ss, 32);
            const float rs = rsqrtf(ss * (1.f / 64.f) + EPS) * 0.125f;
#pragma unroll
            for (int s = 0; s < 4; ++s) { const f32x4 g0 = *(const f32x4*)(qgain + 16 * s + 8 * hh), g1 = *(const f32x4*)(qgain + 16 * s + 8 * hh + 4);
                v4u w; w.x = pkbf(qv[s][0] * rs * g0.x, qv[s][1] * rs * g0.y); w.y = pkbf(qv[s][2] * rs * g0.z, qv[s][3] * rs * g0.w);
                w.z = pkbf(qv[s][4] * rs * g1.x, qv[s][5] * rs * g1.y); w.w = pkbf(qv[s][6] * rs * g1.z, qv[s][7] * rs * g1.w); qf[s] = __builtin_bit_cast(bf16x8, w); } }
        __syncthreads();
        f32x16 sc[5];
#pragma unroll
        for (int j = 0; j < 5; ++j) {
#pragma unroll
            for (int e = 0; e < 16; ++e) sc[j][e] = 0.f;
#pragma unroll
            for (int s = 0; s < 4; ++s) { const bf16x8 kf = *(const LAS bf16x8*)(L + ATT_KS + (32 * wave + 32 * j + c) * ATT_KSTR + (16 * s + 8 * hh) * 2);
                sc[j] = __builtin_amdgcn_mfma_f32_32x32x16_bf16(kf, qf[s], sc[j], 0, 0, 0); } }
        const LAS float* bl_ = (const LAS float*)(L + ATT_BIAS);
        float mx = -INFINITY;
#pragma unroll
        for (int j = 0; j < 5; ++j)
#pragma unroll
            for (int e = 0; e < 16; ++e) { const int row = (e & 3) + 8 * (e >> 2) + 4 * hh, delta = c + 128 - 32 * j - row, kpos = m0 - 128 + 32 * wave + 32 * j + row;
                const bool ok = (delta >= 0) && (delta <= 128) && (kpos >= 0); const int di = delta < 0 ? 0 : (delta > 128 ? 128 : delta);
                const float v = ok ? sc[j][e] + bl_[di] : -INFINITY; sc[j][e] = v; mx = fmaxf(mx, v); }
        mx = fmaxf(mx, __shfl_xor(mx, 32));
        float l = 0.f;
#pragma unroll
        for (int j = 0; j < 5; ++j)
#pragma unroll
            for (int e = 0; e < 16; ++e) { const float pe = __expf(sc[j][e] - mx); sc[j][e] = pe; l += pe; }
        l += __shfl_xor(l, 32);
        f32x16 o[2];
#pragma unroll
        for (int e = 0; e < 16; ++e) { o[0][e] = 0.f; o[1][e] = 0.f; }
#pragma unroll
        for (int j = 0; j < 5; ++j)
#pragma unroll
            for (int s2 = 0; s2 < 2; ++s2) {
                v4u pw; pw.x = pkbf(sc[j][8 * s2 + 0], sc[j][8 * s2 + 1]); pw.y = pkbf(sc[j][8 * s2 + 2], sc[j][8 * s2 + 3]); pw.z = pkbf(sc[j][8 * s2 + 4], sc[j][8 * s2 + 5]); pw.w = pkbf(sc[j][8 * s2 + 6], sc[j][8 * s2 + 7]);
                const bf16x8 pf = __builtin_bit_cast(bf16x8, pw);
                const int kb = 32 * wave + 32 * j + 16 * s2 + 4 * hh;
#pragma unroll
                for (int dt = 0; dt < 2; ++dt) { const LAS unsigned char* vp = L + ATT_VT + (32 * dt + c) * ATT_VSTR + kb * 2;
                    const v2u lo = *(const LAS v2u*)vp, hi = *(const LAS v2u*)(vp + 16);
                    v4u vw4; vw4.x = lo.x; vw4.y = lo.y; vw4.z = hi.x; vw4.w = hi.y;
                    o[dt] = __builtin_amdgcn_mfma_f32_32x32x16_bf16(__builtin_bit_cast(bf16x8, vw4), pf, o[dt], 0, 0, 0); } }
        const float inv = 1.f / l;
        bf16* op = part + ((size_t)p * TOKG + orow) * 1024 + h * 64 + 4 * hh;
#pragma unroll
        for (int dt = 0; dt < 2; ++dt)
#pragma unroll
            for (int g4 = 0; g4 < 4; ++g4) { v2u w; w.x = pkbf(o[dt][4 * g4] * inv, o[dt][4 * g4 + 1] * inv); w.y = pkbf(o[dt][4 * g4 + 2] * inv, o[dt][4 * g4 + 3] * inv);
                *(v2u*)(op + 32 * dt + 8 * g4) = w; }
        if (hh == 0) lse[((size_t)p * TOKG + orow) * 16 + h] = mx + __logf(l);
    }
}
__device__ __forceinline__ void merge_conv(const bf16* proj, const bf16* part, const float* lse, bf16* y, int TOKG, const float* convw, int lane, int gw, int ngw) {
    for (int it = gw; it < TOKG; it += ngw) {
        const int t = it & (SEQ - 1); const bf16* prow = proj + (size_t)it * PW;
#pragma unroll
        for (int i = 0; i < 2; ++i) { const int c0 = lane * 8 + 512 * i;
            float acc[8] = {0.f, 0.f, 0.f, 0.f, 0.f, 0.f, 0.f, 0.f};
#pragma unroll
            for (int dt = 0; dt < 3; ++dt) { const int tt = t - 2 + dt;
                if (tt >= 0) { const bf16* pr = prow - (size_t)(2 - dt) * PW; float gc[8], xa[8];
                    unpack8(*(const v4u*)(pr + 1024 + c0), gc); unpack8(*(const v4u*)(pr + 2048 + c0), xa);
#pragma unroll
                    for (int e = 0; e < 8; ++e) acc[e] += convw[dt * 1024 + c0 + e] * (gc[e] * xa[e]); } }
            float gb[8], z[8]; unpack8(*(const v4u*)(prow + c0), gb); unpack8(*(const v4u*)(prow + 6144 + c0), z);
            v4u o; o.x = pk2(gb[0] * acc[0] * z[0], gb[1] * acc[1] * z[1]); o.y = pk2(gb[2] * acc[2] * z[2], gb[3] * acc[3] * z[3]);
            o.z = pk2(gb[4] * acc[4] * z[4], gb[5] * acc[5] * z[5]); o.w = pk2(gb[6] * acc[6] * z[6], gb[7] * acc[7] * z[7]);
            *(v4u*)(y + (size_t)it * MW + c0) = o; }
#pragma unroll
        for (int i = 0; i < 2; ++i) { const int c0 = lane * 8 + 512 * i, h = c0 >> 6;
            const float l0 = lse[((size_t)0 * TOKG + it) * 16 + h], l1 = lse[((size_t)1 * TOKG + it) * 16 + h], l2 = lse[((size_t)2 * TOKG + it) * 16 + h];
            const float mx = fmaxf(l0, fmaxf(l1, l2)); float w0 = __expf(l0 - mx), w1 = __expf(l1 - mx), w2 = __expf(l2 - mx); const float inv = 1.f / (w0 + w1 + w2); w0 *= inv; w1 *= inv; w2 *= inv;
            float a0[8], a1[8], a2[8], z[8];
            unpack8(*(const v4u*)(part + ((size_t)0 * TOKG + it) * 1024 + c0), a0); unpack8(*(const v4u*)(part + ((size_t)1 * TOKG + it) * 1024 + c0), a1); unpack8(*(const v4u*)(part + ((size_t)2 * TOKG + it) * 1024 + c0), a2);
            unpack8(*(const v4u*)(prow + 6144 + 1024 + c0), z);
            float r[8];
#pragma unroll
            for (int e = 0; e < 8; ++e) r[e] = (w0 * a0[e] + w1 * a1[e] + w2 * a2[e]) * z[e];
            v4u o; o.x = pk2(r[0], r[1]); o.y = pk2(r[2], r[3]); o.z = pk2(r[4], r[5]); o.w = pk2(r[6], r[7]);
            *(v4u*)(y + (size_t)it * MW + 1024 + c0) = o; }
    }
}

__device__ __forceinline__ void hgrn_scalar(const bf16* proj, bf16* y, int TOKG, const float* ogain, unsigned char* lds, int tid, int lane, int wave, int bid, int G) {
    float* sq = (float*)lds; float* sf = sq + 4096; float* sk = sf + 4096; float* sv = sk + 4096; float* sop = sv + 4096;
    const int nseq = (TOKG / SEQ) * 16;
    const int v = tid & 127, kq = tid >> 7;
    for (int s = bid; s < nseq; s += G) {
        const int bl = s >> 4, h = s & 15; const size_t rowb = (size_t)bl * SEQ;
        float S[32];
#pragma unroll
        for (int i = 0; i < 32; ++i) S[i] = 0.f;
        const float og0 = ogain[h * 128 + lane], og1 = ogain[h * 128 + 64 + lane];
        for (int t0 = 0; t0 < SEQ; t0 += 32) {
#pragma unroll
            for (int i = 0; i < 8; ++i) { const int idx = tid + 512 * i, tt = idx >> 7, col = idx & 127; const bf16* prow = proj + (rowb + t0 + tt) * PW + h * 128 + col;
                sq[idx] = bf2f(prow[0]); const float f = __expf(bf2f(prow[2048])); sf[idx] = f; sk[idx] = 1.f - f; sv[idx] = bf2f(prow[4096]); }
            __syncthreads();
            for (int tt = 0; tt < 32; ++tt) {
                const float vv = sv[tt * 128 + v]; float acc = 0.f;
                const f32x4* pf = (const f32x4*)(sf + tt * 128 + kq * 32); const f32x4* pk = (const f32x4*)(sk + tt * 128 + kq * 32); const f32x4* pq = (const f32x4*)(sq + tt * 128 + kq * 32);
#pragma unroll
                for (int i4 = 0; i4 < 8; ++i4) { const f32x4 f = pf[i4], k = pk[i4], q = pq[i4];
#pragma unroll
                    for (int e = 0; e < 4; ++e) { S[i4 * 4 + e] = f[e] * S[i4 * 4 + e] + k[e] * vv; acc += q[e] * S[i4 * 4 + e]; } }
                sop[(kq * 32 + tt) * 128 + v] = acc;
            }
            __syncthreads();
#pragma unroll
            for (int i2 = 0; i2 < 4; ++i2) { const int tt = wave + 8 * i2;
                float o0 = 0.f, o1 = 0.f;
#pragma unroll
                for (int k4 = 0; k4 < 4; ++k4) { o0 += sop[(k4 * 32 + tt) * 128 + lane]; o1 += sop[(k4 * 32 + tt) * 128 + 64 + lane]; }
                const float rstd = rsqrtf(wave_sum(o0 * o0 + o1 * o1) * (1.f / 128.f) + EPS);
                const bf16* prow = proj + (rowb + t0 + tt) * PW + 6144 + h * 128;
                bf16* yr = y + (rowb + t0 + tt) * MW + h * 128;
                yr[lane] = (bf16)f2bf(o0 * rstd * og0 * bf2f(prow[lane])); yr[64 + lane] = (bf16)f2bf(o1 * rstd * og1 * bf2f(prow[64 + lane])); }
            __syncthreads();
        }
    }
}


typedef float f32x4h __attribute__((ext_vector_type(4)));
#define MFMA16(a, b, c) __builtin_amdgcn_mfma_f32_16x16x32_bf16((a), (b), (c), 0, 0, 0)
constexpr int HS = 144, HQS = 272;
constexpr int H1_KT = 0, H1_VT = 128 * HS, H1_SEG = 2 * 128 * HS;
constexpr int H3_QH = 0, H3_QM = 64 * HQS, H3_KM = 2 * 64 * HQS, H3_VT = 3 * 64 * HQS, H3_AM = H3_VT + 128 * HS, H3_SEG = H3_AM + 64 * HS, H3_RED = H3_SEG + 2048;
__device__ __forceinline__ void hgrn_h1(const bf16* proj, bf16* ST, float* dec, int TOKG, unsigned char* lds, int tid, int lane, int wave, int bid, int G) {
    LAS unsigned char* L = (LAS unsigned char*)lds;
    LAS float* segtot = (LAS float*)(L + H1_SEG);
    const int nunits = (TOKG / SEQ) * 16 * 128;
    const int col = tid & 127, seg = tid >> 7, fr = lane & 15, fq = lane >> 4;
    for (int u = bid; u < nunits; u += G) {
        const int cch = u & 127, seq = u >> 7, h = seq & 15, bl = seq >> 4;
        const bf16* pbase = proj + ((size_t)bl * SEQ + cch * 64 + seg * 16) * PW + h * 128 + col;
        float gc[16], kv[16]; float run = 0.f; unsigned vw[8];
#pragma unroll
        for (int i = 0; i < 16; ++i) { const float g = bf2f(pbase[(size_t)i * PW + 2048]); run += g; gc[i] = run; kv[i] = 1.f - __expf(g); }
#pragma unroll
        for (int i = 0; i < 8; ++i) vw[i] = (unsigned)pbase[(size_t)(2 * i) * PW + 4096] | ((unsigned)pbase[(size_t)(2 * i + 1) * PW + 4096] << 16);
        __syncthreads();
        segtot[seg * 128 + col] = run;
        { v4u a, b; a.x = vw[0]; a.y = vw[1]; a.z = vw[2]; a.w = vw[3]; b.x = vw[4]; b.y = vw[5]; b.z = vw[6]; b.w = vw[7];
          *(LAS v4u*)(L + H1_VT + col * HS + seg * 32) = a; *(LAS v4u*)(L + H1_VT + col * HS + seg * 32 + 16) = b; }
        __syncthreads();
        float pre = 0.f, tot = 0.f;
#pragma unroll
        for (int s4 = 0; s4 < 4; ++s4) { const float t = segtot[s4 * 128 + col]; tot += t; pre += (s4 < seg) ? t : 0.f; }
        { unsigned w[8];
#pragma unroll
          for (int i = 0; i < 8; ++i) w[i] = pkbf(kv[2 * i] * __expf(tot - (pre + gc[2 * i])), kv[2 * i + 1] * __expf(tot - (pre + gc[2 * i + 1])));
          v4u a, b; a.x = w[0]; a.y = w[1]; a.z = w[2]; a.w = w[3]; b.x = w[4]; b.y = w[5]; b.z = w[6]; b.w = w[7];
          *(LAS v4u*)(L + H1_KT + col * HS + seg * 32) = a; *(LAS v4u*)(L + H1_KT + col * HS + seg * 32 + 16) = b; }
        if (seg == 0) dec[(size_t)u * 128 + col] = __expf(tot);
        __syncthreads();
        f32x4h acc[8];
#pragma unroll
        for (int nk = 0; nk < 8; ++nk) acc[nk] = (f32x4h){0.f, 0.f, 0.f, 0.f};
        bf16x8 vf[2];
#pragma unroll
        for (int ks = 0; ks < 2; ++ks) vf[ks] = *(const LAS bf16x8*)(L + H1_VT + (16 * wave + fr) * HS + (32 * ks + 8 * fq) * 2);
#pragma unroll
        for (int nk = 0; nk < 8; ++nk)
#pragma unroll
            for (int ks = 0; ks < 2; ++ks) { const bf16x8 kf = *(const LAS bf16x8*)(L + H1_KT + (16 * nk + fr) * HS + (32 * ks + 8 * fq) * 2); acc[nk] = MFMA16(kf, vf[ks], acc[nk]); }
        bf16* sp = ST + (size_t)u * 16384 + (16 * wave + fr) * 128 + 4 * fq;
#pragma unroll
        for (int nk = 0; nk < 8; ++nk) { v2u w; w.x = pkbf(acc[nk][0], acc[nk][1]); w.y = pkbf(acc[nk][2], acc[nk][3]); *(v2u*)(sp + 16 * nk) = w; }
    }
}
__device__ __forceinline__ void hgrn_h2(bf16* ST, const float* dec, int TOKG, int tid, int bid, int G) {
    const int nitems = (TOKG / SEQ) * 16 * 4096;
    for (int item = bid * 512 + tid; item < nitems; item += G * 512) {
        const int seq = item >> 12, rem = item & 4095;
        bf16* p = ST + (size_t)seq * (128 * 16384) + rem * 4;
        const float* dp = dec + (size_t)seq * (128 * 128) + (rem & 31) * 4;
        f32x4 S = {0.f, 0.f, 0.f, 0.f};
        for (int c0 = 0; c0 < 128; c0 += 8) {
            v2u uw[8]; f32x4 dv[8];
#pragma unroll
            for (int i = 0; i < 8; ++i) { uw[i] = *(const v2u*)(p + (size_t)(c0 + i) * 16384); dv[i] = *(const f32x4*)(dp + (c0 + i) * 128); }
#pragma unroll
            for (int i = 0; i < 8; ++i) { v2u o; o.x = pkbf(S.x, S.y); o.y = pkbf(S.z, S.w); *(v2u*)(p + (size_t)(c0 + i) * 16384) = o;
                S.x = S.x * dv[i].x + __uint_as_float(uw[i].x << 16); S.y = S.y * dv[i].y + __uint_as_float(uw[i].x & 0xffff0000u);
                S.z = S.z * dv[i].z + __uint_as_float(uw[i].y << 16); S.w = S.w * dv[i].w + __uint_as_float(uw[i].y & 0xffff0000u); }
        }
    }
}
__device__ __forceinline__ void hgrn_h3(const bf16* proj, const bf16* ST, bf16* y, int TOKG, const float* ogain, unsigned char* lds, int tid, int lane, int wave, int bid, int G) {
    LAS unsigned char* L = (LAS unsigned char*)lds;
    LAS float* segtot = (LAS float*)(L + H3_SEG); LAS float* red = (LAS float*)(L + H3_RED);
    const int nunits = (TOKG / SEQ) * 16 * 128;
    const int col = tid & 127, seg = tid >> 7, fr = lane & 15, fq = lane >> 4;
    for (int u = bid; u < nunits; u += G) {
        const int cch = u & 127, seq = u >> 7, h = seq & 15, bl = seq >> 4;
        const size_t rowc = (size_t)bl * SEQ + cch * 64;
        const bf16* pbase = proj + (rowc + seg * 16) * PW + h * 128 + col;
        bf16x8 sf[4];
        { const bf16* sp = ST + (size_t)u * 16384 + (16 * wave + fr) * 128 + 8 * fq;
#pragma unroll
          for (int ks = 0; ks < 4; ++ks) sf[ks] = *(const bf16x8*)(sp + 32 * ks); }
        float gc[16], kv[16], qv[16]; float run = 0.f; unsigned vw[8];
#pragma unroll
        for (int i = 0; i < 16; ++i) { const float g = bf2f(pbase[(size_t)i * PW + 2048]); run += g; gc[i] = run; kv[i] = 1.f - __expf(g); qv[i] = bf2f(pbase[(size_t)i * PW]); }
#pragma unroll
        for (int i = 0; i < 8; ++i) vw[i] = (unsigned)pbase[(size_t)(2 * i) * PW + 4096] | ((unsigned)pbase[(size_t)(2 * i + 1) * PW + 4096] << 16);
        __syncthreads();
        segtot[seg * 128 + col] = run;
        { v4u a, b; a.x = vw[0]; a.y = vw[1]; a.z = vw[2]; a.w = vw[3]; b.x = vw[4]; b.y = vw[5]; b.z = vw[6]; b.w = vw[7];
          *(LAS v4u*)(L + H3_VT + col * HS + seg * 32) = a; *(LAS v4u*)(L + H3_VT + col * HS + seg * 32 + 16) = b; }
        __syncthreads();
        { float pre = 0.f;
#pragma unroll
          for (int s4 = 0; s4 < 4; ++s4) { const float t = segtot[s4 * 128 + col]; pre += (s4 < seg) ? t : 0.f; }
          const float gref = segtot[col] + segtot[128 + col];
#pragma unroll
          for (int i = 0; i < 16; ++i) { const float gcum = pre + gc[i]; const int s = seg * 16 + i;
              *(LAS unsigned short*)(L + H3_QH + s * HQS + col * 2) = (unsigned short)f2bf(qv[i] * __expf(gcum));
              *(LAS unsigned short*)(L + H3_QM + s * HQS + col * 2) = (unsigned short)f2bf(qv[i] * __expf(fminf(gcum - gref, 80.f)));
              *(LAS unsigned short*)(L + H3_KM + s * HQS + col * 2) = (unsigned short)f2bf(kv[i] * __expf(fminf(gref - gcum, 80.f))); } }
        __syncthreads();
        { const int tt = wave >> 1;
#pragma unroll
          for (int ss2 = 0; ss2 < 2; ++ss2) { const int ss = 2 * (wave & 1) + ss2; f32x4h a = {0.f, 0.f, 0.f, 0.f};
              if (ss <= tt) {
#pragma unroll
                  for (int ks = 0; ks < 4; ++ks) { const bf16x8 kmf = *(const LAS bf16x8*)(L + H3_KM + (16 * ss + fr) * HQS + (32 * ks + 8 * fq) * 2);
                      const bf16x8 qmf = *(const LAS bf16x8*)(L + H3_QM + (16 * tt + fr) * HQS + (32 * ks + 8 * fq) * 2); a = MFMA16(kmf, qmf, a); } }
              const int t = 16 * tt + fr, s0 = 16 * ss + 4 * fq;
              v2u w; w.x = pkbf(s0 <= t ? a[0] : 0.f, s0 + 1 <= t ? a[1] : 0.f); w.y = pkbf(s0 + 2 <= t ? a[2] : 0.f, s0 + 3 <= t ? a[3] : 0.f);
              *(LAS v2u*)(L + H3_AM + t * HS + s0 * 2) = w; } }
        __syncthreads();
        f32x4h acc[4];
#pragma unroll
        for (int t2 = 0; t2 < 4; ++t2) acc[t2] = (f32x4h){0.f, 0.f, 0.f, 0.f};
#pragma unroll
        for (int t2 = 0; t2 < 4; ++t2)
#pragma unroll
            for (int ks = 0; ks < 4; ++ks) { const bf16x8 qf = *(const LAS bf16x8*)(L + H3_QH + (16 * t2 + fr) * HQS + (32 * ks + 8 * fq) * 2); acc[t2] = MFMA16(sf[ks], qf, acc[t2]); }
        bf16x8 vf[2];
#pragma unroll
        for (int ks = 0; ks < 2; ++ks) vf[ks] = *(const LAS bf16x8*)(L + H3_VT + (16 * wave + fr) * HS + (32 * ks + 8 * fq) * 2);
#pragma unroll
        for (int t2 = 0; t2 < 4; ++t2)
#pragma unroll
            for (int ks = 0; ks < 2; ++ks) { const bf16x8 af = *(const LAS bf16x8*)(L + H3_AM + (16 * t2 + fr) * HS + (32 * ks + 8 * fq) * 2); acc[t2] = MFMA16(vf[ks], af, acc[t2]); }
#pragma unroll
        for (int t2 = 0; t2 < 4; ++t2) { float ss = acc[t2][0] * acc[t2][0] + acc[t2][1] * acc[t2][1] + acc[t2][2] * acc[t2][2] + acc[t2][3] * acc[t2][3];
            ss += __shfl_xor(ss, 16); ss += __shfl_xor(ss, 32); if (fq == 0) red[wave * 64 + 16 * t2 + fr] = ss; }
        __syncthreads();
        const int v0 = 16 * wave + 4 * fq; const f32x4 og = *(const f32x4*)(ogain + h * 128 + v0);
#pragma unroll
        for (int t2 = 0; t2 < 4; ++t2) { const int t = 16 * t2 + fr; float tot = 0.f;
#pragma unroll
            for (int w8 = 0; w8 < 8; ++w8) tot += red[w8 * 64 + t];
            const float rstd = rsqrtf(tot * (1.f / 128.f) + EPS);
            const v2u zw = *(const v2u*)(proj + (rowc + t) * PW + 6144 + h * 128 + v0);
            v2u w; w.x = pkbf(acc[t2][0] * rstd * og.x * __uint_as_float(zw.x << 16), acc[t2][1] * rstd * og.y * __uint_as_float(zw.x & 0xffff0000u));
            w.y = pkbf(acc[t2][2] * rstd * og.z * __uint_as_float(zw.y << 16), acc[t2][3] * rstd * og.w * __uint_as_float(zw.y & 0xffff0000u));
            *(v2u*)(y + (rowc + t) * MW + h * 128 + v0) = w; }
    }
}

__device__ __forceinline__ unsigned long long ldptr(LAS unsigned long long* tab, int i) { asm volatile("" ::: "memory"); const unsigned long long v = tab[i];
    const unsigned lo = __builtin_amdgcn_readfirstlane((unsigned)v), hi = __builtin_amdgcn_readfirstlane((unsigned)(v >> 32)); return ((unsigned long long)hi << 32) | lo; }
struct Args { const float* in[13]; float* out; unsigned char* ws; int ngroups; int pad; };
struct Ctx { int layer, g, NG, TOKG, j, even, tid, lane, wave, G, bid, gw, ngw; unsigned char* wsb; bf16 *Wt_in, *Wt_out, *proj, *ybuf, *xn; float* lbtab; size_t row0; };
__device__ __forceinline__ Ctx load_ctx(LAS unsigned long long* ptab) {
    Ctx c; const int step = (int)ldptr(ptab, 16); c.NG = (int)ldptr(ptab, 15); c.layer = step / c.NG; c.g = step - c.layer * c.NG; c.TOKG = NTOK / c.NG; c.j = c.layer >> 1; c.even = !(c.layer & 1);
    int tid_raw = threadIdx.x; asm volatile("" : "+v"(tid_raw)); c.tid = tid_raw; c.lane = c.tid & 63; c.wave = __builtin_amdgcn_readfirstlane(c.tid >> 6);
    c.G = gridDim.x; c.bid = blockIdx.x; c.gw = c.bid * 8 + c.wave; c.ngw = c.G * 8;
    c.wsb = (unsigned char*)ldptr(ptab, 14);
    c.Wt_in = (bf16*)(c.wsb + WS_WIN); c.Wt_out = (bf16*)(c.wsb + WS_WOUT); c.lbtab = (float*)(c.wsb + WS_MISC); c.proj = (bf16*)(c.wsb + WS_PROJ);
    c.ybuf = (bf16*)(c.wsb + WS_PROJ + (size_t)c.TOKG * (PW * 2)); c.xn = (bf16*)(c.wsb + WS_PROJ + (size_t)c.TOKG * (PW * 2 + MW * 2));
    c.row0 = (size_t)c.g * c.TOKG; return c;
}
#define ARGP(i) ((const float*)ldptr(ptab, (i)))
__global__ void __launch_bounds__(512, 2) fwd(Args a) {
    extern __shared__ __attribute__((aligned(16))) unsigned char lds[];
    cg::grid_group grid = cg::this_grid();
    LAS unsigned long long* ptab = (LAS unsigned long long*)((LAS unsigned char*)lds + 131072 + 1024);
    if (threadIdx.x == 0) {
#pragma unroll
        for (int i = 0; i < 13; ++i) ptab[i] = (unsigned long long)a.in[i];
        ptab[13] = (unsigned long long)a.out; ptab[14] = (unsigned long long)a.ws; ptab[15] = (unsigned long long)a.ngroups; ptab[16] = 0ull; }
    __syncthreads();
    for (;;) {
        {
            const Ctx c = load_ctx(ptab);
            if (c.g == 0) {
                const float* w_in = (c.even ? ARGP(2) : ARGP(9)) + (size_t)c.j * D * PW;
                const float* ln = (c.even ? ARGP(1) : ARGP(8)) + (size_t)c.j * D;
                const float* w_out = (c.even ? ARGP(6) : ARGP(12)) + (size_t)c.j * MW * D;
                LAS float* scr = (LAS float*)((LAS unsigned char*)lds + c.wave * 16384);
                constexpr int I_IN = (D / 64) * (PW / 32), I_OUT = (MW / 64) * (D / 32);
                for (int it = c.gw; it < I_IN + I_OUT; it += c.ngw) {
                    if (it < I_IN) transpose_item(w_in, D, PW, ln, c.Wt_in, scr, it, c.lane);
                    else transpose_item(w_out, MW, D, nullptr, c.Wt_out, scr, it - I_IN, c.lane);
                }
                if (!c.even && c.bid == 0) { const float* lbp = ARGP(10);
                    for (int col = c.tid; col < 2048; col += 512) c.lbtab[col] = (c.j == 0) ? 0.f : 1.f / (1.f + expf(lbp[col] - lbp[2048 + col])); }
            }
            const float* xsrc = (c.layer == 0) ? ARGP(0) : ARGP(13);
            norm_rows(xsrc + c.row0 * D, c.xn, c.TOKG, c.gw, c.ngw, c.lane);
        }
        grid.sync();
        {
            const Ctx c = load_ctx(ptab);
            pg8::Gemm gm{c.xn, c.Wt_in, c.TOKG, PW, D}; pg8::StaticOrder S; S.init(c.TOKG, PW, c.G, c.bid); EpiProj E{c.proj, c.even ? 0 : 1, c.lbtab};
            pg8::gemm_phase<EpiProj, pg8::StaticOrder, true, true>((PG8_LAS unsigned char*)lds, gm, S, E);
        }
        grid.sync();
        {
            const Ctx c = load_ctx(ptab);
            if (c.even) {
                attn_mfma(c.proj, c.xn, (float*)(c.xn + (size_t)c.TOKG * 3072), c.TOKG, ARGP(4) + c.j * 64, ARGP(5) + c.j * 64, ARGP(7), lds, c.tid, c.lane, c.wave, c.bid, c.G);
            } else {
                hgrn_h1(c.proj, c.xn, (float*)(c.wsb + WS_MISC + MiB), c.TOKG, lds, c.tid, c.lane, c.wave, c.bid, c.G);
            }
        }
        grid.sync();
        {
            const Ctx c = load_ctx(ptab);
            if (c.even) merge_conv(c.proj, c.xn, (const float*)(c.xn + (size_t)c.TOKG * 3072), c.ybuf, c.TOKG, ARGP(3) + c.j * 3 * 1024, c.lane, c.gw, c.ngw);
            else hgrn_h2(c.xn, (const float*)(c.wsb + WS_MISC + MiB), c.TOKG, c.tid, c.bid, c.G);
        }
        grid.sync();
        {
            const Ctx c = load_ctx(ptab);
            if (!c.even) hgrn_h3(c.proj, c.xn, c.ybuf, c.TOKG, ARGP(11) + c.j * MW, lds, c.tid, c.lane, c.wave, c.bid, c.G);
        }
        grid.sync();
        {
            const Ctx c = load_ctx(ptab);
            const float* xsrc = (c.layer == 0) ? ARGP(0) : ARGP(13);
            pg8::Gemm gm{c.ybuf, c.Wt_out, c.TOKG, D, MW}; pg8::StaticOrder S; S.init(c.TOKG, D, c.G, c.bid); EpiRes E{xsrc + c.row0 * D, (float*)ARGP(13) + c.row0 * D};
            pg8::gemm_phase<EpiRes, pg8::StaticOrder, true, true>((PG8_LAS unsigned char*)lds, gm, S, E);
        }
        grid.sync();
        const int step = (int)ldptr(ptab, 16), nsteps = 4 * (int)ldptr(ptab, 15);
        __syncthreads();
        if (threadIdx.x == 0) ptab[16] = (unsigned long long)(step + 1);
        __syncthreads();
        if (step + 1 >= nsteps) break;
    }
}

extern "C" void kernel_launch(void* const* d_in, const int* in_sizes, int n_in, void* d_out, int out_size, void* d_ws, size_t ws_size, hipStream_t stream) {
    static int grid = 0;
    if (grid == 0) {
        int dev = 0, cus = 0, per_cu = 0;
        if (hipGetDevice(&dev) != hipSuccess || hipDeviceGetAttribute(&cus, hipDeviceAttributeMultiprocessorCount, dev) != hipSuccess) { fprintf(stderr, "kernel_launch: device query failed\n"); grid = -1; return; }
        if (hipFuncSetAttribute((const void*)fwd, hipFuncAttributeMaxDynamicSharedMemorySize, LDS_BYTES) != hipSuccess) { fprintf(stderr, "kernel_launch: hipFuncSetAttribute failed\n"); grid = -1; return; }
        if (hipOccupancyMaxActiveBlocksPerMultiprocessor(&per_cu, (const void*)fwd, 512, LDS_BYTES) != hipSuccess || per_cu < 1) fprintf(stderr, "kernel_launch: occupancy query reports %d\n", per_cu);
        (void)hipGetLastError();
        grid = cus;
    }
    if (grid < 0) return;
    Args a{};
    for (int i = 0; i < 13; ++i) a.in[i] = (const float*)d_in[i];
    a.out = (float*)d_out; a.ws = (unsigned char*)d_ws;
    a.ngroups = (ws_size >= (size_t)472 * MiB) ? 2 : 4;
    void* args[] = {&a};
    hipError_t e = hipLaunchCooperativeKernel((const void*)fwd, dim3(grid), dim3(512), args, LDS_BYTES, stream);
    if (e != hipSuccess) fprintf(stderr, "kernel_launch: cooperative launch failed: %s (grid %d)\n", hipGetErrorString(e), grid);
}
```

```cpp
#include <hip/hip_runtime.h>
#include <hip/hip_cooperative_groups.h>
#include <cstdio>
#include <cstdint>
namespace cg = cooperative_groups;
namespace pg8 {
#define PG8_LAS __attribute__((address_space(3)))
typedef unsigned short bf16_t;
typedef short bf16x8 __attribute__((ext_vector_type(8)));
typedef float f32x4 __attribute__((ext_vector_type(4)));
typedef unsigned u32x4 __attribute__((ext_vector_type(4)));
constexpr int BM = 256, BK = 64, HALF = 128, HTB = HALF * BK * 2  , STAGE_BYTES = 8 * HTB, NXCD = 8, WGM = 8;

__host__ __device__ __forceinline__ int lds_byte(int r, int c) { const int st = (r >> 4) * 2 + (c >> 5), rr = r & 15, cc = c & 31, ob = rr * 64 + cc * 2; return st * 1024 + (ob ^ (((ob >> 9) & 1) << 5)); }
__host__ __device__ __forceinline__ void stage_rc(int b, int& R, int& C) { const int st = b / 1024, sb = b % 1024, swz = sb ^ (((sb >> 9) & 1) << 5); R = (st >> 1) * 16 + swz / 64; C = (st & 1) * 32 + (swz % 64) / 2; }
__host__ __device__ __forceinline__ int perm32(int rho) { const int n = rho >> 4, i = rho & 15; return 8 * (i >> 2) + 4 * n + (i & 3); }

struct Unit { int pm, pn; };
struct Gemm { const bf16_t* A; const bf16_t* Bt; int M, N, K; };

struct StaticOrder {
    int nM, nN, nwg, G, c;
    __host__ __device__ void init(int M, int N, int G_, int c_) { nM = M / BM; nN = N / BM; nwg = nM * nN; G = G_; c = c_; }
    __host__ __device__ bool next(int i, Unit& u) const {
        const long L = (long)i * G + c; if (L >= nwg) return false;
        int wgid = (int)L; { const int q = nwg / NXCD, r = nwg % NXCD, xcd = wgid % NXCD, off = wgid / NXCD; wgid = (xcd < r ? xcd * (q + 1) : r * (q + 1) + (xcd - r) * q) + off; }
        const int nig = WGM * nN, gid = wgid / nig, fm = gid * WGM, gsz = (nM - fm) < WGM ? (nM - fm) : WGM;
        u.pm = fm + ((wgid % nig) % gsz); u.pn = (wgid % nig) / gsz; return true;
    }
    __device__ __forceinline__ void a_ready(const Unit&) const {}
    __device__ __forceinline__ void done(const Unit&) const {}
};

__device__ __forceinline__ unsigned cvt_pk_bf16(float lo, float hi) { unsigned r; asm volatile("v_cvt_pk_bf16_f32 %0, %1, %2" : "=v"(r) : "v"(lo), "v"(hi)); return r; }
template <class Epi, class Sched, bool ALIGN_EPI = false, bool SP2 = false>
__device__ __forceinline__ void gemm_phase(PG8_LAS unsigned char* lds, const Gemm g, const Sched& S, const Epi& E) {
    int tid_raw = threadIdx.x; asm volatile("" : "+v"(tid_raw)); const int tid = tid_raw, wid = __builtin_amdgcn_readfirstlane(tid >> 6), lane = tid & 63, wr = wid >> 2, wc = wid & 3, fr = lane & 15, fq = lane >> 4;
    const int K = g.K, nt = K / BK;
    unsigned voffA[2], voffB[2];
#pragma unroll
    for (int i = 0; i < 2; ++i) { int R, C; stage_rc(tid * 16 + i * 8192, R, C); const int Rb = Epi::PERM ? ((R & ~31) + perm32(R & 31)) : R;
        voffA[i] = (unsigned)(R * K + C) * 2u; voffB[i] = (unsigned)(Rb * K + C) * 2u; }
    const size_t kstep = (size_t)(BK * 2);
    const size_t hstep = (size_t)HALF * K * 2;
    const size_t tstep = 2 * hstep;
    const unsigned ldsw = (unsigned)wid * 1024u;
    const int aoff = lds_byte(wr * 64 + fr, fq * 8), boff = lds_byte(wc * 32 + fr, fq * 8);
#define PG8_SA(b, h) (((b) * 2 + (h)) * HTB)
#define PG8_SB(b, h) ((4 + (b) * 2 + (h)) * HTB)
#define PG8_STAGE(bufoff, gbase, voff) do { _Pragma("unroll") for (int _i = 0; _i < 2; ++_i) \
        __builtin_amdgcn_global_load_lds((const unsigned*)((const char*)(gbase) + (voff)[_i]), (PG8_LAS unsigned*)(lds + (bufoff) + ldsw + _i * 8192), 16, 0, 0); } while (0)
#define PG8_LDA(dst, b, h) do { _Pragma("unroll") for (int m = 0; m < 4; ++m) _Pragma("unroll") for (int k = 0; k < 2; ++k) dst[m][k] = *(const PG8_LAS bf16x8*)(lds + PG8_SA(b, h) + aoff + m * 2048 + k * 1024); } while (0)
#define PG8_LDB(dst, b, h) do { _Pragma("unroll") for (int n = 0; n < 2; ++n) _Pragma("unroll") for (int k = 0; k < 2; ++k) dst[n][k] = *(const PG8_LAS bf16x8*)(lds + PG8_SB(b, h) + boff + n * 2048 + k * 1024); } while (0)
#define PG8_MMA(ai, bj, At, Bt) do { __builtin_amdgcn_s_setprio(1); _Pragma("unroll") for (int m = 0; m < 4; ++m) _Pragma("unroll") for (int n = 0; n < 2; ++n) _Pragma("unroll") for (int k = 0; k < 2; ++k) \
        acc[ai][bj][m][n] = __builtin_amdgcn_mfma_f32_16x16x32_bf16(Bt[n][k], At[m][k], acc[ai][bj][m][n], 0, 0, 0); __builtin_amdgcn_s_setprio(0); } while (0)
#define PG8_WAIT_V(n) asm volatile("s_waitcnt vmcnt(" #n ")" ::: "memory")
#define PG8_WAIT_L(n) asm volatile("s_waitcnt lgkmcnt(" #n ")" ::: "memory")
#define PG8_BAR __builtin_amdgcn_s_barrier()
#define PG8_SCHED __builtin_amdgcn_sched_barrier(0)
    Unit cur, nxt; int ui = 0;
    if (!S.next(0, cur)) return;
    f32x4 acc[2][2][4][2];
#pragma unroll
    for (int a = 0; a < 2; ++a)
#pragma unroll
        for (int b = 0; b < 2; ++b)
#pragma unroll
            for (int m = 0; m < 4; ++m)
#pragma unroll
                for (int n = 0; n < 2; ++n) acc[a][b][m][n] = (f32x4){0.f, 0.f, 0.f, 0.f};
    bf16x8 At[4][2], B0[2][2], B1[2][2];
    const char* cA = (const char*)g.A + (size_t)cur.pm * tstep; const char* cB = (const char*)g.Bt + (size_t)cur.pn * tstep;
    S.a_ready(cur);
    if constexpr (SP2) {
        PG8_STAGE(PG8_SB(0, 0), cB, voffB); PG8_STAGE(PG8_SB(0, 1), cB + hstep, voffB); PG8_STAGE(PG8_SA(0, 0), cA, voffA); PG8_STAGE(PG8_SA(0, 1), cA + hstep, voffA);
        if (wr == 1) PG8_BAR;
        PG8_WAIT_V(2); PG8_BAR;
        PG8_STAGE(PG8_SB(1, 0), cB + kstep, voffB); PG8_STAGE(PG8_SA(1, 0), cA + kstep, voffA); PG8_STAGE(PG8_SB(1, 1), cB + hstep + kstep, voffB);
        PG8_WAIT_V(6); PG8_BAR;
    } else {
        PG8_STAGE(PG8_SB(0, 0), cB, voffB); PG8_STAGE(PG8_SA(0, 0), cA, voffA); PG8_STAGE(PG8_SB(0, 1), cB + hstep, voffB); PG8_STAGE(PG8_SA(0, 1), cA + hstep, voffA);
        if (wr == 1) PG8_BAR;
        PG8_WAIT_V(4); PG8_BAR;
        PG8_STAGE(PG8_SB(1, 0), cB + kstep, voffB); PG8_STAGE(PG8_SA(1, 0), cA + kstep, voffA); PG8_STAGE(PG8_SB(1, 1), cB + hstep + kstep, voffB);
        PG8_WAIT_V(6); PG8_BAR;
    }
    for (;;) {
        const bool has_next = S.next(ui + 1, nxt);
        const char* nA = has_next ? (const char*)g.A + (size_t)nxt.pm * tstep : cA; const char* nB = has_next ? (const char*)g.Bt + (size_t)nxt.pn * tstep : cB;
        for (int t = 0; t < nt; t += 2) {
            const bool last = (t == nt - 2);
            const char* a1 = cA + (size_t)(t + 1) * kstep;
            const char* a2 = last ? nA : cA + (size_t)(t + 2) * kstep; const char* b2 = last ? nB : cB + (size_t)(t + 2) * kstep;
            const char* a3 = a2 + kstep; const char* b3 = b2 + kstep;
            if (last && has_next) S.a_ready(nxt);
            if constexpr (SP2) {
            PG8_LDB(B0, 0, 0); PG8_LDB(B1, 0, 1); PG8_SCHED; PG8_LDA(At, 0, 0); PG8_STAGE(PG8_SA(1, 1), a1 + hstep, voffA);
            PG8_WAIT_V(8); PG8_WAIT_L(0); PG8_BAR; PG8_MMA(0, 0, At, B0); PG8_MMA(0, 1, At, B1); PG8_BAR; PG8_SCHED;
            PG8_LDA(At, 0, 1); PG8_STAGE(PG8_SB(0, 0), b2, voffB); PG8_STAGE(PG8_SB(0, 1), b2 + hstep, voffB); PG8_STAGE(PG8_SA(0, 0), a2, voffA);
            PG8_WAIT_V(8); PG8_WAIT_L(0); PG8_BAR; PG8_MMA(1, 0, At, B0); PG8_MMA(1, 1, At, B1); PG8_BAR; PG8_SCHED;
            PG8_LDB(B0, 1, 0); PG8_LDB(B1, 1, 1); PG8_SCHED; PG8_LDA(At, 1, 0); PG8_STAGE(PG8_SA(0, 1), a2 + hstep, voffA);
            PG8_WAIT_V(8); PG8_WAIT_L(0); PG8_BAR; PG8_MMA(0, 0, At, B0); PG8_MMA(0, 1, At, B1); PG8_BAR; PG8_SCHED;
            PG8_LDA(At, 1, 1); PG8_STAGE(PG8_SB(1, 0), b3, voffB); PG8_STAGE(PG8_SB(1, 1), b3 + hstep, voffB); PG8_STAGE(PG8_SA(1, 0), a3, voffA);
            PG8_WAIT_V(8); PG8_WAIT_L(0); PG8_BAR; PG8_MMA(1, 0, At, B0); PG8_MMA(1, 1, At, B1); PG8_BAR; PG8_SCHED;
            } else {
            PG8_LDB(B0, 0, 0); PG8_SCHED; PG8_LDA(At, 0, 0); PG8_STAGE(PG8_SA(1, 1), a1 + hstep, voffA);
            PG8_WAIT_L(8); PG8_BAR; PG8_WAIT_L(0); PG8_MMA(0, 0, At, B0); PG8_BAR; PG8_SCHED;
            PG8_LDB(B1, 0, 1); PG8_STAGE(PG8_SB(0, 0), b2, voffB);
            PG8_BAR; PG8_WAIT_L(0); PG8_MMA(0, 1, At, B1); PG8_BAR;
            PG8_LDA(At, 0, 1); PG8_STAGE(PG8_SA(0, 0), a2, voffA);
            PG8_BAR; PG8_WAIT_L(0); PG8_MMA(1, 0, At, B0); PG8_BAR; PG8_SCHED;
            PG8_STAGE(PG8_SB(0, 1), b2 + hstep, voffB);
            PG8_WAIT_V(6); PG8_BAR; PG8_MMA(1, 1, At, B1); PG8_BAR;
            PG8_LDB(B0, 1, 0); PG8_SCHED; PG8_LDA(At, 1, 0); PG8_STAGE(PG8_SA(0, 1), a2 + hstep, voffA);
            PG8_WAIT_L(8); PG8_BAR; PG8_WAIT_L(0); PG8_MMA(0, 0, At, B0); PG8_BAR; PG8_SCHED;
            PG8_LDB(B1, 1, 1); PG8_STAGE(PG8_SB(1, 0), b3, voffB);
            PG8_BAR; PG8_WAIT_L(0); PG8_MMA(0, 1, At, B1); PG8_BAR;
            PG8_LDA(At, 1, 1); PG8_STAGE(PG8_SA(1, 0), a3, voffA);
            PG8_BAR; PG8_WAIT_L(0); PG8_MMA(1, 0, At, B0); PG8_BAR; PG8_SCHED;
            PG8_STAGE(PG8_SB(1, 1), b3 + hstep, voffB);
            PG8_WAIT_V(6); PG8_BAR; PG8_MMA(1, 1, At, B1); PG8_BAR;
            }
        }
        if constexpr (ALIGN_EPI) { if (wr == 0) PG8_BAR; }
        if constexpr (!Epi::AFTER_DRAIN) { E(acc, cur, wr, wc, fr, fq); S.done(cur); }
        if (!has_next) break;
#pragma unroll
        for (int a = 0; a < 2; ++a)
#pragma unroll
            for (int b = 0; b < 2; ++b)
#pragma unroll
                for (int m = 0; m < 4; ++m)
#pragma unroll
                    for (int n = 0; n < 2; ++n) acc[a][b][m][n] = (f32x4){0.f, 0.f, 0.f, 0.f};
        cur = nxt; cA = nA; cB = nB; ++ui;
        if constexpr (ALIGN_EPI) { if (wr == 1) PG8_BAR; }
    }
    PG8_WAIT_V(0);
    if constexpr (!ALIGN_EPI) { if (wr == 0) PG8_BAR; }
    PG8_BAR;
    if constexpr (Epi::AFTER_DRAIN) { E.fused(acc, cur, wr, wc, fr, fq, lds, wid, lane); S.done(cur); }
#undef PG8_SA
#undef PG8_SB
#undef PG8_STAGE
#undef PG8_LDA
#undef PG8_LDB
#undef PG8_MMA
#undef PG8_WAIT_V
#undef PG8_WAIT_L
#undef PG8_BAR
#undef PG8_SCHED
}
}

constexpr int D = 1024, SEQ = 8192, NBATCH = 4, NTOK = NBATCH * SEQ, PW = 8192, MW = 2048;
constexpr float EPS = 1e-6f;
constexpr size_t MiB = 1u << 20;
constexpr size_t WS_WIN = 0, WS_WOUT = 16 * MiB, WS_MISC = 20 * MiB, WS_BAR = 23 * MiB, WS_PROJ = 24 * MiB;
constexpr int LDS_BYTES = 147456;
typedef unsigned short bf16;
typedef unsigned v4u __attribute__((ext_vector_type(4)));
typedef float f32x4 __attribute__((ext_vector_type(4)));
#define LAS __attribute__((address_space(3)))

__device__ __forceinline__ float bf2f(unsigned short b) { return __uint_as_float(((unsigned)b) << 16); }
__device__ __forceinline__ unsigned f2bf(float f) { unsigned u = __float_as_uint(f); return (u + 0x7fffu + ((u >> 16) & 1u)) >> 16; }
__device__ __forceinline__ unsigned pk2(float lo, float hi) { return f2bf(lo) | (f2bf(hi) << 16); }
__device__ __forceinline__ float wave_sum(float v) {
#pragma unroll
    for (int o = 1; o < 64; o <<= 1) v += __shfl_xor(v, o);
    return v;
}
__device__ __forceinline__ float wave_max(float v) {
#pragma unroll
    for (int o = 1; o < 64; o <<= 1) v = fmaxf(v, __shfl_xor(v, o));
    return v;
}
__device__ __forceinline__ float silu_f(float x) { return x / (1.f + __expf(-x)); }
__device__ __forceinline__ void unpack8(const v4u w, float (&f)[8]) {
    f[0] = __uint_as_float(w.x << 16); f[1] = __uint_as_float(w.x & 0xffff0000u);
    f[2] = __uint_as_float(w.y << 16); f[3] = __uint_as_float(w.y & 0xffff0000u);
    f[4] = __uint_as_float(w.z << 16); f[5] = __uint_as_float(w.z & 0xffff0000u);
    f[6] = __uint_as_float(w.w << 16); f[7] = __uint_as_float(w.w & 0xffff0000u);
}

struct EpiProj {
    static constexpr bool PERM = true, AFTER_DRAIN = false;
    pg8::bf16_t* O; int odd; const float* lb;
    __device__ __forceinline__ void operator()(const pg8::f32x4 (&acc)[2][2][4][2], const pg8::Unit& u, int wr, int wc, int fr, int fq) const {
        const int row0 = u.pm * 256 + wr * 64 + fr, col0 = u.pn * 256 + wc * 32 + 8 * fq;
        int act;
        if (!odd) act = (u.pn >= 24) ? 1 : 0; else act = (u.pn < 8) ? 1 : (u.pn < 16 ? 2 : (u.pn < 24 ? 0 : 1));
        pg8::f32x4 lbv[2][2];
#pragma unroll
        for (int bj = 0; bj < 2; ++bj)
#pragma unroll
            for (int n = 0; n < 2; ++n) lbv[bj][n] = (act == 2) ? *(const pg8::f32x4*)(lb + (col0 - 2048) + bj * 128 + 4 * n) : (pg8::f32x4){0.f, 0.f, 0.f, 0.f};
#pragma unroll
        for (int ai = 0; ai < 2; ++ai)
#pragma unroll
            for (int m = 0; m < 4; ++m) { pg8::bf16_t* rowp = O + (size_t)(row0 + ai * 128 + m * 16) * PW + col0;
#pragma unroll
                for (int bj = 0; bj < 2; ++bj) { pg8::f32x4 v0 = acc[ai][bj][m][0], v1 = acc[ai][bj][m][1];
                    if (act == 1) {
#pragma unroll
                        for (int e = 0; e < 4; ++e) { v0[e] = silu_f(v0[e]); v1[e] = silu_f(v1[e]); } }
                    else if (act == 2) {
#pragma unroll
                        for (int e = 0; e < 4; ++e) { const float s0 = 1.f / (1.f + __expf(-v0[e])), s1 = 1.f / (1.f + __expf(-v1[e]));
                            v0[e] = __logf(lbv[bj][0][e] + (1.f - lbv[bj][0][e]) * s0); v1[e] = __logf(lbv[bj][1][e] + (1.f - lbv[bj][1][e]) * s1); } }
                    pg8::u32x4 w; w.x = pg8::cvt_pk_bf16(v0[0], v0[1]); w.y = pg8::cvt_pk_bf16(v0[2], v0[3]); w.z = pg8::cvt_pk_bf16(v1[0], v1[1]); w.w = pg8::cvt_pk_bf16(v1[2], v1[3]);
                    *(pg8::u32x4*)(rowp + bj * 128) = w; } }
    }
};
struct EpiRes {
    static constexpr bool PERM = false, AFTER_DRAIN = false;
    const float* base; float* out;
    __device__ __forceinline__ void operator()(const pg8::f32x4 (&acc)[2][2][4][2], const pg8::Unit& u, int wr, int wc, int fr, int fq) const {
        const int row0 = u.pm * 256 + wr * 64 + fr, col0 = u.pn * 256 + wc * 32 + 4 * fq;
#pragma unroll
        for (int ai = 0; ai < 2; ++ai)
#pragma unroll
            for (int m = 0; m < 4; ++m) { const size_t off = (size_t)(row0 + ai * 128 + m * 16) * D + col0;
#pragma unroll
                for (int bj = 0; bj < 2; ++bj)
#pragma unroll
                    for (int n = 0; n < 2; ++n) { const pg8::f32x4 b = *(const pg8::f32x4*)(base + off + bj * 128 + n * 16);
                        *(pg8::f32x4*)(out + off + bj * 128 + n * 16) = b + acc[ai][bj][m][n]; } }
    }
};

__device__ __forceinline__ void transpose_item(const float* W, int K, int N, const float* gain, bf16* WT, LAS float* scr, int item, int lane) {
    const int nblk = N / 32, kb = item / nblk, nb = item % nblk, k0 = 64 * kb, n0 = 32 * nb;
#pragma unroll 8
    for (int i = 0; i < 32; ++i) { const int kk = 2 * i + (lane >> 5); float w = W[(size_t)(k0 + kk) * N + n0 + (lane & 31)]; if (gain) w *= gain[k0 + kk]; scr[kk * 33 + (lane & 31)] = w; }
    asm volatile("s_waitcnt lgkmcnt(0)" ::: "memory");
    const int c = lane & 7;
#pragma unroll
    for (int j = 0; j < 4; ++j) { const int n = (lane >> 3) + 8 * j; const LAS float* s = scr + (8 * c) * 33 + n;
        v4u o; o.x = pk2(s[0 * 33], s[1 * 33]); o.y = pk2(s[2 * 33], s[3 * 33]); o.z = pk2(s[4 * 33], s[5 * 33]); o.w = pk2(s[6 * 33], s[7 * 33]);
        *(v4u*)(WT + (size_t)(n0 + n) * K + k0 + 8 * c) = o; }
    asm volatile("s_waitcnt lgkmcnt(0)" ::: "memory");
}
__device__ __forceinline__ void norm_rows(const float* x, bf16* xn, int nrows, int gw, int ngw, int lane) {
    for (int m = gw; m < nrows; m += ngw) {
        const f32x4* xr = (const f32x4*)(x + (size_t)m * D) + lane;
        f32x4 v[4]; float s = 0.f;
#pragma unroll
        for (int j = 0; j < 4; ++j) { v[j] = xr[64 * j]; s += (v[j].x * v[j].x + v[j].y * v[j].y) + (v[j].z * v[j].z + v[j].w * v[j].w); }
        const float rstd = rsqrtf(wave_sum(s) * (1.f / D) + EPS);
        unsigned long long* o8 = (unsigned long long*)(xn + (size_t)m * D) + lane;
#pragma unroll
        for (int j = 0; j < 4; ++j) o8[64 * j] = (unsigned long long)pk2(v[j].x * rstd, v[j].y * rstd) | ((unsigned long long)pk2(v[j].z * rstd, v[j].w * rstd) << 32);
    }
}

__device__ __forceinline__ void attn_scalar(const bf16* proj, bf16* y, int TOKG, const float* qgain, const float* kgain, const float* rel_bias,
                                            unsigned char* lds, int tid, int lane, int wave, int gw, int ngw) {
    int* btab = (int*)lds;
    float* wq = (float*)(lds + 2048 + wave * 2304);
    float* wp = wq + 64;
    for (int e = tid; e < 448; e += 512) {
        int bk = -1;
        if (e < 387) { const int p = e / 129, jj = e - 129 * p, dist = jj << (2 * p);
            if (dist < 16) bk = dist; else { const float sc = logf((float)dist / 16.f) / logf(128.f); int lg = 16 + (int)(sc * 16.f); bk = lg < 31 ? lg : 31; } }
        btab[e] = bk;
    }
    __syncthreads();
    const float qgl = qgain[lane] * 0.125f, kgl = kgain[lane];
    const int nitems = TOKG * 16;
    for (int it = gw; it < nitems; it += ngw) {
        const int t = it & (SEQ - 1), bh = it >> 13, h = bh & 15, bl = bh >> 4;
        const size_t rowb = (size_t)bl * SEQ;
        const bf16* prow = proj + (rowb + t) * PW;
        const float q = bf2f(prow[3072 + h * 64 + lane]);
        const float ss = wave_sum(q * q);
        wq[lane] = q * rsqrtf(ss * (1.f / 64.f) + EPS) * qgl * kgl;
        asm volatile("s_waitcnt lgkmcnt(0)" ::: "memory");
        float lg[7]; float mx = -INFINITY;
#pragma unroll
        for (int r = 0; r < 7; ++r) {
            const int e = lane + 64 * r; const int bk = btab[e];
            const int p = e / 129, jj = e - 129 * p; const int tk = t - (jj << (2 * p));
            float l = -INFINITY;
            if (bk >= 0 && tk >= 0) {
                const v4u* kr = (const v4u*)(proj + (rowb + tk) * PW + 4096 + h * 64);
                float dot = 0.f, ks = 0.f;
#pragma unroll
                for (int c8 = 0; c8 < 8; ++c8) { float f[8]; unpack8(kr[c8], f);
#pragma unroll
                    for (int i = 0; i < 8; ++i) { dot += wq[c8 * 8 + i] * f[i]; ks += f[i] * f[i]; } }
                l = dot * rsqrtf(ks * (1.f / 64.f) + EPS) + rel_bias[bk * 16 + h];
            }
            lg[r] = l; mx = fmaxf(mx, l);
        }
        mx = wave_max(mx);
        float sum = 0.f;
#pragma unroll
        for (int r = 0; r < 7; ++r) { const float pe = (lg[r] == -INFINITY) ? 0.f : __expf(lg[r] - mx); wp[lane + 64 * r] = pe; sum += pe; }
        sum = wave_sum(sum);
        asm volatile("s_waitcnt lgkmcnt(0)" ::: "memory");
        float o = 0.f;
        const bf16* vbase = proj + rowb * PW + 5120 + h * 64 + lane;
#pragma unroll
        for (int p = 0; p < 3; ++p) {
#pragma unroll 8
            for (int jj = 0; jj <= 128; ++jj) { int tk = t - (jj << (2 * p)); const float pe = wp[p * 129 + jj]; if (tk < 0) tk = t;
                o += pe * bf2f(vbase[(size_t)tk * PW]); }
        }
        const float z = bf2f(prow[6144 + 1024 + h * 64 + lane]);
        y[(rowb + t) * MW + 1024 + h * 64 + lane] = (bf16)f2bf(o / sum * z);
    }
}
__device__ __forceinline__ void conv_scalar(const bf16* proj, bf16* y, int TOKG, const float* convw, int lane, int gw, int ngw) {
    for (int it = gw; it < TOKG; it += ngw) {
        const int t = it & (SEQ - 1); const bf16* prow = proj + (size_t)it * PW;
#pragma unroll
        for (int i = 0; i < 2; ++i) { const int c0 = lane * 8 + 512 * i;
            float acc[8] = {0.f, 0.f, 0.f, 0.f, 0.f, 0.f, 0.f, 0.f};
#pragma unroll
            for (int dt = 0; dt < 3; ++dt) { const int tt = t - 2 + dt;
                if (tt >= 0) { const bf16* pr = prow - (size_t)(2 - dt) * PW; float gc[8], xa[8];
                    unpack8(*(const v4u*)(pr + 1024 + c0), gc); unpack8(*(const v4u*)(pr + 2048 + c0), xa);
#pragma unroll
                    for (int e = 0; e < 8; ++e) acc[e] += convw[dt * 1024 + c0 + e] * (gc[e] * xa[e]); } }
            float gb[8], z[8]; unpack8(*(const v4u*)(prow + c0), gb); unpack8(*(const v4u*)(prow + 6144 + c0), z);
            v4u o; o.x = pk2(gb[0] * acc[0] * z[0], gb[1] * acc[1] * z[1]); o.y = pk2(gb[2] * acc[2] * z[2], gb[3] * acc[3] * z[3]);
            o.z = pk2(gb[4] * acc[4] * z[4], gb[5] * acc[5] * z[5]); o.w = pk2(gb[6] * acc[6] * z[6], gb[7] * acc[7] * z[7]);
            *(v4u*)(y + (size_t)it * MW + c0) = o; }
    }
}


typedef short bf16x8 __attribute__((ext_vector_type(8)));
typedef float f32x16 __attribute__((ext_vector_type(16)));
typedef __bf16 bf16x2_t __attribute__((ext_vector_type(2)));
typedef float f32x2_t __attribute__((ext_vector_type(2)));
typedef unsigned v2u __attribute__((ext_vector_type(2)));
__device__ __forceinline__ unsigned pkbf(float lo, float hi) { const f32x2_t v = {lo, hi}; const bf16x2_t b = __builtin_convertvector(v, bf16x2_t); return __builtin_bit_cast(unsigned, b); }
constexpr int ATT_KS = 0, ATT_KSTR = 144, ATT_VT = 384 * 144, ATT_VSTR = 776, ATT_BIAS = ATT_VT + 64 * 776;
__device__ __forceinline__ void attn_mfma(const bf16* proj, bf16* part, float* lse, int TOKG, const float* qgain, const float* kgain, const float* rel_bias,
                                          unsigned char* lds, int tid, int lane, int wave, int bid, int G) {
    LAS unsigned char* L = (LAS unsigned char*)lds;
    const int nunits = (TOKG / SEQ) * 16 * 96;
    const int c = lane & 31, hh = lane >> 5, c8 = tid & 7;
    float kg[8];
#pragma unroll
    for (int e = 0; e < 8; ++e) kg[e] = kgain[c8 * 8 + e];
    for (int u = bid; u < nunits; u += G) {
        const int i = u & 31, pbh = u >> 5, p = pbh % 3, bh = pbh / 3, h = bh & 15, bl = bh >> 4;
        const int dsh = 2 * p, d = 1 << dsh, r = i & (d - 1), qb = i >> dsh, m0 = qb * 256;
        const size_t rowb = (size_t)bl * SEQ;
        __syncthreads();
        if (tid < 192) { float tv = -INFINITY; const int dl = 160 - tid;
            if (dl >= 0 && dl <= 128) { const int dist = dl << dsh; int bk;
                if (dist < 16) bk = dist; else { const float scl = logf((float)dist / 16.f) / logf(128.f); const int lg = 16 + (int)(scl * 16.f); bk = lg < 31 ? lg : 31; }
                tv = rel_bias[bk * 16 + h] * 1.4426950408889634f; }
            ((LAS float*)(L + ATT_BIAS))[tid] = tv; }
#pragma unroll 1
        for (int it = 0; it < 6; ++it) {
            const int kk = (tid + 512 * it) >> 3, m = m0 - 128 + kk;
            v4u kw = {0u, 0u, 0u, 0u}, vw = {0u, 0u, 0u, 0u};
            if (m >= 0) { const bf16* rp = proj + (rowb + ((size_t)m << dsh) + r) * PW + h * 64 + c8 * 8; kw = *(const v4u*)(rp + 4096); vw = *(const v4u*)(rp + 5120); }
            float f[8]; unpack8(kw, f); float ss = 0.f;
#pragma unroll
            for (int e = 0; e < 8; ++e) ss += f[e] * f[e];
            ss += __shfl_xor(ss, 1); ss += __shfl_xor(ss, 2); ss += __shfl_xor(ss, 4);
            const float rs = rsqrtf(ss * (1.f / 64.f) + EPS);
            v4u ko; ko.x = pkbf(f[0] * rs * kg[0], f[1] * rs * kg[1]); ko.y = pkbf(f[2] * rs * kg[2], f[3] * rs * kg[3]); ko.z = pkbf(f[4] * rs * kg[4], f[5] * rs * kg[5]); ko.w = pkbf(f[6] * rs * kg[6], f[7] * rs * kg[7]);
            *(LAS v4u*)(L + ATT_KS + kk * ATT_KSTR + c8 * 16) = ko;
            LAS unsigned short* vt = (LAS unsigned short*)(L + ATT_VT + (c8 * 8) * ATT_VSTR + kk * 2);
            vt[0 * (ATT_VSTR / 2)] = (unsigned short)(vw.x & 0xffffu); vt[1 * (ATT_VSTR / 2)] = (unsigned short)(vw.x >> 16);
            vt[2 * (ATT_VSTR / 2)] = (unsigned short)(vw.y & 0xffffu); vt[3 * (ATT_VSTR / 2)] = (unsigned short)(vw.y >> 16);
            vt[4 * (ATT_VSTR / 2)] = (unsigned short)(vw.z & 0xffffu); vt[5 * (ATT_VSTR / 2)] = (unsigned short)(vw.z >> 16);
            vt[6 * (ATT_VSTR / 2)] = (unsigned short)(vw.w & 0xffffu); vt[7 * (ATT_VSTR / 2)] = (unsigned short)(vw.w >> 16);
        }
        const size_t orow = rowb + ((size_t)(m0 + 32 * wave + c) << dsh) + r;
        bf16x8 qf[4];
        { const bf16* qp = proj + orow * PW + 3072 + h * 64 + 8 * hh; float qv[4][8]; float ss = 0.f;
#pragma unroll
            for (int s = 0; s < 4; ++s) { unpack8(*(const v4u*)(qp + 16 * s), qv[s]);
#pragma unroll
                for (int e = 0; e < 8; ++e) ss += qv[s][e] * qv[s][e]; }
            ss += __shfl_xor(ss, 32);
            const float rs = rsqrtf(ss * (1.f / 64.f) + EPS) * (0.125f * 1.4426950408889634f);
#pragma unroll
            for (int s = 0; s < 4; ++s) { const f32x4 g0 = *(const f32x4*)(qgain + 16 * s + 8 * hh), g1 = *(const f32x4*)(qgain + 16 * s + 8 * hh + 4);
                v4u w; w.x = pkbf(qv[s][0] * rs * g0.x, qv[s][1] * rs * g0.y); w.y = pkbf(qv[s][2] * rs * g0.z, qv[s][3] * rs * g0.w);
                w.z = pkbf(qv[s][4] * rs * g1.x, qv[s][5] * rs * g1.y); w.w = pkbf(qv[s][6] * rs * g1.z, qv[s][7] * rs * g1.w); qf[s] = __builtin_bit_cast(bf16x8, w); } }
        __syncthreads();
        f32x16 sc[5];
#pragma unroll
        for (int j = 0; j < 5; ++j) {
#pragma unroll
            for (int e = 0; e < 16; ++e) sc[j][e] = 0.f;
#pragma unroll
            for (int s = 0; s < 4; ++s) { const bf16x8 kf = *(const LAS bf16x8*)(L + ATT_KS + (32 * wave + 32 * j + c) * ATT_KSTR + (16 * s + 8 * hh) * 2);
                sc[j] = __builtin_amdgcn_mfma_f32_32x32x16_bf16(kf, qf[s], sc[j], 0, 0, 0); } }
        const LAS float* tb = (const LAS float*)(L + ATT_BIAS) + (32 + 4 * hh - c);
        float mx = -INFINITY;
#pragma unroll
        for (int j = 0; j < 5; ++j)
#pragma unroll
            for (int e = 0; e < 16; ++e) sc[j][e] += tb[32 * j + (e & 3) + 8 * (e >> 2)];
        if (m0 == 0 && wave < 4) {
#pragma unroll
            for (int j = 0; j < 5; ++j)
#pragma unroll
                for (int e = 0; e < 16; ++e) if (32 * wave + 4 * hh + 32 * j + (e & 3) + 8 * (e >> 2) < 128) sc[j][e] = -INFINITY; }
#pragma unroll
        for (int j = 0; j < 5; ++j)
#pragma unroll
            for (int e = 0; e < 16; ++e) mx = fmaxf(mx, sc[j][e]);
        mx = fmaxf(mx, __shfl_xor(mx, 32));
        float l = 0.f;
#pragma unroll
        for (int j = 0; j < 5; ++j)
#pragma unroll
            for (int e = 0; e < 16; ++e) { const float pe = __builtin_amdgcn_exp2f(sc[j][e] - mx); sc[j][e] = pe; l += pe; }
        l += __shfl_xor(l, 32);
        f32x16 o[2];
#pragma unroll
        for (int e = 0; e < 16; ++e) { o[0][e] = 0.f; o[1][e] = 0.f; }
#pragma unroll
        for (int j = 0; j < 5; ++j)
#pragma unroll
            for (int s2 = 0; s2 < 2; ++s2) {
                v4u pw; pw.x = pkbf(sc[j][8 * s2 + 0], sc[j][8 * s2 + 1]); pw.y = pkbf(sc[j][8 * s2 + 2], sc[j][8 * s2 + 3]); pw.z = pkbf(sc[j][8 * s2 + 4], sc[j][8 * s2 + 5]); pw.w = pkbf(sc[j][8 * s2 + 6], sc[j][8 * s2 + 7]);
                const bf16x8 pf = __builtin_bit_cast(bf16x8, pw);
                const int kb = 32 * wave + 32 * j + 16 * s2 + 4 * hh;
#pragma unroll
                for (int dt = 0; dt < 2; ++dt) { const LAS unsigned char* vp = L + ATT_VT + (32 * dt + c) * ATT_VSTR + kb * 2;
                    const v2u lo = *(const LAS v2u*)vp, hi = *(const LAS v2u*)(vp + 16);
                    v4u vw4; vw4.x = lo.x; vw4.y = lo.y; vw4.z = hi.x; vw4.w = hi.y;
                    o[dt] = __builtin_amdgcn_mfma_f32_32x32x16_bf16(__builtin_bit_cast(bf16x8, vw4), pf, o[dt], 0, 0, 0); } }
        const float inv = 1.f / l;
        bf16* op = part + ((size_t)p * TOKG + orow) * 1024 + h * 64 + 4 * hh;
#pragma unroll
        for (int dt = 0; dt < 2; ++dt)
#pragma unroll
            for (int g4 = 0; g4 < 4; ++g4) { v2u w; w.x = pkbf(o[dt][4 * g4] * inv, o[dt][4 * g4 + 1] * inv); w.y = pkbf(o[dt][4 * g4 + 2] * inv, o[dt][4 * g4 + 3] * inv);
                *(v2u*)(op + 32 * dt + 8 * g4) = w; }
        if (hh == 0) lse[((size_t)p * TOKG + orow) * 16 + h] = mx * 0.6931471805599453f + __logf(l);
    }
}
__device__ __forceinline__ void merge_conv(const bf16* proj, const bf16* part, const float* lse, bf16* y, int TOKG, const float* convw, int lane, int gw, int ngw) {
    for (int it = gw; it < TOKG; it += ngw) {
        const int t = it & (SEQ - 1); const bf16* prow = proj + (size_t)it * PW;
#pragma unroll
        for (int i = 0; i < 2; ++i) { const int c0 = lane * 8 + 512 * i;
            float acc[8] = {0.f, 0.f, 0.f, 0.f, 0.f, 0.f, 0.f, 0.f};
#pragma unroll
            for (int dt = 0; dt < 3; ++dt) { const int tt = t - 2 + dt;
                if (tt >= 0) { const bf16* pr = prow - (size_t)(2 - dt) * PW; float gc[8], xa[8];
                    unpack8(*(const v4u*)(pr + 1024 + c0), gc); unpack8(*(const v4u*)(pr + 2048 + c0), xa);
#pragma unroll
                    for (int e = 0; e < 8; ++e) acc[e] += convw[dt * 1024 + c0 + e] * (gc[e] * xa[e]); } }
            float gb[8], z[8]; unpack8(*(const v4u*)(prow + c0), gb); unpack8(*(const v4u*)(prow + 6144 + c0), z);
            v4u o; o.x = pk2(gb[0] * acc[0] * z[0], gb[1] * acc[1] * z[1]); o.y = pk2(gb[2] * acc[2] * z[2], gb[3] * acc[3] * z[3]);
            o.z = pk2(gb[4] * acc[4] * z[4], gb[5] * acc[5] * z[5]); o.w = pk2(gb[6] * acc[6] * z[6], gb[7] * acc[7] * z[7]);
            *(v4u*)(y + (size_t)it * MW + c0) = o; }
#pragma unroll
        for (int i = 0; i < 2; ++i) { const int c0 = lane * 8 + 512 * i, h = c0 >> 6;
            const float l0 = lse[((size_t)0 * TOKG + it) * 16 + h], l1 = lse[((size_t)1 * TOKG + it) * 16 + h], l2 = lse[((size_t)2 * TOKG + it) * 16 + h];
            const float mx = fmaxf(l0, fmaxf(l1, l2)); float w0 = __expf(l0 - mx), w1 = __expf(l1 - mx), w2 = __expf(l2 - mx); const float inv = 1.f / (w0 + w1 + w2); w0 *= inv; w1 *= inv; w2 *= inv;
            float a0[8], a1[8], a2[8], z[8];
            unpack8(*(const v4u*)(part + ((size_t)0 * TOKG + it) * 1024 + c0), a0); unpack8(*(const v4u*)(part + ((size_t)1 * TOKG + it) * 1024 + c0), a1); unpack8(*(const v4u*)(part + ((size_t)2 * TOKG + it) * 1024 + c0), a2);
            unpack8(*(const v4u*)(prow + 6144 + 1024 + c0), z);
            float r[8];
#pragma unroll
            for (int e = 0; e < 8; ++e) r[e] = (w0 * a0[e] + w1 * a1[e] + w2 * a2[e]) * z[e];
            v4u o; o.x = pk2(r[0], r[1]); o.y = pk2(r[2], r[3]); o.z = pk2(r[4], r[5]); o.w = pk2(r[6], r[7]);
            *(v4u*)(y + (size_t)it * MW + 1024 + c0) = o; }
    }
}

__device__ __forceinline__ void hgrn_scalar(const bf16* proj, bf16* y, int TOKG, const float* ogain, unsigned char* lds, int tid, int lane, int wave, int bid, int G) {
    float* sq = (float*)lds; float* sf = sq + 4096; float* sk = sf + 4096; float* sv = sk + 4096; float* sop = sv + 4096;
    const int nseq = (TOKG / SEQ) * 16;
    const int v = tid & 127, kq = tid >> 7;
    for (int s = bid; s < nseq; s += G) {
        const int bl = s >> 4, h = s & 15; const size_t rowb = (size_t)bl * SEQ;
        float S[32];
#pragma unroll
        for (int i = 0; i < 32; ++i) S[i] = 0.f;
        const float og0 = ogain[h * 128 + lane], og1 = ogain[h * 128 + 64 + lane];
        for (int t0 = 0; t0 < SEQ; t0 += 32) {
#pragma unroll
            for (int i = 0; i < 8; ++i) { const int idx = tid + 512 * i, tt = idx >> 7, col = idx & 127; const bf16* prow = proj + (rowb + t0 + tt) * PW + h * 128 + col;
                sq[idx] = bf2f(prow[0]); const float f = __expf(bf2f(prow[2048])); sf[idx] = f; sk[idx] = 1.f - f; sv[idx] = bf2f(prow[4096]); }
            __syncthreads();
            for (int tt = 0; tt < 32; ++tt) {
                const float vv = sv[tt * 128 + v]; float acc = 0.f;
                const f32x4* pf = (const f32x4*)(sf + tt * 128 + kq * 32); const f32x4* pk = (const f32x4*)(sk + tt * 128 + kq * 32); const f32x4* pq = (const f32x4*)(sq + tt * 128 + kq * 32);
#pragma unroll
                for (int i4 = 0; i4 < 8; ++i4) { const f32x4 f = pf[i4], k = pk[i4], q = pq[i4];
#pragma unroll
                    for (int e = 0; e < 4; ++e) { S[i4 * 4 + e] = f[e] * S[i4 * 4 + e] + k[e] * vv; acc += q[e] * S[i4 * 4 + e]; } }
                sop[(kq * 32 + tt) * 128 + v] = acc;
            }
            __syncthreads();
#pragma unroll
            for (int i2 = 0; i2 < 4; ++i2) { const int tt = wave + 8 * i2;
                float o0 = 0.f, o1 = 0.f;
#pragma unroll
                for (int k4 = 0; k4 < 4; ++k4) { o0 += sop[(k4 * 32 + tt) * 128 + lane]; o1 += sop[(k4 * 32 + tt) * 128 + 64 + lane]; }
                const float rstd = rsqrtf(wave_sum(o0 * o0 + o1 * o1) * (1.f / 128.f) + EPS);
                const bf16* prow = proj + (rowb + t0 + tt) * PW + 6144 + h * 128;
                bf16* yr = y + (rowb + t0 + tt) * MW + h * 128;
                yr[lane] = (bf16)f2bf(o0 * rstd * og0 * bf2f(prow[lane])); yr[64 + lane] = (bf16)f2bf(o1 * rstd * og1 * bf2f(prow[64 + lane])); }
            __syncthreads();
        }
    }
}


typedef float f32x4h __attribute__((ext_vector_type(4)));
#define MFMA16(a, b, c) __builtin_amdgcn_mfma_f32_16x16x32_bf16((a), (b), (c), 0, 0, 0)
constexpr int HS = 144, HQS = 272;
constexpr int H1_KT = 0, H1_VT = 128 * HS, H1_SEG = 2 * 128 * HS;
constexpr int H3_QH = 0, H3_QM = 64 * HQS, H3_KM = 2 * 64 * HQS, H3_VT = 3 * 64 * HQS, H3_AM = H3_VT + 128 * HS, H3_SEG = H3_AM + 64 * HS, H3_RED = H3_SEG + 2048;
__device__ __forceinline__ void hgrn_h1(const bf16* proj, bf16* ST, float* dec, int TOKG, unsigned char* lds, int tid, int lane, int wave, int bid, int G) {
    LAS unsigned char* L = (LAS unsigned char*)lds;
    LAS float* segtot = (LAS float*)(L + H1_SEG);
    const int nunits = (TOKG / SEQ) * 16 * 128;
    const int col = tid & 127, seg = tid >> 7, fr = lane & 15, fq = lane >> 4;
    for (int u = bid; u < nunits; u += G) {
        const int cch = u & 127, seq = u >> 7, h = seq & 15, bl = seq >> 4;
        const bf16* pbase = proj + ((size_t)bl * SEQ + cch * 64 + seg * 16) * PW + h * 128 + col;
        float gc[16], kv[16]; float run = 0.f; unsigned vw[8];
#pragma unroll
        for (int i = 0; i < 16; ++i) { const float g = bf2f(pbase[(size_t)i * PW + 2048]); run += g; gc[i] = run; kv[i] = 1.f - __expf(g); }
#pragma unroll
        for (int i = 0; i < 8; ++i) vw[i] = (unsigned)pbase[(size_t)(2 * i) * PW + 4096] | ((unsigned)pbase[(size_t)(2 * i + 1) * PW + 4096] << 16);
        __syncthreads();
        segtot[seg * 128 + col] = run;
        { v4u a, b; a.x = vw[0]; a.y = vw[1]; a.z = vw[2]; a.w = vw[3]; b.x = vw[4]; b.y = vw[5]; b.z = vw[6]; b.w = vw[7];
          *(LAS v4u*)(L + H1_VT + col * HS + seg * 32) = a; *(LAS v4u*)(L + H1_VT + col * HS + seg * 32 + 16) = b; }
        __syncthreads();
        float pre = 0.f, tot = 0.f;
#pragma unroll
        for (int s4 = 0; s4 < 4; ++s4) { const float t = segtot[s4 * 128 + col]; tot += t; pre += (s4 < seg) ? t : 0.f; }
        { unsigned w[8];
#pragma unroll
          for (int i = 0; i < 8; ++i) w[i] = pkbf(kv[2 * i] * __expf(tot - (pre + gc[2 * i])), kv[2 * i + 1] * __expf(tot - (pre + gc[2 * i + 1])));
          v4u a, b; a.x = w[0]; a.y = w[1]; a.z = w[2]; a.w = w[3]; b.x = w[4]; b.y = w[5]; b.z = w[6]; b.w = w[7];
          *(LAS v4u*)(L + H1_KT + col * HS + seg * 32) = a; *(LAS v4u*)(L + H1_KT + col * HS + seg * 32 + 16) = b; }
        if (seg == 0) dec[(size_t)u * 128 + col] = __expf(tot);
        __syncthreads();
        f32x4h acc[8];
#pragma unroll
        for (int nk = 0; nk < 8; ++nk) acc[nk] = (f32x4h){0.f, 0.f, 0.f, 0.f};
        bf16x8 vf[2];
#pragma unroll
        for (int ks = 0; ks < 2; ++ks) vf[ks] = *(const LAS bf16x8*)(L + H1_VT + (16 * wave + fr) * HS + (32 * ks + 8 * fq) * 2);
#pragma unroll
        for (int nk = 0; nk < 8; ++nk)
#pragma unroll
            for (int ks = 0; ks < 2; ++ks) { const bf16x8 kf = *(const LAS bf16x8*)(L + H1_KT + (16 * nk + fr) * HS + (32 * ks + 8 * fq) * 2); acc[nk] = MFMA16(kf, vf[ks], acc[nk]); }
        bf16* sp = ST + (size_t)u * 16384 + (16 * wave + fr) * 128 + 4 * fq;
#pragma unroll
        for (int nk = 0; nk < 8; ++nk) { v2u w; w.x = pkbf(acc[nk][0], acc[nk][1]); w.y = pkbf(acc[nk][2], acc[nk][3]); *(v2u*)(sp + 16 * nk) = w; }
    }
}
__device__ __forceinline__ void hgrn_h2(bf16* ST, const float* dec, int TOKG, int tid, int bid, int G) {
    const int nitems = (TOKG / SEQ) * 16 * 4096;
    for (int item = bid * 512 + tid; item < nitems; item += G * 512) {
        const int seq = item >> 12, rem = item & 4095;
        bf16* p = ST + (size_t)seq * (128 * 16384) + rem * 4;
        const float* dp = dec + (size_t)seq * (128 * 128) + (rem & 31) * 4;
        f32x4 S = {0.f, 0.f, 0.f, 0.f};
        for (int c0 = 0; c0 < 128; c0 += 8) {
            v2u uw[8]; f32x4 dv[8];
#pragma unroll
            for (int i = 0; i < 8; ++i) { uw[i] = *(const v2u*)(p + (size_t)(c0 + i) * 16384); dv[i] = *(const f32x4*)(dp + (c0 + i) * 128); }
#pragma unroll
            for (int i = 0; i < 8; ++i) { v2u o; o.x = pkbf(S.x, S.y); o.y = pkbf(S.z, S.w); *(v2u*)(p + (size_t)(c0 + i) * 16384) = o;
                S.x = S.x * dv[i].x + __uint_as_float(uw[i].x << 16); S.y = S.y * dv[i].y + __uint_as_float(uw[i].x & 0xffff0000u);
                S.z = S.z * dv[i].z + __uint_as_float(uw[i].y << 16); S.w = S.w * dv[i].w + __uint_as_float(uw[i].y & 0xffff0000u); }
        }
    }
}
__device__ __forceinline__ void hgrn_h3(const bf16* proj, const bf16* ST, bf16* y, int TOKG, const float* ogain, unsigned char* lds, int tid, int lane, int wave, int bid, int G) {
    LAS unsigned char* L = (LAS unsigned char*)lds;
    LAS float* segtot = (LAS float*)(L + H3_SEG); LAS float* red = (LAS float*)(L + H3_RED);
    const int nunits = (TOKG / SEQ) * 16 * 128;
    const int col = tid & 127, seg = tid >> 7, fr = lane & 15, fq = lane >> 4;
    for (int u = bid; u < nunits; u += G) {
        const int cch = u & 127, seq = u >> 7, h = seq & 15, bl = seq >> 4;
        const size_t rowc = (size_t)bl * SEQ + cch * 64;
        const bf16* pbase = proj + (rowc + seg * 16) * PW + h * 128 + col;
        bf16x8 sf[4];
        { const bf16* sp = ST + (size_t)u * 16384 + (16 * wave + fr) * 128 + 8 * fq;
#pragma unroll
          for (int ks = 0; ks < 4; ++ks) sf[ks] = *(const bf16x8*)(sp + 32 * ks); }
        float gc[16], kv[16], qv[16]; float run = 0.f; unsigned vw[8];
#pragma unroll
        for (int i = 0; i < 16; ++i) { const float g = bf2f(pbase[(size_t)i * PW + 2048]); run += g; gc[i] = run; kv[i] = 1.f - __expf(g); qv[i] = bf2f(pbase[(size_t)i * PW]); }
#pragma unroll
        for (int i = 0; i < 8; ++i) vw[i] = (unsigned)pbase[(size_t)(2 * i) * PW + 4096] | ((unsigned)pbase[(size_t)(2 * i + 1) * PW + 4096] << 16);
        __syncthreads();
        segtot[seg * 128 + col] = run;
        { v4u a, b; a.x = vw[0]; a.y = vw[1]; a.z = vw[2]; a.w = vw[3]; b.x = vw[4]; b.y = vw[5]; b.z = vw[6]; b.w = vw[7];
          *(LAS v4u*)(L + H3_VT + col * HS + seg * 32) = a; *(LAS v4u*)(L + H3_VT + col * HS + seg * 32 + 16) = b; }
        __syncthreads();
        { float pre = 0.f;
#pragma unroll
          for (int s4 = 0; s4 < 4; ++s4) { const float t = segtot[s4 * 128 + col]; pre += (s4 < seg) ? t : 0.f; }
          const float gref = segtot[col] + segtot[128 + col];
#pragma unroll
          for (int i = 0; i < 16; ++i) { const float gcum = pre + gc[i]; const int s = seg * 16 + i;
              *(LAS unsigned short*)(L + H3_QH + s * HQS + col * 2) = (unsigned short)f2bf(qv[i] * __expf(gcum));
              *(LAS unsigned short*)(L + H3_QM + s * HQS + col * 2) = (unsigned short)f2bf(qv[i] * __expf(fminf(gcum - gref, 80.f)));
              *(LAS unsigned short*)(L + H3_KM + s * HQS + col * 2) = (unsigned short)f2bf(kv[i] * __expf(fminf(gref - gcum, 80.f))); } }
        __syncthreads();
        { const int tt = wave >> 1;
#pragma unroll
          for (int ss2 = 0; ss2 < 2; ++ss2) { const int ss = 2 * (wave & 1) + ss2; f32x4h a = {0.f, 0.f, 0.f, 0.f};
              if (ss <= tt) {
#pragma unroll
                  for (int ks = 0; ks < 4; ++ks) { const bf16x8 kmf = *(const LAS bf16x8*)(L + H3_KM + (16 * ss + fr) * HQS + (32 * ks + 8 * fq) * 2);
                      const bf16x8 qmf = *(const LAS bf16x8*)(L + H3_QM + (16 * tt + fr) * HQS + (32 * ks + 8 * fq) * 2); a = MFMA16(kmf, qmf, a); } }
              const int t = 16 * tt + fr, s0 = 16 * ss + 4 * fq;
              v2u w; w.x = pkbf(s0 <= t ? a[0] : 0.f, s0 + 1 <= t ? a[1] : 0.f); w.y = pkbf(s0 + 2 <= t ? a[2] : 0.f, s0 + 3 <= t ? a[3] : 0.f);
              *(LAS v2u*)(L + H3_AM + t * HS + s0 * 2) = w; } }
        __syncthreads();
        f32x4h acc[4];
#pragma unroll
        for (int t2 = 0; t2 < 4; ++t2) acc[t2] = (f32x4h){0.f, 0.f, 0.f, 0.f};
#pragma unroll
        for (int t2 = 0; t2 < 4; ++t2)
#pragma unroll
            for (int ks = 0; ks < 4; ++ks) { const bf16x8 qf = *(const LAS bf16x8*)(L + H3_QH + (16 * t2 + fr) * HQS + (32 * ks + 8 * fq) * 2); acc[t2] = MFMA16(sf[ks], qf, acc[t2]); }
        bf16x8 vf[2];
#pragma unroll
        for (int ks = 0; ks < 2; ++ks) vf[ks] = *(const LAS bf16x8*)(L + H3_VT + (16 * wave + fr) * HS + (32 * ks + 8 * fq) * 2);
#pragma unroll
        for (int t2 = 0; t2 < 4; ++t2)
#pragma unroll
            for (int ks = 0; ks < 2; ++ks) { const bf16x8 af = *(const LAS bf16x8*)(L + H3_AM + (16 * t2 + fr) * HS + (32 * ks + 8 * fq) * 2); acc[t2] = MFMA16(vf[ks], af, acc[t2]); }
#pragma unroll
        for (int t2 = 0; t2 < 4; ++t2) { float ss = acc[t2][0] * acc[t2][0] + acc[t2][1] * acc[t2][1] + acc[t2][2] * acc[t2][2] + acc[t2][3] * acc[t2][3];
            ss += __shfl_xor(ss, 16); ss += __shfl_xor(ss, 32); if (fq == 0) red[wave * 64 + 16 * t2 + fr] = ss; }
        __syncthreads();
        const int v0 = 16 * wave + 4 * fq; const f32x4 og = *(const f32x4*)(ogain + h * 128 + v0);
#pragma unroll
        for (int t2 = 0; t2 < 4; ++t2) { const int t = 16 * t2 + fr; float tot = 0.f;
#pragma unroll
            for (int w8 = 0; w8 < 8; ++w8) tot += red[w8 * 64 + t];
            const float rstd = rsqrtf(tot * (1.f / 128.f) + EPS);
            const v2u zw = *(const v2u*)(proj + (rowc + t) * PW + 6144 + h * 128 + v0);
            v2u w; w.x = pkbf(acc[t2][0] * rstd * og.x * __uint_as_float(zw.x << 16), acc[t2][1] * rstd * og.y * __uint_as_float(zw.x & 0xffff0000u));
            w.y = pkbf(acc[t2][2] * rstd * og.z * __uint_as_float(zw.y << 16), acc[t2][3] * rstd * og.w * __uint_as_float(zw.y & 0xffff0000u));
            *(v2u*)(y + (rowc + t) * MW + h * 128 + v0) = w; }
    }
}

#define XB_TMO      128
#define XB_XCNT(j)  (256  + 64 * (j))
#define XB_XSUB(j)  (1280 + 64 * (j))
#define XB_XGEN(j)  (2304 + 64 * (j))
#define XB_TOP      3328
#define XB_TOPGEN   3392
#define XCD_BAR_WORDS 3456
#define XB_SPIN_CAP (1u << 18)

__device__ __forceinline__ unsigned xb_ld(unsigned* p)              { return __hip_atomic_load(p, __ATOMIC_RELAXED, __HIP_MEMORY_SCOPE_AGENT); }
__device__ __forceinline__ unsigned xb_add(unsigned* p, unsigned v) { return __hip_atomic_fetch_add(p, v, __ATOMIC_RELAXED, __HIP_MEMORY_SCOPE_AGENT); }
__device__ __forceinline__ unsigned xb_xcc_id() { return (unsigned)__builtin_amdgcn_s_getreg((3 << 11) | 20) & 0xFu; }
#define XB_SPIN(cond, bar) do { unsigned _sp = 0; while (cond) { __builtin_amdgcn_s_sleep(1); \
    if ((++_sp & 255u) == 0u) { if (xb_ld(&(bar)[XB_TMO])) break; if (_sp > XB_SPIN_CAP) { atomicAdd(&(bar)[XB_TMO], 1u); break; } } } } while (0)

struct XcdBarrier {
    unsigned* bar; unsigned x;
    volatile LAS unsigned* st;
};

__device__ __forceinline__ XcdBarrier xcd_barrier_post(unsigned* bar, volatile LAS unsigned* st) {
    XcdBarrier b; b.bar = bar; b.x = xb_xcc_id(); b.st = st;
    if (threadIdx.x == 0) (void)xb_add(&bar[XB_XCNT(b.x)], 1u);
    return b;
}
__device__ __forceinline__ void xcd_barrier_complete(unsigned* bar, unsigned x, unsigned& nloc, unsigned& nx) {
    const unsigned G = gridDim.x * gridDim.y * gridDim.z;
    unsigned sum, cnt, mine, sp = 0u;
    for (;;) {
        sum = 0u; cnt = 0u; mine = 0u;
#pragma unroll
        for (unsigned j = 0; j < 16; ++j) { const unsigned c = xb_ld(&bar[XB_XCNT(j)]); sum += c; cnt += (c > 0u) ? 1u : 0u; mine = (j == x) ? c : mine; }
        if (sum == G) break;
        __builtin_amdgcn_s_sleep(1);
        if ((++sp & 255u) == 0u) { if (xb_ld(&bar[XB_TMO])) break; if (sp > XB_SPIN_CAP) { atomicAdd(&bar[XB_TMO], 1u); break; } }
    }
    nloc = mine > 0u ? mine : 1u; nx = cnt > 0u ? cnt : 1u;
}

__device__ __forceinline__ void xcd_barrier(const XcdBarrier& b) {
    asm volatile("s_waitcnt vmcnt(0)" ::: "memory");
    __syncthreads();
    if (threadIdx.x == 0) {
        unsigned* bar = b.bar;
        __builtin_amdgcn_s_waitcnt(0);
        unsigned nloc = b.st[0], nx = b.st[1];
        if (nloc == 0u) { xcd_barrier_complete(bar, b.x, nloc, nx); b.st[0] = nloc; b.st[1] = nx; }
        const unsigned old = xb_add(&bar[XB_XSUB(b.x)], 1u);
        const unsigned gen = old / nloc;
        if (old + 1u == (gen + 1u) * nloc) {
            __builtin_amdgcn_fence(__ATOMIC_RELEASE, "agent");
            asm volatile("s_waitcnt vmcnt(0)" ::: "memory");
            const unsigned og = xb_add(&bar[XB_TOP], 1u);
            const unsigned tg = og / nx;
            if (og + 1u == (tg + 1u) * nx) xb_add(&bar[XB_TOPGEN], 1u);
            else XB_SPIN(xb_ld(&bar[XB_TOPGEN]) == tg, bar);
            __builtin_amdgcn_fence(__ATOMIC_ACQUIRE, "agent");
            xb_add(&bar[XB_XGEN(b.x)], 1u);
            asm volatile("s_waitcnt vmcnt(0)" ::: "memory");
        } else {
            XB_SPIN(xb_ld(&bar[XB_XGEN(b.x)]) == gen, bar);
            __builtin_amdgcn_fence(__ATOMIC_ACQUIRE, "agent");
            asm volatile("s_waitcnt vmcnt(0)" ::: "memory");
        }
    }
    __syncthreads();
}

__device__ __forceinline__ unsigned long long ldptr(LAS unsigned long long* tab, int i) { asm volatile("" ::: "memory"); const unsigned long long v = tab[i];
    const unsigned lo = __builtin_amdgcn_readfirstlane((unsigned)v), hi = __builtin_amdgcn_readfirstlane((unsigned)(v >> 32)); return ((unsigned long long)hi << 32) | lo; }
struct Args { const float* in[13]; float* out; unsigned char* ws; int ngroups; int pad; };
struct Ctx { int layer, g, NG, TOKG, j, even, tid, lane, wave, G, bid, gw, ngw; unsigned char* wsb; bf16 *Wt_in, *Wt_out, *proj, *ybuf, *xn; float* lbtab; size_t row0; };
__device__ __forceinline__ Ctx load_ctx(LAS unsigned long long* ptab) {
    Ctx c; const int step = (int)ldptr(ptab, 16); c.NG = (int)ldptr(ptab, 15); c.layer = step / c.NG; c.g = step - c.layer * c.NG; c.TOKG = NTOK / c.NG; c.j = c.layer >> 1; c.even = !(c.layer & 1);
    int tid_raw = threadIdx.x; asm volatile("" : "+v"(tid_raw)); c.tid = tid_raw; c.lane = c.tid & 63; c.wave = __builtin_amdgcn_readfirstlane(c.tid >> 6);
    c.G = gridDim.x; c.bid = blockIdx.x; c.gw = c.bid * 8 + c.wave; c.ngw = c.G * 8;
    c.wsb = (unsigned char*)ldptr(ptab, 14);
    c.Wt_in = (bf16*)(c.wsb + WS_WIN); c.Wt_out = (bf16*)(c.wsb + WS_WOUT); c.lbtab = (float*)(c.wsb + WS_MISC); c.proj = (bf16*)(c.wsb + WS_PROJ);
    c.ybuf = (bf16*)(c.wsb + WS_PROJ + (size_t)c.TOKG * (PW * 2)); c.xn = (bf16*)(c.wsb + WS_PROJ + (size_t)c.TOKG * (PW * 2 + MW * 2));
    c.row0 = (size_t)c.g * c.TOKG; return c;
}
#define ARGP(i) ((const float*)ldptr(ptab, (i)))
__global__ void __launch_bounds__(512, 2) fwd(Args a) {
    extern __shared__ __attribute__((aligned(16))) unsigned char lds[];
    cg::grid_group grid = cg::this_grid();
    LAS unsigned long long* ptab = (LAS unsigned long long*)((LAS unsigned char*)lds + 131072 + 1024);
    if (threadIdx.x == 0) {
#pragma unroll
        for (int i = 0; i < 13; ++i) ptab[i] = (unsigned long long)a.in[i];
        ptab[13] = (unsigned long long)a.out; ptab[14] = (unsigned long long)a.ws; ptab[15] = (unsigned long long)a.ngroups; ptab[16] = 0ull;
        ((LAS unsigned*)(ptab + 24))[0] = 0u; ((LAS unsigned*)(ptab + 24))[1] = 0u; }
    __syncthreads();
    (void)xcd_barrier_post((unsigned*)(ldptr(ptab, 14) + WS_BAR), (volatile LAS unsigned*)(ptab + 24));
#define GSYNC() do { XcdBarrier b_; b_.bar = (unsigned*)(ldptr(ptab, 14) + WS_BAR); b_.x = xb_xcc_id(); b_.st = (volatile LAS unsigned*)(ptab + 24); xcd_barrier(b_); } while (0)
    for (;;) {
        {
            const Ctx c = load_ctx(ptab);
            if (c.g == 0) {
                const float* w_in = (c.even ? ARGP(2) : ARGP(9)) + (size_t)c.j * D * PW;
                const float* ln = (c.even ? ARGP(1) : ARGP(8)) + (size_t)c.j * D;
                const float* w_out = (c.even ? ARGP(6) : ARGP(12)) + (size_t)c.j * MW * D;
                LAS float* scr = (LAS float*)((LAS unsigned char*)lds + c.wave * 16384);
                constexpr int I_IN = (D / 64) * (PW / 32), I_OUT = (MW / 64) * (D / 32);
                for (int it = c.gw; it < I_IN + I_OUT; it += c.ngw) {
                    if (it < I_IN) transpose_item(w_in, D, PW, ln, c.Wt_in, scr, it, c.lane);
                    else transpose_item(w_out, MW, D, nullptr, c.Wt_out, scr, it - I_IN, c.lane);
                }
                if (!c.even && c.bid == 0) { const float* lbp = ARGP(10);
                    for (int col = c.tid; col < 2048; col += 512) c.lbtab[col] = (c.j == 0) ? 0.f : 1.f / (1.f + expf(lbp[col] - lbp[2048 + col])); }
            }
            const float* xsrc = (c.layer == 0) ? ARGP(0) : ARGP(13);
            norm_rows(xsrc + c.row0 * D, c.xn, c.TOKG, c.gw, c.ngw, c.lane);
        }
        if ((int)ldptr(ptab, 16) == 0) grid.sync(); else GSYNC();
        {
            const Ctx c = load_ctx(ptab);
            pg8::Gemm gm{c.xn, c.Wt_in, c.TOKG, PW, D}; pg8::StaticOrder S; S.init(c.TOKG, PW, c.G, c.bid); EpiProj E{c.proj, c.even ? 0 : 1, c.lbtab};
            pg8::gemm_phase<EpiProj, pg8::StaticOrder, true, true>((PG8_LAS unsigned char*)lds, gm, S, E);
        }
        GSYNC();
        {
            const Ctx c = load_ctx(ptab);
            if (c.even) {
                attn_mfma(c.proj, c.xn, (float*)(c.xn + (size_t)c.TOKG * 3072), c.TOKG, ARGP(4) + c.j * 64, ARGP(5) + c.j * 64, ARGP(7), lds, c.tid, c.lane, c.wave, c.bid, c.G);
            } else {
                hgrn_h1(c.proj, c.xn, (float*)(c.wsb + WS_MISC + MiB), c.TOKG, lds, c.tid, c.lane, c.wave, c.bid, c.G);
            }
        }
        GSYNC();
        {
            const Ctx c = load_ctx(ptab);
            if (c.even) merge_conv(c.proj, c.xn, (const float*)(c.xn + (size_t)c.TOKG * 3072), c.ybuf, c.TOKG, ARGP(3) + c.j * 3 * 1024, c.lane, c.gw, c.ngw);
            else hgrn_h2(c.xn, (const float*)(c.wsb + WS_MISC + MiB), c.TOKG, c.tid, c.bid, c.G);
        }
        GSYNC();
        {
            const Ctx c = load_ctx(ptab);
            if (!c.even) hgrn_h3(c.proj, c.xn, c.ybuf, c.TOKG, ARGP(11) + c.j * MW, lds, c.tid, c.lane, c.wave, c.bid, c.G);
        }
        GSYNC();
        {
            const Ctx c = load_ctx(ptab);
            const float* xsrc = (c.layer == 0) ? ARGP(0) : ARGP(13);
            pg8::Gemm gm{c.ybuf, c.Wt_out, c.TOKG, D, MW}; pg8::StaticOrder S; S.init(c.TOKG, D, c.G, c.bid); EpiRes E{xsrc + c.row0 * D, (float*)ARGP(13) + c.row0 * D};
            pg8::gemm_phase<EpiRes, pg8::StaticOrder, true, true>((PG8_LAS unsigned char*)lds, gm, S, E);
        }
        GSYNC();
        const int step = (int)ldptr(ptab, 16), nsteps = 4 * (int)ldptr(ptab, 15);
        __syncthreads();
        if (threadIdx.x == 0) ptab[16] = (unsigned long long)(step + 1);
        __syncthreads();
        if (step + 1 >= nsteps) break;
    }
}

extern "C" void kernel_launch(void* const* d_in, const int* in_sizes, int n_in, void* d_out, int out_size, void* d_ws, size_t ws_size, hipStream_t stream) {
    static int grid = 0;
    if (grid == 0) {
        int dev = 0, cus = 0, per_cu = 0;
        if (hipGetDevice(&dev) != hipSuccess || hipDeviceGetAttribute(&cus, hipDeviceAttributeMultiprocessorCount, dev) != hipSuccess) { fprintf(stderr, "kernel_launch: device query failed\n"); grid = -1; return; }
        if (hipFuncSetAttribute((const void*)fwd, hipFuncAttributeMaxDynamicSharedMemorySize, LDS_BYTES) != hipSuccess) { fprintf(stderr, "kernel_launch: hipFuncSetAttribute failed\n"); grid = -1; return; }
        if (hipOccupancyMaxActiveBlocksPerMultiprocessor(&per_cu, (const void*)fwd, 512, LDS_BYTES) != hipSuccess || per_cu < 1) fprintf(stderr, "kernel_launch: occupancy query reports %d\n", per_cu);
        (void)hipGetLastError();
        grid = cus;
    }
    if (grid < 0) return;
    Args a{};
    for (int i = 0; i < 13; ++i) a.in[i] = (const float*)d_in[i];
    a.out = (float*)d_out; a.ws = (unsigned char*)d_ws;
    a.ngroups = (ws_size >= (size_t)472 * MiB) ? 2 : 4;
    if (hipMemsetAsync((char*)d_ws + WS_BAR, 0, 16384, stream) != hipSuccess) { fprintf(stderr, "kernel_launch: memset failed\n"); return; }
    void* args[] = {&a};
    hipError_t e = hipLaunchCooperativeKernel((const void*)fwd, dim3(grid), dim3(512), args, LDS_BYTES, stream);
    if (e != hipSuccess) fprintf(stderr, "kernel_launch: cooperative launch failed: %s (grid %d)\n", hipGetErrorString(e), grid);
}
```

```cpp
#include <hip/hip_runtime.h>
#include <hip/hip_cooperative_groups.h>
#include <cstdio>
#include <cstdint>
namespace cg = cooperative_groups;
namespace pg8 {
#define PG8_LAS __attribute__((address_space(3)))
typedef unsigned short bf16_t;
typedef short bf16x8 __attribute__((ext_vector_type(8)));
typedef float f32x4 __attribute__((ext_vector_type(4)));
typedef unsigned u32x4 __attribute__((ext_vector_type(4)));
constexpr int BM = 256, BK = 64, HALF = 128, HTB = HALF * BK * 2  , STAGE_BYTES = 8 * HTB, NXCD = 8, WGM = 8;

__host__ __device__ __forceinline__ int lds_byte(int r, int c) { const int st = (r >> 4) * 2 + (c >> 5), rr = r & 15, cc = c & 31, ob = rr * 64 + cc * 2; return st * 1024 + (ob ^ (((ob >> 9) & 1) << 5)); }
__host__ __device__ __forceinline__ void stage_rc(int b, int& R, int& C) { const int st = b / 1024, sb = b % 1024, swz = sb ^ (((sb >> 9) & 1) << 5); R = (st >> 1) * 16 + swz / 64; C = (st & 1) * 32 + (swz % 64) / 2; }
__host__ __device__ __forceinline__ int perm32(int rho) { const int n = rho >> 4, i = rho & 15; return 8 * (i >> 2) + 4 * n + (i & 3); }

struct Unit { int pm, pn; };
struct Gemm { const bf16_t* A; const bf16_t* Bt; int M, N, K; };

struct StaticOrder {
    int nM, nN, nwg, G, c;
    __host__ __device__ void init(int M, int N, int G_, int c_) { nM = M / BM; nN = N / BM; nwg = nM * nN; G = G_; c = c_; }
    __host__ __device__ bool next(int i, Unit& u) const {
        const long L = (long)i * G + c; if (L >= nwg) return false;
        int wgid = (int)L; { const int q = nwg / NXCD, r = nwg % NXCD, xcd = wgid % NXCD, off = wgid / NXCD; wgid = (xcd < r ? xcd * (q + 1) : r * (q + 1) + (xcd - r) * q) + off; }
        const int nig = WGM * nN, gid = wgid / nig, fm = gid * WGM, gsz = (nM - fm) < WGM ? (nM - fm) : WGM;
        u.pm = fm + ((wgid % nig) % gsz); u.pn = (wgid % nig) / gsz; return true;
    }
    __device__ __forceinline__ void a_ready(const Unit&) const {}
    __device__ __forceinline__ void done(const Unit&) const {}
};

__device__ __forceinline__ unsigned cvt_pk_bf16(float lo, float hi) { unsigned r; asm volatile("v_cvt_pk_bf16_f32 %0, %1, %2" : "=v"(r) : "v"(lo), "v"(hi)); return r; }
template <class Epi, class Sched, bool ALIGN_EPI = false, bool SP2 = false>
__device__ __forceinline__ void gemm_phase(PG8_LAS unsigned char* lds, const Gemm g, const Sched& S, const Epi& E) {
    int tid_raw = threadIdx.x; asm volatile("" : "+v"(tid_raw)); const int tid = tid_raw, wid = __builtin_amdgcn_readfirstlane(tid >> 6), lane = tid & 63, wr = wid >> 2, wc = wid & 3, fr = lane & 15, fq = lane >> 4;
    const int K = g.K, nt = K / BK;
    unsigned voffA[2], voffB[2];
#pragma unroll
    for (int i = 0; i < 2; ++i) { int R, C; stage_rc(tid * 16 + i * 8192, R, C); const int Rb = Epi::PERM ? ((R & ~31) + perm32(R & 31)) : R;
        voffA[i] = (unsigned)(R * K + C) * 2u; voffB[i] = (unsigned)(Rb * K + C) * 2u; }
    const size_t kstep = (size_t)(BK * 2);
    const size_t hstep = (size_t)HALF * K * 2;
    const size_t tstep = 2 * hstep;
    const unsigned ldsw = (unsigned)wid * 1024u;
    const int aoff = lds_byte(wr * 64 + fr, fq * 8), boff = lds_byte(wc * 32 + fr, fq * 8);
#define PG8_SA(b, h) (((b) * 2 + (h)) * HTB)
#define PG8_SB(b, h) ((4 + (b) * 2 + (h)) * HTB)
#define PG8_STAGE(bufoff, gbase, voff) do { _Pragma("unroll") for (int _i = 0; _i < 2; ++_i) \
        __builtin_amdgcn_global_load_lds((const unsigned*)((const char*)(gbase) + (voff)[_i]), (PG8_LAS unsigned*)(lds + (bufoff) + ldsw + _i * 8192), 16, 0, 0); } while (0)
#define PG8_LDA(dst, b, h) do { _Pragma("unroll") for (int m = 0; m < 4; ++m) _Pragma("unroll") for (int k = 0; k < 2; ++k) dst[m][k] = *(const PG8_LAS bf16x8*)(lds + PG8_SA(b, h) + aoff + m * 2048 + k * 1024); } while (0)
#define PG8_LDB(dst, b, h) do { _Pragma("unroll") for (int n = 0; n < 2; ++n) _Pragma("unroll") for (int k = 0; k < 2; ++k) dst[n][k] = *(const PG8_LAS bf16x8*)(lds + PG8_SB(b, h) + boff + n * 2048 + k * 1024); } while (0)
#define PG8_MMA(ai, bj, At, Bt) do { __builtin_amdgcn_s_setprio(1); _Pragma("unroll") for (int m = 0; m < 4; ++m) _Pragma("unroll") for (int n = 0; n < 2; ++n) _Pragma("unroll") for (int k = 0; k < 2; ++k) \
        acc[ai][bj][m][n] = __builtin_amdgcn_mfma_f32_16x16x32_bf16(Bt[n][k], At[m][k], acc[ai][bj][m][n], 0, 0, 0); __builtin_amdgcn_s_setprio(0); } while (0)
#define PG8_WAIT_V(n) asm volatile("s_waitcnt vmcnt(" #n ")" ::: "memory")
#define PG8_WAIT_L(n) asm volatile("s_waitcnt lgkmcnt(" #n ")" ::: "memory")
#define PG8_BAR __builtin_amdgcn_s_barrier()
#define PG8_SCHED __builtin_amdgcn_sched_barrier(0)
    Unit cur, nxt; int ui = 0;
    if (!S.next(0, cur)) return;
    f32x4 acc[2][2][4][2];
#pragma unroll
    for (int a = 0; a < 2; ++a)
#pragma unroll
        for (int b = 0; b < 2; ++b)
#pragma unroll
            for (int m = 0; m < 4; ++m)
#pragma unroll
                for (int n = 0; n < 2; ++n) acc[a][b][m][n] = (f32x4){0.f, 0.f, 0.f, 0.f};
    bf16x8 At[4][2], B0[2][2], B1[2][2];
    const char* cA = (const char*)g.A + (size_t)cur.pm * tstep; const char* cB = (const char*)g.Bt + (size_t)cur.pn * tstep;
    S.a_ready(cur);
    if constexpr (SP2) {
        PG8_STAGE(PG8_SB(0, 0), cB, voffB); PG8_STAGE(PG8_SB(0, 1), cB + hstep, voffB); PG8_STAGE(PG8_SA(0, 0), cA, voffA); PG8_STAGE(PG8_SA(0, 1), cA + hstep, voffA);
        if (wr == 1) PG8_BAR;
        PG8_WAIT_V(2); PG8_BAR;
        PG8_STAGE(PG8_SB(1, 0), cB + kstep, voffB); PG8_STAGE(PG8_SA(1, 0), cA + kstep, voffA); PG8_STAGE(PG8_SB(1, 1), cB + hstep + kstep, voffB);
        PG8_WAIT_V(6); PG8_BAR;
    } else {
        PG8_STAGE(PG8_SB(0, 0), cB, voffB); PG8_STAGE(PG8_SA(0, 0), cA, voffA); PG8_STAGE(PG8_SB(0, 1), cB + hstep, voffB); PG8_STAGE(PG8_SA(0, 1), cA + hstep, voffA);
        if (wr == 1) PG8_BAR;
        PG8_WAIT_V(4); PG8_BAR;
        PG8_STAGE(PG8_SB(1, 0), cB + kstep, voffB); PG8_STAGE(PG8_SA(1, 0), cA + kstep, voffA); PG8_STAGE(PG8_SB(1, 1), cB + hstep + kstep, voffB);
        PG8_WAIT_V(6); PG8_BAR;
    }
    for (;;) {
        const bool has_next = S.next(ui + 1, nxt);
        const char* nA = has_next ? (const char*)g.A + (size_t)nxt.pm * tstep : cA; const char* nB = has_next ? (const char*)g.Bt + (size_t)nxt.pn * tstep : cB;
        for (int t = 0; t < nt; t += 2) {
            const bool last = (t == nt - 2);
            const char* a1 = cA + (size_t)(t + 1) * kstep;
            const char* a2 = last ? nA : cA + (size_t)(t + 2) * kstep; const char* b2 = last ? nB : cB + (size_t)(t + 2) * kstep;
            const char* a3 = a2 + kstep; const char* b3 = b2 + kstep;
            if (last && has_next) S.a_ready(nxt);
            if constexpr (SP2) {
            PG8_LDB(B0, 0, 0); PG8_LDB(B1, 0, 1); PG8_SCHED; PG8_LDA(At, 0, 0); PG8_STAGE(PG8_SA(1, 1), a1 + hstep, voffA);
            PG8_WAIT_V(8); PG8_WAIT_L(0); PG8_BAR; PG8_MMA(0, 0, At, B0); PG8_MMA(0, 1, At, B1); PG8_BAR; PG8_SCHED;
            PG8_LDA(At, 0, 1); PG8_STAGE(PG8_SB(0, 0), b2, voffB); PG8_STAGE(PG8_SB(0, 1), b2 + hstep, voffB); PG8_STAGE(PG8_SA(0, 0), a2, voffA);
            PG8_WAIT_V(8); PG8_WAIT_L(0); PG8_BAR; PG8_MMA(1, 0, At, B0); PG8_MMA(1, 1, At, B1); PG8_BAR; PG8_SCHED;
            PG8_LDB(B0, 1, 0); PG8_LDB(B1, 1, 1); PG8_SCHED; PG8_LDA(At, 1, 0); PG8_STAGE(PG8_SA(0, 1), a2 + hstep, voffA);
            PG8_WAIT_V(8); PG8_WAIT_L(0); PG8_BAR; PG8_MMA(0, 0, At, B0); PG8_MMA(0, 1, At, B1); PG8_BAR; PG8_SCHED;
            PG8_LDA(At, 1, 1); PG8_STAGE(PG8_SB(1, 0), b3, voffB); PG8_STAGE(PG8_SB(1, 1), b3 + hstep, voffB); PG8_STAGE(PG8_SA(1, 0), a3, voffA);
            PG8_WAIT_V(8); PG8_WAIT_L(0); PG8_BAR; PG8_MMA(1, 0, At, B0); PG8_MMA(1, 1, At, B1); PG8_BAR; PG8_SCHED;
            } else {
            PG8_LDB(B0, 0, 0); PG8_SCHED; PG8_LDA(At, 0, 0); PG8_STAGE(PG8_SA(1, 1), a1 + hstep, voffA);
            PG8_WAIT_L(8); PG8_BAR; PG8_WAIT_L(0); PG8_MMA(0, 0, At, B0); PG8_BAR; PG8_SCHED;
            PG8_LDB(B1, 0, 1); PG8_STAGE(PG8_SB(0, 0), b2, voffB);
            PG8_BAR; PG8_WAIT_L(0); PG8_MMA(0, 1, At, B1); PG8_BAR;
            PG8_LDA(At, 0, 1); PG8_STAGE(PG8_SA(0, 0), a2, voffA);
            PG8_BAR; PG8_WAIT_L(0); PG8_MMA(1, 0, At, B0); PG8_BAR; PG8_SCHED;
            PG8_STAGE(PG8_SB(0, 1), b2 + hstep, voffB);
            PG8_WAIT_V(6); PG8_BAR; PG8_MMA(1, 1, At, B1); PG8_BAR;
            PG8_LDB(B0, 1, 0); PG8_SCHED; PG8_LDA(At, 1, 0); PG8_STAGE(PG8_SA(0, 1), a2 + hstep, voffA);
            PG8_WAIT_L(8); PG8_BAR; PG8_WAIT_L(0); PG8_MMA(0, 0, At, B0); PG8_BAR; PG8_SCHED;
            PG8_LDB(B1, 1, 1); PG8_STAGE(PG8_SB(1, 0), b3, voffB);
            PG8_BAR; PG8_WAIT_L(0); PG8_MMA(0, 1, At, B1); PG8_BAR;
            PG8_LDA(At, 1, 1); PG8_STAGE(PG8_SA(1, 0), a3, voffA);
            PG8_BAR; PG8_WAIT_L(0); PG8_MMA(1, 0, At, B0); PG8_BAR; PG8_SCHED;
            PG8_STAGE(PG8_SB(1, 1), b3 + hstep, voffB);
            PG8_WAIT_V(6); PG8_BAR; PG8_MMA(1, 1, At, B1); PG8_BAR;
            }
        }
        if constexpr (ALIGN_EPI) { if (wr == 0) PG8_BAR; }
        if constexpr (!Epi::AFTER_DRAIN) { E(acc, cur, wr, wc, fr, fq); S.done(cur); }
        if (!has_next) break;
#pragma unroll
        for (int a = 0; a < 2; ++a)
#pragma unroll
            for (int b = 0; b < 2; ++b)
#pragma unroll
                for (int m = 0; m < 4; ++m)
#pragma unroll
                    for (int n = 0; n < 2; ++n) acc[a][b][m][n] = (f32x4){0.f, 0.f, 0.f, 0.f};
        cur = nxt; cA = nA; cB = nB; ++ui;
        if constexpr (ALIGN_EPI) { if (wr == 1) PG8_BAR; }
    }
    PG8_WAIT_V(0);
    if constexpr (!ALIGN_EPI) { if (wr == 0) PG8_BAR; }
    PG8_BAR;
    if constexpr (Epi::AFTER_DRAIN) { E.fused(acc, cur, wr, wc, fr, fq, lds, wid, lane); S.done(cur); }
#undef PG8_SA
#undef PG8_SB
#undef PG8_STAGE
#undef PG8_LDA
#undef PG8_LDB
#undef PG8_MMA
#undef PG8_WAIT_V
#undef PG8_WAIT_L
#undef PG8_BAR
#undef PG8_SCHED
}
}

constexpr int D = 1024, SEQ = 8192, NBATCH = 4, NTOK = NBATCH * SEQ, PW = 8192, MW = 2048;
constexpr float EPS = 1e-6f;
constexpr size_t MiB = 1u << 20;
constexpr size_t WS_WIN = 0, WS_WOUT = 16 * MiB, WS_MISC = 20 * MiB, WS_BAR = 23 * MiB, WS_PROJ = 24 * MiB;
constexpr int LDS_BYTES = 147456;
typedef unsigned short bf16;
typedef unsigned v4u __attribute__((ext_vector_type(4)));
typedef float f32x4 __attribute__((ext_vector_type(4)));
#define LAS __attribute__((address_space(3)))

__device__ __forceinline__ float bf2f(unsigned short b) { return __uint_as_float(((unsigned)b) << 16); }
__device__ __forceinline__ unsigned f2bf(float f) { unsigned u = __float_as_uint(f); return (u + 0x7fffu + ((u >> 16) & 1u)) >> 16; }
__device__ __forceinline__ unsigned pk2(float lo, float hi) { return f2bf(lo) | (f2bf(hi) << 16); }
__device__ __forceinline__ float wave_sum(float v) {
#pragma unroll
    for (int o = 1; o < 64; o <<= 1) v += __shfl_xor(v, o);
    return v;
}
__device__ __forceinline__ float wave_max(float v) {
#pragma unroll
    for (int o = 1; o < 64; o <<= 1) v = fmaxf(v, __shfl_xor(v, o));
    return v;
}
__device__ __forceinline__ float silu_f(float x) { return x / (1.f + __expf(-x)); }
__device__ __forceinline__ void unpack8(const v4u w, float (&f)[8]) {
    f[0] = __uint_as_float(w.x << 16); f[1] = __uint_as_float(w.x & 0xffff0000u);
    f[2] = __uint_as_float(w.y << 16); f[3] = __uint_as_float(w.y & 0xffff0000u);
    f[4] = __uint_as_float(w.z << 16); f[5] = __uint_as_float(w.z & 0xffff0000u);
    f[6] = __uint_as_float(w.w << 16); f[7] = __uint_as_float(w.w & 0xffff0000u);
}

struct EpiProj {
    static constexpr bool PERM = true, AFTER_DRAIN = false;
    pg8::bf16_t* O; int odd; const float* lb;
    __device__ __forceinline__ void operator()(const pg8::f32x4 (&acc)[2][2][4][2], const pg8::Unit& u, int wr, int wc, int fr, int fq) const {
        const int row0 = u.pm * 256 + wr * 64 + fr, col0 = u.pn * 256 + wc * 32 + 8 * fq;
        int act;
        if (!odd) act = (u.pn >= 24) ? 1 : 0; else act = (u.pn < 8) ? 1 : (u.pn < 16 ? 2 : (u.pn < 24 ? 0 : 1));
        pg8::f32x4 lbv[2][2];
#pragma unroll
        for (int bj = 0; bj < 2; ++bj)
#pragma unroll
            for (int n = 0; n < 2; ++n) lbv[bj][n] = (act == 2) ? *(const pg8::f32x4*)(lb + (col0 - 2048) + bj * 128 + 4 * n) : (pg8::f32x4){0.f, 0.f, 0.f, 0.f};
#pragma unroll
        for (int ai = 0; ai < 2; ++ai)
#pragma unroll
            for (int m = 0; m < 4; ++m) { pg8::bf16_t* rowp = O + (size_t)(row0 + ai * 128 + m * 16) * PW + col0;
#pragma unroll
                for (int bj = 0; bj < 2; ++bj) { pg8::f32x4 v0 = acc[ai][bj][m][0], v1 = acc[ai][bj][m][1];
                    if (act == 1) {
#pragma unroll
                        for (int e = 0; e < 4; ++e) { v0[e] = silu_f(v0[e]); v1[e] = silu_f(v1[e]); } }
                    else if (act == 2) {
#pragma unroll
                        for (int e = 0; e < 4; ++e) { const float s0 = 1.f / (1.f + __expf(-v0[e])), s1 = 1.f / (1.f + __expf(-v1[e]));
                            v0[e] = __logf(lbv[bj][0][e] + (1.f - lbv[bj][0][e]) * s0); v1[e] = __logf(lbv[bj][1][e] + (1.f - lbv[bj][1][e]) * s1); } }
                    pg8::u32x4 w; w.x = pg8::cvt_pk_bf16(v0[0], v0[1]); w.y = pg8::cvt_pk_bf16(v0[2], v0[3]); w.z = pg8::cvt_pk_bf16(v1[0], v1[1]); w.w = pg8::cvt_pk_bf16(v1[2], v1[3]);
                    *(pg8::u32x4*)(rowp + bj * 128) = w; } }
    }
};
struct EpiRes {
    static constexpr bool PERM = false, AFTER_DRAIN = false;
    const float* base; float* out;
    __device__ __forceinline__ void operator()(const pg8::f32x4 (&acc)[2][2][4][2], const pg8::Unit& u, int wr, int wc, int fr, int fq) const {
        const int row0 = u.pm * 256 + wr * 64 + fr, col0 = u.pn * 256 + wc * 32 + 4 * fq;
#pragma unroll
        for (int ai = 0; ai < 2; ++ai)
#pragma unroll
            for (int m = 0; m < 4; ++m) { const size_t off = (size_t)(row0 + ai * 128 + m * 16) * D + col0;
#pragma unroll
                for (int bj = 0; bj < 2; ++bj)
#pragma unroll
                    for (int n = 0; n < 2; ++n) { const pg8::f32x4 b = *(const pg8::f32x4*)(base + off + bj * 128 + n * 16);
                        *(pg8::f32x4*)(out + off + bj * 128 + n * 16) = b + acc[ai][bj][m][n]; } }
    }
};

__device__ __forceinline__ void transpose_item(const float* W, int K, int N, const float* gain, bf16* WT, LAS float* scr, int item, int lane) {
    const int nblk = N / 32, kb = item / nblk, nb = item % nblk, k0 = 64 * kb, n0 = 32 * nb;
#pragma unroll 8
    for (int i = 0; i < 32; ++i) { const int kk = 2 * i + (lane >> 5); float w = W[(size_t)(k0 + kk) * N + n0 + (lane & 31)]; if (gain) w *= gain[k0 + kk]; scr[kk * 33 + (lane & 31)] = w; }
    asm volatile("s_waitcnt lgkmcnt(0)" ::: "memory");
    const int c = lane & 7;
#pragma unroll
    for (int j = 0; j < 4; ++j) { const int n = (lane >> 3) + 8 * j; const LAS float* s = scr + (8 * c) * 33 + n;
        v4u o; o.x = pk2(s[0 * 33], s[1 * 33]); o.y = pk2(s[2 * 33], s[3 * 33]); o.z = pk2(s[4 * 33], s[5 * 33]); o.w = pk2(s[6 * 33], s[7 * 33]);
        *(v4u*)(WT + (size_t)(n0 + n) * K + k0 + 8 * c) = o; }
    asm volatile("s_waitcnt lgkmcnt(0)" ::: "memory");
}
__device__ __forceinline__ void norm_rows(const float* x, bf16* xn, int nrows, int gw, int ngw, int lane) {
    for (int m = gw; m < nrows; m += ngw) {
        const f32x4* xr = (const f32x4*)(x + (size_t)m * D) + lane;
        f32x4 v[4]; float s = 0.f;
#pragma unroll
        for (int j = 0; j < 4; ++j) { v[j] = xr[64 * j]; s += (v[j].x * v[j].x + v[j].y * v[j].y) + (v[j].z * v[j].z + v[j].w * v[j].w); }
        const float rstd = rsqrtf(wave_sum(s) * (1.f / D) + EPS);
        unsigned long long* o8 = (unsigned long long*)(xn + (size_t)m * D) + lane;
#pragma unroll
        for (int j = 0; j < 4; ++j) o8[64 * j] = (unsigned long long)pk2(v[j].x * rstd, v[j].y * rstd) | ((unsigned long long)pk2(v[j].z * rstd, v[j].w * rstd) << 32);
    }
}

__device__ __forceinline__ void attn_scalar(const bf16* proj, bf16* y, int TOKG, const float* qgain, const float* kgain, const float* rel_bias,
                                            unsigned char* lds, int tid, int lane, int wave, int gw, int ngw) {
    int* btab = (int*)lds;
    float* wq = (float*)(lds + 2048 + wave * 2304);
    float* wp = wq + 64;
    for (int e = tid; e < 448; e += 512) {
        int bk = -1;
        if (e < 387) { const int p = e / 129, jj = e - 129 * p, dist = jj << (2 * p);
            if (dist < 16) bk = dist; else { const float sc = logf((float)dist / 16.f) / logf(128.f); int lg = 16 + (int)(sc * 16.f); bk = lg < 31 ? lg : 31; } }
        btab[e] = bk;
    }
    __syncthreads();
    const float qgl = qgain[lane] * 0.125f, kgl = kgain[lane];
    const int nitems = TOKG * 16;
    for (int it = gw; it < nitems; it += ngw) {
        const int t = it & (SEQ - 1), bh = it >> 13, h = bh & 15, bl = bh >> 4;
        const size_t rowb = (size_t)bl * SEQ;
        const bf16* prow = proj + (rowb + t) * PW;
        const float q = bf2f(prow[3072 + h * 64 + lane]);
        const float ss = wave_sum(q * q);
        wq[lane] = q * rsqrtf(ss * (1.f / 64.f) + EPS) * qgl * kgl;
        asm volatile("s_waitcnt lgkmcnt(0)" ::: "memory");
        float lg[7]; float mx = -INFINITY;
#pragma unroll
        for (int r = 0; r < 7; ++r) {
            const int e = lane + 64 * r; const int bk = btab[e];
            const int p = e / 129, jj = e - 129 * p; const int tk = t - (jj << (2 * p));
            float l = -INFINITY;
            if (bk >= 0 && tk >= 0) {
                const v4u* kr = (const v4u*)(proj + (rowb + tk) * PW + 4096 + h * 64);
                float dot = 0.f, ks = 0.f;
#pragma unroll
                for (int c8 = 0; c8 < 8; ++c8) { float f[8]; unpack8(kr[c8], f);
#pragma unroll
                    for (int i = 0; i < 8; ++i) { dot += wq[c8 * 8 + i] * f[i]; ks += f[i] * f[i]; } }
                l = dot * rsqrtf(ks * (1.f / 64.f) + EPS) + rel_bias[bk * 16 + h];
            }
            lg[r] = l; mx = fmaxf(mx, l);
        }
        mx = wave_max(mx);
        float sum = 0.f;
#pragma unroll
        for (int r = 0; r < 7; ++r) { const float pe = (lg[r] == -INFINITY) ? 0.f : __expf(lg[r] - mx); wp[lane + 64 * r] = pe; sum += pe; }
        sum = wave_sum(sum);
        asm volatile("s_waitcnt lgkmcnt(0)" ::: "memory");
        float o = 0.f;
        const bf16* vbase = proj + rowb * PW + 5120 + h * 64 + lane;
#pragma unroll
        for (int p = 0; p < 3; ++p) {
#pragma unroll 8
            for (int jj = 0; jj <= 128; ++jj) { int tk = t - (jj << (2 * p)); const float pe = wp[p * 129 + jj]; if (tk < 0) tk = t;
                o += pe * bf2f(vbase[(size_t)tk * PW]); }
        }
        const float z = bf2f(prow[6144 + 1024 + h * 64 + lane]);
        y[(rowb + t) * MW + 1024 + h * 64 + lane] = (bf16)f2bf(o / sum * z);
    }
}
__device__ __forceinline__ void conv_scalar(const bf16* proj, bf16* y, int TOKG, const float* convw, int lane, int gw, int ngw) {
    for (int it = gw; it < TOKG; it += ngw) {
        const int t = it & (SEQ - 1); const bf16* prow = proj + (size_t)it * PW;
#pragma unroll
        for (int i = 0; i < 2; ++i) { const int c0 = lane * 8 + 512 * i;
            float acc[8] = {0.f, 0.f, 0.f, 0.f, 0.f, 0.f, 0.f, 0.f};
#pragma unroll
            for (int dt = 0; dt < 3; ++dt) { const int tt = t - 2 + dt;
                if (tt >= 0) { const bf16* pr = prow - (size_t)(2 - dt) * PW; float gc[8], xa[8];
                    unpack8(*(const v4u*)(pr + 1024 + c0), gc); unpack8(*(const v4u*)(pr + 2048 + c0), xa);
#pragma unroll
                    for (int e = 0; e < 8; ++e) acc[e] += convw[dt * 1024 + c0 + e] * (gc[e] * xa[e]); } }
            float gb[8], z[8]; unpack8(*(const v4u*)(prow + c0), gb); unpack8(*(const v4u*)(prow + 6144 + c0), z);
            v4u o; o.x = pk2(gb[0] * acc[0] * z[0], gb[1] * acc[1] * z[1]); o.y = pk2(gb[2] * acc[2] * z[2], gb[3] * acc[3] * z[3]);
            o.z = pk2(gb[4] * acc[4] * z[4], gb[5] * acc[5] * z[5]); o.w = pk2(gb[6] * acc[6] * z[6], gb[7] * acc[7] * z[7]);
            *(v4u*)(y + (size_t)it * MW + c0) = o; }
    }
}


typedef short bf16x8 __attribute__((ext_vector_type(8)));
typedef float f32x16 __attribute__((ext_vector_type(16)));
typedef __bf16 bf16x2_t __attribute__((ext_vector_type(2)));
typedef float f32x2_t __attribute__((ext_vector_type(2)));
typedef unsigned v2u __attribute__((ext_vector_type(2)));
__device__ __forceinline__ unsigned pkbf(float lo, float hi) { const f32x2_t v = {lo, hi}; const bf16x2_t b = __builtin_convertvector(v, bf16x2_t); return __builtin_bit_cast(unsigned, b); }
constexpr int ATT_KS = 0, ATT_KSTR = 144, ATT_VT = 384 * 144, ATT_VSTR = 776, ATT_BIAS = ATT_VT + 64 * 776;
__device__ __forceinline__ void attn_mfma(const bf16* proj, bf16* part, float* lse, int TOKG, const float* qgain, const float* kgain, const float* rel_bias,
                                          unsigned char* lds, int tid, int lane, int wave, int bid, int G) {
    LAS unsigned char* L = (LAS unsigned char*)lds;
    const int nunits = (TOKG / SEQ) * 16 * 96;
    const int c = lane & 31, hh = lane >> 5, c8 = tid & 7;
    float kg[8];
#pragma unroll
    for (int e = 0; e < 8; ++e) kg[e] = kgain[c8 * 8 + e];
    for (int u = bid; u < nunits; u += G) {
        const int i = u & 31, pbh = u >> 5, p = pbh % 3, bh = pbh / 3, h = bh & 15, bl = bh >> 4;
        const int dsh = 2 * p, d = 1 << dsh, r = i & (d - 1), qb = i >> dsh, m0 = qb * 256;
        const size_t rowb = (size_t)bl * SEQ;
        __syncthreads();
        if (tid < 192) { float tv = -INFINITY; const int dl = 160 - tid;
            if (dl >= 0 && dl <= 128) { const int dist = dl << dsh; int bk;
                if (dist < 16) bk = dist; else { const float scl = logf((float)dist / 16.f) / logf(128.f); const int lg = 16 + (int)(scl * 16.f); bk = lg < 31 ? lg : 31; }
                tv = rel_bias[bk * 16 + h] * 1.4426950408889634f; }
            ((LAS float*)(L + ATT_BIAS))[tid] = tv; }
#pragma unroll 1
        for (int it = 0; it < 6; ++it) {
            const int kk = (tid + 512 * it) >> 3, m = m0 - 128 + kk;
            v4u kw = {0u, 0u, 0u, 0u}, vw = {0u, 0u, 0u, 0u};
            if (m >= 0) { const bf16* rp = proj + (rowb + ((size_t)m << dsh) + r) * PW + h * 64 + c8 * 8; kw = *(const v4u*)(rp + 4096); vw = *(const v4u*)(rp + 5120); }
            float f[8]; unpack8(kw, f); float ss = 0.f;
#pragma unroll
            for (int e = 0; e < 8; ++e) ss += f[e] * f[e];
            ss += __shfl_xor(ss, 1); ss += __shfl_xor(ss, 2); ss += __shfl_xor(ss, 4);
            const float rs = rsqrtf(ss * (1.f / 64.f) + EPS);
            v4u ko; ko.x = pkbf(f[0] * rs * kg[0], f[1] * rs * kg[1]); ko.y = pkbf(f[2] * rs * kg[2], f[3] * rs * kg[3]); ko.z = pkbf(f[4] * rs * kg[4], f[5] * rs * kg[5]); ko.w = pkbf(f[6] * rs * kg[6], f[7] * rs * kg[7]);
            *(LAS v4u*)(L + ATT_KS + kk * ATT_KSTR + c8 * 16) = ko;
            LAS unsigned short* vt = (LAS unsigned short*)(L + ATT_VT + (c8 * 8) * ATT_VSTR + kk * 2);
            vt[0 * (ATT_VSTR / 2)] = (unsigned short)(vw.x & 0xffffu); vt[1 * (ATT_VSTR / 2)] = (unsigned short)(vw.x >> 16);
            vt[2 * (ATT_VSTR / 2)] = (unsigned short)(vw.y & 0xffffu); vt[3 * (ATT_VSTR / 2)] = (unsigned short)(vw.y >> 16);
            vt[4 * (ATT_VSTR / 2)] = (unsigned short)(vw.z & 0xffffu); vt[5 * (ATT_VSTR / 2)] = (unsigned short)(vw.z >> 16);
            vt[6 * (ATT_VSTR / 2)] = (unsigned short)(vw.w & 0xffffu); vt[7 * (ATT_VSTR / 2)] = (unsigned short)(vw.w >> 16);
        }
        const size_t orow = rowb + ((size_t)(m0 + 32 * wave + c) << dsh) + r;
        bf16x8 qf[4];
        { const bf16* qp = proj + orow * PW + 3072 + h * 64 + 8 * hh; float qv[4][8]; float ss = 0.f;
#pragma unroll
            for (int s = 0; s < 4; ++s) { unpack8(*(const v4u*)(qp + 16 * s), qv[s]);
#pragma unroll
                for (int e = 0; e < 8; ++e) ss += qv[s][e] * qv[s][e]; }
            ss += __shfl_xor(ss, 32);
            const float rs = rsqrtf(ss * (1.f / 64.f) + EPS) * (0.125f * 1.4426950408889634f);
#pragma unroll
            for (int s = 0; s < 4; ++s) { const f32x4 g0 = *(const f32x4*)(qgain + 16 * s + 8 * hh), g1 = *(const f32x4*)(qgain + 16 * s + 8 * hh + 4);
                v4u w; w.x = pkbf(qv[s][0] * rs * g0.x, qv[s][1] * rs * g0.y); w.y = pkbf(qv[s][2] * rs * g0.z, qv[s][3] * rs * g0.w);
                w.z = pkbf(qv[s][4] * rs * g1.x, qv[s][5] * rs * g1.y); w.w = pkbf(qv[s][6] * rs * g1.z, qv[s][7] * rs * g1.w); qf[s] = __builtin_bit_cast(bf16x8, w); } }
        __syncthreads();
        f32x16 sc[5];
#pragma unroll
        for (int j = 0; j < 5; ++j) {
#pragma unroll
            for (int e = 0; e < 16; ++e) sc[j][e] = 0.f;
#pragma unroll
            for (int s = 0; s < 4; ++s) { const bf16x8 kf = *(const LAS bf16x8*)(L + ATT_KS + (32 * wave + 32 * j + c) * ATT_KSTR + (16 * s + 8 * hh) * 2);
                sc[j] = __builtin_amdgcn_mfma_f32_32x32x16_bf16(kf, qf[s], sc[j], 0, 0, 0); } }
        const LAS float* tb = (const LAS float*)(L + ATT_BIAS) + (32 + 4 * hh - c);
        float mx = -INFINITY;
#pragma unroll
        for (int j = 0; j < 5; ++j)
#pragma unroll
            for (int e = 0; e < 16; ++e) sc[j][e] += tb[32 * j + (e & 3) + 8 * (e >> 2)];
        if (m0 == 0 && wave < 4) {
#pragma unroll
            for (int j = 0; j < 5; ++j)
#pragma unroll
                for (int e = 0; e < 16; ++e) if (32 * wave + 4 * hh + 32 * j + (e & 3) + 8 * (e >> 2) < 128) sc[j][e] = -INFINITY; }
#pragma unroll
        for (int j = 0; j < 5; ++j)
#pragma unroll
            for (int e = 0; e < 16; ++e) mx = fmaxf(mx, sc[j][e]);
        mx = fmaxf(mx, __shfl_xor(mx, 32));
        float l = 0.f;
#pragma unroll
        for (int j = 0; j < 5; ++j)
#pragma unroll
            for (int e = 0; e < 16; ++e) { const float pe = __builtin_amdgcn_exp2f(sc[j][e] - mx); sc[j][e] = pe; l += pe; }
        l += __shfl_xor(l, 32);
        f32x16 o[2];
#pragma unroll
        for (int e = 0; e < 16; ++e) { o[0][e] = 0.f; o[1][e] = 0.f; }
#pragma unroll
        for (int j = 0; j < 5; ++j)
#pragma unroll
            for (int s2 = 0; s2 < 2; ++s2) {
                v4u pw; pw.x = pkbf(sc[j][8 * s2 + 0], sc[j][8 * s2 + 1]); pw.y = pkbf(sc[j][8 * s2 + 2], sc[j][8 * s2 + 3]); pw.z = pkbf(sc[j][8 * s2 + 4], sc[j][8 * s2 + 5]); pw.w = pkbf(sc[j][8 * s2 + 6], sc[j][8 * s2 + 7]);
                const bf16x8 pf = __builtin_bit_cast(bf16x8, pw);
                const int kb = 32 * wave + 32 * j + 16 * s2 + 4 * hh;
#pragma unroll
                for (int dt = 0; dt < 2; ++dt) { const LAS unsigned char* vp = L + ATT_VT + (32 * dt + c) * ATT_VSTR + kb * 2;
                    const v2u lo = *(const LAS v2u*)vp, hi = *(const LAS v2u*)(vp + 16);
                    v4u vw4; vw4.x = lo.x; vw4.y = lo.y; vw4.z = hi.x; vw4.w = hi.y;
                    o[dt] = __builtin_amdgcn_mfma_f32_32x32x16_bf16(__builtin_bit_cast(bf16x8, vw4), pf, o[dt], 0, 0, 0); } }
        const float inv = 1.f / l;
        bf16* op = part + ((size_t)p * TOKG + orow) * 1024 + h * 64 + 4 * hh;
#pragma unroll
        for (int dt = 0; dt < 2; ++dt)
#pragma unroll
            for (int g4 = 0; g4 < 4; ++g4) { v2u w; w.x = pkbf(o[dt][4 * g4] * inv, o[dt][4 * g4 + 1] * inv); w.y = pkbf(o[dt][4 * g4 + 2] * inv, o[dt][4 * g4 + 3] * inv);
                *(v2u*)(op + 32 * dt + 8 * g4) = w; }
        if (hh == 0) lse[((size_t)p * TOKG + orow) * 16 + h] = mx * 0.6931471805599453f + __logf(l);
    }
}
__device__ __forceinline__ void merge_conv(const bf16* proj, const bf16* part, const float* lse, bf16* y, int TOKG, const float* convw, int lane, int gw, int ngw) {
    for (int it = gw; it < TOKG; it += ngw) {
        const int t = it & (SEQ - 1); const bf16* prow = proj + (size_t)it * PW;
#pragma unroll
        for (int i = 0; i < 2; ++i) { const int c0 = lane * 8 + 512 * i;
            float acc[8] = {0.f, 0.f, 0.f, 0.f, 0.f, 0.f, 0.f, 0.f};
#pragma unroll
            for (int dt = 0; dt < 3; ++dt) { const int tt = t - 2 + dt;
                if (tt >= 0) { const bf16* pr = prow - (size_t)(2 - dt) * PW; float gc[8], xa[8];
                    unpack8(*(const v4u*)(pr + 1024 + c0), gc); unpack8(*(const v4u*)(pr + 2048 + c0), xa);
#pragma unroll
                    for (int e = 0; e < 8; ++e) acc[e] += convw[dt * 1024 + c0 + e] * (gc[e] * xa[e]); } }
            float gb[8], z[8]; unpack8(*(const v4u*)(prow + c0), gb); unpack8(*(const v4u*)(prow + 6144 + c0), z);
            v4u o; o.x = pk2(gb[0] * acc[0] * z[0], gb[1] * acc[1] * z[1]); o.y = pk2(gb[2] * acc[2] * z[2], gb[3] * acc[3] * z[3]);
            o.z = pk2(gb[4] * acc[4] * z[4], gb[5] * acc[5] * z[5]); o.w = pk2(gb[6] * acc[6] * z[6], gb[7] * acc[7] * z[7]);
            *(v4u*)(y + (size_t)it * MW + c0) = o; }
#pragma unroll
        for (int i = 0; i < 2; ++i) { const int c0 = lane * 8 + 512 * i, h = c0 >> 6;
            const float l0 = lse[((size_t)0 * TOKG + it) * 16 + h], l1 = lse[((size_t)1 * TOKG + it) * 16 + h], l2 = lse[((size_t)2 * TOKG + it) * 16 + h];
            const float mx = fmaxf(l0, fmaxf(l1, l2)); float w0 = __expf(l0 - mx), w1 = __expf(l1 - mx), w2 = __expf(l2 - mx); const float inv = 1.f / (w0 + w1 + w2); w0 *= inv; w1 *= inv; w2 *= inv;
            float a0[8], a1[8], a2[8], z[8];
            unpack8(*(const v4u*)(part + ((size_t)0 * TOKG + it) * 1024 + c0), a0); unpack8(*(const v4u*)(part + ((size_t)1 * TOKG + it) * 1024 + c0), a1); unpack8(*(const v4u*)(part + ((size_t)2 * TOKG + it) * 1024 + c0), a2);
            unpack8(*(const v4u*)(prow + 6144 + 1024 + c0), z);
            float r[8];
#pragma unroll
            for (int e = 0; e < 8; ++e) r[e] = (w0 * a0[e] + w1 * a1[e] + w2 * a2[e]) * z[e];
            v4u o; o.x = pk2(r[0], r[1]); o.y = pk2(r[2], r[3]); o.z = pk2(r[4], r[5]); o.w = pk2(r[6], r[7]);
            *(v4u*)(y + (size_t)it * MW + 1024 + c0) = o; }
    }
}

__device__ __forceinline__ void hgrn_scalar(const bf16* proj, bf16* y, int TOKG, const float* ogain, unsigned char* lds, int tid, int lane, int wave, int bid, int G) {
    float* sq = (float*)lds; float* sf = sq + 4096; float* sk = sf + 4096; float* sv = sk + 4096; float* sop = sv + 4096;
    const int nseq = (TOKG / SEQ) * 16;
    const int v = tid & 127, kq = tid >> 7;
    for (int s = bid; s < nseq; s += G) {
        const int bl = s >> 4, h = s & 15; const size_t rowb = (size_t)bl * SEQ;
        float S[32];
#pragma unroll
        for (int i = 0; i < 32; ++i) S[i] = 0.f;
        const float og0 = ogain[h * 128 + lane], og1 = ogain[h * 128 + 64 + lane];
        for (int t0 = 0; t0 < SEQ; t0 += 32) {
#pragma unroll
            for (int i = 0; i < 8; ++i) { const int idx = tid + 512 * i, tt = idx >> 7, col = idx & 127; const bf16* prow = proj + (rowb + t0 + tt) * PW + h * 128 + col;
                sq[idx] = bf2f(prow[0]); const float f = __expf(bf2f(prow[2048])); sf[idx] = f; sk[idx] = 1.f - f; sv[idx] = bf2f(prow[4096]); }
            __syncthreads();
            for (int tt = 0; tt < 32; ++tt) {
                const float vv = sv[tt * 128 + v]; float acc = 0.f;
                const f32x4* pf = (const f32x4*)(sf + tt * 128 + kq * 32); const f32x4* pk = (const f32x4*)(sk + tt * 128 + kq * 32); const f32x4* pq = (const f32x4*)(sq + tt * 128 + kq * 32);
#pragma unroll
                for (int i4 = 0; i4 < 8; ++i4) { const f32x4 f = pf[i4], k = pk[i4], q = pq[i4];
#pragma unroll
                    for (int e = 0; e < 4; ++e) { S[i4 * 4 + e] = f[e] * S[i4 * 4 + e] + k[e] * vv; acc += q[e] * S[i4 * 4 + e]; } }
                sop[(kq * 32 + tt) * 128 + v] = acc;
            }
            __syncthreads();
#pragma unroll
            for (int i2 = 0; i2 < 4; ++i2) { const int tt = wave + 8 * i2;
                float o0 = 0.f, o1 = 0.f;
#pragma unroll
                for (int k4 = 0; k4 < 4; ++k4) { o0 += sop[(k4 * 32 + tt) * 128 + lane]; o1 += sop[(k4 * 32 + tt) * 128 + 64 + lane]; }
                const float rstd = rsqrtf(wave_sum(o0 * o0 + o1 * o1) * (1.f / 128.f) + EPS);
                const bf16* prow = proj + (rowb + t0 + tt) * PW + 6144 + h * 128;
                bf16* yr = y + (rowb + t0 + tt) * MW + h * 128;
                yr[lane] = (bf16)f2bf(o0 * rstd * og0 * bf2f(prow[lane])); yr[64 + lane] = (bf16)f2bf(o1 * rstd * og1 * bf2f(prow[64 + lane])); }
            __syncthreads();
        }
    }
}


typedef float f32x4h __attribute__((ext_vector_type(4)));
typedef float f32x2h __attribute__((ext_vector_type(2)));
#define MFMA16(a, b, c) __builtin_amdgcn_mfma_f32_16x16x32_bf16((a), (b), (c), 0, 0, 0)
constexpr float LOG2E = 1.4426950408889634f;
constexpr int HS = 144, HQS = 272;
constexpr int H1_KT = 0, H1_VT = 128 * HS, H1_SEG = 2 * 128 * HS;
constexpr int H3_QH = 0, H3_QM = 64 * HQS, H3_KM = 2 * 64 * HQS, H3_VT = 3 * 64 * HQS, H3_AM = H3_VT + 128 * HS, H3_SEG = H3_AM + 64 * HS, H3_RED = H3_SEG + 4096;
__device__ __forceinline__ float lo16(unsigned w) { return __uint_as_float(w << 16); }
__device__ __forceinline__ float hi16(unsigned w) { return __uint_as_float(w & 0xffff0000u); }
__device__ __forceinline__ void hgrn_h1(const bf16* proj, bf16* ST, float* dec, int TOKG, unsigned char* lds, int tid, int lane, int wave, int bid, int G) {
    LAS unsigned char* L = (LAS unsigned char*)lds;
    LAS float* segtot = (LAS float*)(L + H1_SEG);
    const int nunits = (TOKG / SEQ) * 16 * 128;
    const int fr = lane & 15, fq = lane >> 4;
    unsigned rg[8], rv[8];
#define H1_LOAD(u_) do { const int cch_ = (u_) & 127, seq_ = (u_) >> 7; const unsigned* pb_ = (const unsigned*)(proj + ((size_t)(seq_ >> 4) * SEQ + cch_ * 64 + wave * 8) * PW + (seq_ & 15) * 128) + lane; \
        _Pragma("unroll") for (int i = 0; i < 8; ++i) { rg[i] = pb_[(size_t)i * (PW / 2) + 1024]; rv[i] = pb_[(size_t)i * (PW / 2) + 2048]; } } while (0)
    if (bid < nunits) H1_LOAD(bid);
    for (int u = bid; u < nunits; u += G) {
        float gc0[8], gc1[8], kv0[8], kv1[8]; float run0 = 0.f, run1 = 0.f; v4u vv0, vv1;
#pragma unroll
        for (int i = 0; i < 8; ++i) { const float g0 = lo16(rg[i]) * LOG2E, g1 = hi16(rg[i]) * LOG2E; run0 += g0; run1 += g1; gc0[i] = run0; gc1[i] = run1;
            kv0[i] = 1.f - __builtin_amdgcn_exp2f(g0); kv1[i] = 1.f - __builtin_amdgcn_exp2f(g1); }
        vv0.x = (rv[0] & 0xffffu) | (rv[1] << 16); vv0.y = (rv[2] & 0xffffu) | (rv[3] << 16); vv0.z = (rv[4] & 0xffffu) | (rv[5] << 16); vv0.w = (rv[6] & 0xffffu) | (rv[7] << 16);
        vv1.x = (rv[0] >> 16) | (rv[1] & 0xffff0000u); vv1.y = (rv[2] >> 16) | (rv[3] & 0xffff0000u); vv1.z = (rv[4] >> 16) | (rv[5] & 0xffff0000u); vv1.w = (rv[6] >> 16) | (rv[7] & 0xffff0000u);
        if (u + G < nunits) H1_LOAD(u + G);
        __syncthreads();
        *(LAS f32x2h*)(segtot + wave * 128 + 2 * lane) = (f32x2h){run0, run1};
        *(LAS v4u*)(L + H1_VT + (2 * lane) * HS + wave * 16) = vv0; *(LAS v4u*)(L + H1_VT + (2 * lane + 1) * HS + wave * 16) = vv1;
        __syncthreads();
        float pre0 = 0.f, pre1 = 0.f, tot0 = 0.f, tot1 = 0.f;
#pragma unroll
        for (int s8 = 0; s8 < 8; ++s8) { const f32x2h t = *(const LAS f32x2h*)(segtot + s8 * 128 + 2 * lane); tot0 += t.x; tot1 += t.y; pre0 += (s8 < wave) ? t.x : 0.f; pre1 += (s8 < wave) ? t.y : 0.f; }
        { v4u a, b; const float e0 = tot0 - pre0, e1 = tot1 - pre1;
          a.x = pkbf(kv0[0] * __builtin_amdgcn_exp2f(e0 - gc0[0]), kv0[1] * __builtin_amdgcn_exp2f(e0 - gc0[1])); a.y = pkbf(kv0[2] * __builtin_amdgcn_exp2f(e0 - gc0[2]), kv0[3] * __builtin_amdgcn_exp2f(e0 - gc0[3]));
          a.z = pkbf(kv0[4] * __builtin_amdgcn_exp2f(e0 - gc0[4]), kv0[5] * __builtin_amdgcn_exp2f(e0 - gc0[5])); a.w = pkbf(kv0[6] * __builtin_amdgcn_exp2f(e0 - gc0[6]), kv0[7] * __builtin_amdgcn_exp2f(e0 - gc0[7]));
          b.x = pkbf(kv1[0] * __builtin_amdgcn_exp2f(e1 - gc1[0]), kv1[1] * __builtin_amdgcn_exp2f(e1 - gc1[1])); b.y = pkbf(kv1[2] * __builtin_amdgcn_exp2f(e1 - gc1[2]), kv1[3] * __builtin_amdgcn_exp2f(e1 - gc1[3]));
          b.z = pkbf(kv1[4] * __builtin_amdgcn_exp2f(e1 - gc1[4]), kv1[5] * __builtin_amdgcn_exp2f(e1 - gc1[5])); b.w = pkbf(kv1[6] * __builtin_amdgcn_exp2f(e1 - gc1[6]), kv1[7] * __builtin_amdgcn_exp2f(e1 - gc1[7]));
          *(LAS v4u*)(L + H1_KT + (2 * lane) * HS + wave * 16) = a; *(LAS v4u*)(L + H1_KT + (2 * lane + 1) * HS + wave * 16) = b; }
        if (wave == 0) *(f32x2h*)(dec + (size_t)u * 128 + 2 * lane) = (f32x2h){__builtin_amdgcn_exp2f(tot0), __builtin_amdgcn_exp2f(tot1)};
        __syncthreads();
        f32x4h acc[8];
#pragma unroll
        for (int nk = 0; nk < 8; ++nk) acc[nk] = (f32x4h){0.f, 0.f, 0.f, 0.f};
        bf16x8 vf[2];
#pragma unroll
        for (int ks = 0; ks < 2; ++ks) vf[ks] = *(const LAS bf16x8*)(L + H1_VT + (16 * wave + fr) * HS + (32 * ks + 8 * fq) * 2);
#pragma unroll
        for (int nk = 0; nk < 8; ++nk)
#pragma unroll
            for (int ks = 0; ks < 2; ++ks) { const bf16x8 kf = *(const LAS bf16x8*)(L + H1_KT + (16 * nk + fr) * HS + (32 * ks + 8 * fq) * 2); acc[nk] = MFMA16(kf, vf[ks], acc[nk]); }
        bf16* sp = ST + (size_t)u * 16384 + (16 * wave + fr) * 128 + 4 * fq;
#pragma unroll
        for (int nk = 0; nk < 8; ++nk) { v2u w; w.x = pkbf(acc[nk][0], acc[nk][1]); w.y = pkbf(acc[nk][2], acc[nk][3]); *(v2u*)(sp + 16 * nk) = w; }
    }
#undef H1_LOAD
}
__device__ __forceinline__ void hgrn_h2(bf16* ST, const float* dec, int TOKG, int tid, int bid, int G) {
    const int nitems = (TOKG / SEQ) * 16 * 4096;
    for (int item = bid * 512 + tid; item < nitems; item += G * 512) {
        const int seq = item >> 12, rem = item & 4095;
        bf16* p = ST + (size_t)seq * (128 * 16384) + rem * 4;
        const float* dp = dec + (size_t)seq * (128 * 128) + (rem & 31) * 4;
        f32x4 S = {0.f, 0.f, 0.f, 0.f};
        for (int c0 = 0; c0 < 128; c0 += 8) {
            v2u uw[8]; f32x4 dv[8];
#pragma unroll
            for (int i = 0; i < 8; ++i) { uw[i] = *(const v2u*)(p + (size_t)(c0 + i) * 16384); dv[i] = *(const f32x4*)(dp + (c0 + i) * 128); }
#pragma unroll
            for (int i = 0; i < 8; ++i) { v2u o; o.x = pkbf(S.x, S.y); o.y = pkbf(S.z, S.w); *(v2u*)(p + (size_t)(c0 + i) * 16384) = o;
                S.x = S.x * dv[i].x + lo16(uw[i].x); S.y = S.y * dv[i].y + hi16(uw[i].x); S.z = S.z * dv[i].z + lo16(uw[i].y); S.w = S.w * dv[i].w + hi16(uw[i].y); }
        }
    }
}
__device__ __forceinline__ void hgrn_h3(const bf16* proj, const bf16* ST, bf16* y, int TOKG, const float* ogain, unsigned char* lds, int tid, int lane, int wave, int bid, int G) {
    LAS unsigned char* L = (LAS unsigned char*)lds;
    LAS float* segtot = (LAS float*)(L + H3_SEG); LAS float* red = (LAS float*)(L + H3_RED);
    const int nunits = (TOKG / SEQ) * 16 * 128;
    const int fr = lane & 15, fq = lane >> 4;
    unsigned rq[8], rg[8], rv[8];
#define H3_LOAD(u_) do { const int cch_ = (u_) & 127, seq_ = (u_) >> 7; const unsigned* pb_ = (const unsigned*)(proj + ((size_t)(seq_ >> 4) * SEQ + cch_ * 64 + wave * 8) * PW + (seq_ & 15) * 128) + lane; \
        _Pragma("unroll") for (int i = 0; i < 8; ++i) { rq[i] = pb_[(size_t)i * (PW / 2)]; rg[i] = pb_[(size_t)i * (PW / 2) + 1024]; rv[i] = pb_[(size_t)i * (PW / 2) + 2048]; } } while (0)
    if (bid < nunits) H3_LOAD(bid);
    for (int u = bid; u < nunits; u += G) {
        const int cch = u & 127, seq = u >> 7, h = seq & 15, bl = seq >> 4;
        const size_t rowc = (size_t)bl * SEQ + cch * 64;
        const int v0 = 16 * wave + 4 * fq;
        bf16x8 sf[4]; v2u zw[4];
        { const bf16* sp = ST + (size_t)u * 16384 + (16 * wave + fr) * 128 + 8 * fq;
#pragma unroll
          for (int ks = 0; ks < 4; ++ks) sf[ks] = *(const bf16x8*)(sp + 32 * ks);
#pragma unroll
          for (int t2 = 0; t2 < 4; ++t2) zw[t2] = *(const v2u*)(proj + (rowc + 16 * t2 + fr) * PW + 6144 + h * 128 + v0); }
        float gc0[8], gc1[8], kv0[8], kv1[8], qv0[8], qv1[8]; float run0 = 0.f, run1 = 0.f; v4u vv0, vv1;
#pragma unroll
        for (int i = 0; i < 8; ++i) { const float g0 = lo16(rg[i]) * LOG2E, g1 = hi16(rg[i]) * LOG2E; run0 += g0; run1 += g1; gc0[i] = run0; gc1[i] = run1;
            kv0[i] = 1.f - __builtin_amdgcn_exp2f(g0); kv1[i] = 1.f - __builtin_amdgcn_exp2f(g1); qv0[i] = lo16(rq[i]); qv1[i] = hi16(rq[i]); }
        vv0.x = (rv[0] & 0xffffu) | (rv[1] << 16); vv0.y = (rv[2] & 0xffffu) | (rv[3] << 16); vv0.z = (rv[4] & 0xffffu) | (rv[5] << 16); vv0.w = (rv[6] & 0xffffu) | (rv[7] << 16);
        vv1.x = (rv[0] >> 16) | (rv[1] & 0xffff0000u); vv1.y = (rv[2] >> 16) | (rv[3] & 0xffff0000u); vv1.z = (rv[4] >> 16) | (rv[5] & 0xffff0000u); vv1.w = (rv[6] >> 16) | (rv[7] & 0xffff0000u);
        if (u + G < nunits) H3_LOAD(u + G);
        __syncthreads();
        *(LAS f32x2h*)(segtot + wave * 128 + 2 * lane) = (f32x2h){run0, run1};
        *(LAS v4u*)(L + H3_VT + (2 * lane) * HS + wave * 16) = vv0; *(LAS v4u*)(L + H3_VT + (2 * lane + 1) * HS + wave * 16) = vv1;
        __syncthreads();
        { float pre0 = 0.f, pre1 = 0.f, gr0 = 0.f, gr1 = 0.f;
#pragma unroll
          for (int s8 = 0; s8 < 8; ++s8) { const f32x2h t = *(const LAS f32x2h*)(segtot + s8 * 128 + 2 * lane); pre0 += (s8 < wave) ? t.x : 0.f; pre1 += (s8 < wave) ? t.y : 0.f; if (s8 < 4) { gr0 += t.x; gr1 += t.y; } }
#pragma unroll
          for (int i = 0; i < 8; ++i) { const float c0 = pre0 + gc0[i], c1 = pre1 + gc1[i]; const int s = wave * 8 + i;
              *(LAS unsigned*)(L + H3_QH + s * HQS + lane * 4) = pkbf(qv0[i] * __builtin_amdgcn_exp2f(c0), qv1[i] * __builtin_amdgcn_exp2f(c1));
              *(LAS unsigned*)(L + H3_QM + s * HQS + lane * 4) = pkbf(qv0[i] * __builtin_amdgcn_exp2f(fminf(c0 - gr0, 115.f)), qv1[i] * __builtin_amdgcn_exp2f(fminf(c1 - gr1, 115.f)));
              *(LAS unsigned*)(L + H3_KM + s * HQS + lane * 4) = pkbf(kv0[i] * __builtin_amdgcn_exp2f(fminf(gr0 - c0, 115.f)), kv1[i] * __builtin_amdgcn_exp2f(fminf(gr1 - c1, 115.f))); } }
        __syncthreads();
        { const int tt = wave >> 1;
#pragma unroll
          for (int ss2 = 0; ss2 < 2; ++ss2) { const int ss = 2 * (wave & 1) + ss2; f32x4h a = {0.f, 0.f, 0.f, 0.f};
              if (ss <= tt) {
#pragma unroll
                  for (int ks = 0; ks < 4; ++ks) { const bf16x8 kmf = *(const LAS bf16x8*)(L + H3_KM + (16 * ss + fr) * HQS + (32 * ks + 8 * fq) * 2);
                      const bf16x8 qmf = *(const LAS bf16x8*)(L + H3_QM + (16 * tt + fr) * HQS + (32 * ks + 8 * fq) * 2); a = MFMA16(kmf, qmf, a); } }
              const int t = 16 * tt + fr, s0 = 16 * ss + 4 * fq;
              v2u w; w.x = pkbf(s0 <= t ? a[0] : 0.f, s0 + 1 <= t ? a[1] : 0.f); w.y = pkbf(s0 + 2 <= t ? a[2] : 0.f, s0 + 3 <= t ? a[3] : 0.f);
              *(LAS v2u*)(L + H3_AM + t * HS + s0 * 2) = w; } }
        __syncthreads();
        f32x4h acc[4];
#pragma unroll
        for (int t2 = 0; t2 < 4; ++t2) acc[t2] = (f32x4h){0.f, 0.f, 0.f, 0.f};
#pragma unroll
        for (int t2 = 0; t2 < 4; ++t2)
#pragma unroll
            for (int ks = 0; ks < 4; ++ks) { const bf16x8 qf = *(const LAS bf16x8*)(L + H3_QH + (16 * t2 + fr) * HQS + (32 * ks + 8 * fq) * 2); acc[t2] = MFMA16(sf[ks], qf, acc[t2]); }
        bf16x8 vf[2];
#pragma unroll
        for (int ks = 0; ks < 2; ++ks) vf[ks] = *(const LAS bf16x8*)(L + H3_VT + (16 * wave + fr) * HS + (32 * ks + 8 * fq) * 2);
#pragma unroll
        for (int t2 = 0; t2 < 4; ++t2)
#pragma unroll
            for (int ks = 0; ks < 2; ++ks) { const bf16x8 af = *(const LAS bf16x8*)(L + H3_AM + (16 * t2 + fr) * HS + (32 * ks + 8 * fq) * 2); acc[t2] = MFMA16(vf[ks], af, acc[t2]); }
#pragma unroll
        for (int t2 = 0; t2 < 4; ++t2) { float ss = acc[t2][0] * acc[t2][0] + acc[t2][1] * acc[t2][1] + acc[t2][2] * acc[t2][2] + acc[t2][3] * acc[t2][3];
            ss += __shfl_xor(ss, 16); ss += __shfl_xor(ss, 32); if (fq == 0) red[wave * 64 + 16 * t2 + fr] = ss; }
        __syncthreads();
        const f32x4 og = *(const f32x4*)(ogain + h * 128 + v0);
#pragma unroll
        for (int t2 = 0; t2 < 4; ++t2) { const int t = 16 * t2 + fr; float tot = 0.f;
#pragma unroll
            for (int w8 = 0; w8 < 8; ++w8) tot += red[w8 * 64 + t];
            const float rstd = rsqrtf(tot * (1.f / 128.f) + EPS);
            v2u w; w.x = pkbf(acc[t2][0] * rstd * og.x * lo16(zw[t2].x), acc[t2][1] * rstd * og.y * hi16(zw[t2].x));
            w.y = pkbf(acc[t2][2] * rstd * og.z * lo16(zw[t2].y), acc[t2][3] * rstd * og.w * hi16(zw[t2].y));
            *(v2u*)(y + (rowc + t) * MW + h * 128 + v0) = w; }
    }
#undef H3_LOAD
}

#define XB_TMO      128
#define XB_XCNT(j)  (256  + 64 * (j))
#define XB_XSUB(j)  (1280 + 64 * (j))
#define XB_XGEN(j)  (2304 + 64 * (j))
#define XB_TOP      3328
#define XB_TOPGEN   3392
#define XCD_BAR_WORDS 3456
#define XB_SPIN_CAP (1u << 18)

__device__ __forceinline__ unsigned xb_ld(unsigned* p)              { return __hip_atomic_load(p, __ATOMIC_RELAXED, __HIP_MEMORY_SCOPE_AGENT); }
__device__ __forceinline__ unsigned xb_add(unsigned* p, unsigned v) { return __hip_atomic_fetch_add(p, v, __ATOMIC_RELAXED, __HIP_MEMORY_SCOPE_AGENT); }
__device__ __forceinline__ unsigned xb_xcc_id() { return (unsigned)__builtin_amdgcn_s_getreg((3 << 11) | 20) & 0xFu; }
#define XB_SPIN(cond, bar) do { unsigned _sp = 0; while (cond) { __builtin_amdgcn_s_sleep(1); \
    if ((++_sp & 255u) == 0u) { if (xb_ld(&(bar)[XB_TMO])) break; if (_sp > XB_SPIN_CAP) { atomicAdd(&(bar)[XB_TMO], 1u); break; } } } } while (0)

struct XcdBarrier {
    unsigned* bar; unsigned x;
    volatile LAS unsigned* st;
};

__device__ __forceinline__ XcdBarrier xcd_barrier_post(unsigned* bar, volatile LAS unsigned* st) {
    XcdBarrier b; b.bar = bar; b.x = xb_xcc_id(); b.st = st;
    if (threadIdx.x == 0) (void)xb_add(&bar[XB_XCNT(b.x)], 1u);
    return b;
}
__device__ __forceinline__ void xcd_barrier_complete(unsigned* bar, unsigned x, unsigned& nloc, unsigned& nx) {
    const unsigned G = gridDim.x * gridDim.y * gridDim.z;
    unsigned sum, cnt, mine, sp = 0u;
    for (;;) {
        sum = 0u; cnt = 0u; mine = 0u;
#pragma unroll
        for (unsigned j = 0; j < 16; ++j) { const unsigned c = xb_ld(&bar[XB_XCNT(j)]); sum += c; cnt += (c > 0u) ? 1u : 0u; mine = (j == x) ? c : mine; }
        if (sum == G) break;
        __builtin_amdgcn_s_sleep(1);
        if ((++sp & 255u) == 0u) { if (xb_ld(&bar[XB_TMO])) break; if (sp > XB_SPIN_CAP) { atomicAdd(&bar[XB_TMO], 1u); break; } }
    }
    nloc = mine > 0u ? mine : 1u; nx = cnt > 0u ? cnt : 1u;
}

__device__ __forceinline__ void xcd_barrier(const XcdBarrier& b) {
    asm volatile("s_waitcnt vmcnt(0)" ::: "memory");
    __syncthreads();
    if (threadIdx.x == 0) {
        unsigned* bar = b.bar;
        __builtin_amdgcn_s_waitcnt(0);
        unsigned nloc = b.st[0], nx = b.st[1];
        if (nloc == 0u) { xcd_barrier_complete(bar, b.x, nloc, nx); b.st[0] = nloc; b.st[1] = nx; }
        const unsigned old = xb_add(&bar[XB_XSUB(b.x)], 1u);
        const unsigned gen = old / nloc;
        if (old + 1u == (gen + 1u) * nloc) {
            __builtin_amdgcn_fence(__ATOMIC_RELEASE, "agent");
            asm volatile("s_waitcnt vmcnt(0)" ::: "memory");
            const unsigned og = xb_add(&bar[XB_TOP], 1u);
            const unsigned tg = og / nx;
            if (og + 1u == (tg + 1u) * nx) xb_add(&bar[XB_TOPGEN], 1u);
            else XB_SPIN(xb_ld(&bar[XB_TOPGEN]) == tg, bar);
            __builtin_amdgcn_fence(__ATOMIC_ACQUIRE, "agent");
            xb_add(&bar[XB_XGEN(b.x)], 1u);
            asm volatile("s_waitcnt vmcnt(0)" ::: "memory");
        } else {
            XB_SPIN(xb_ld(&bar[XB_XGEN(b.x)]) == gen, bar);
            __builtin_amdgcn_fence(__ATOMIC_ACQUIRE, "agent");
            asm volatile("s_waitcnt vmcnt(0)" ::: "memory");
        }
    }
    __syncthreads();
}

__device__ __forceinline__ unsigned long long ldptr(LAS unsigned long long* tab, int i) { asm volatile("" ::: "memory"); const unsigned long long v = tab[i];
    const unsigned lo = __builtin_amdgcn_readfirstlane((unsigned)v), hi = __builtin_amdgcn_readfirstlane((unsigned)(v >> 32)); return ((unsigned long long)hi << 32) | lo; }
struct Args { const float* in[13]; float* out; unsigned char* ws; int ngroups; int pad; };
struct Ctx { int layer, g, NG, TOKG, j, even, tid, lane, wave, G, bid, gw, ngw; unsigned char* wsb; bf16 *Wt_in, *Wt_out, *proj, *ybuf, *xn; float* lbtab; size_t row0; };
__device__ __forceinline__ Ctx load_ctx(LAS unsigned long long* ptab) {
    Ctx c; const int step = (int)ldptr(ptab, 16); c.NG = (int)ldptr(ptab, 15); c.layer = step / c.NG; c.g = step - c.layer * c.NG; c.TOKG = NTOK / c.NG; c.j = c.layer >> 1; c.even = !(c.layer & 1);
    int tid_raw = threadIdx.x; asm volatile("" : "+v"(tid_raw)); c.tid = tid_raw; c.lane = c.tid & 63; c.wave = __builtin_amdgcn_readfirstlane(c.tid >> 6);
    c.G = gridDim.x; c.bid = blockIdx.x; c.gw = c.bid * 8 + c.wave; c.ngw = c.G * 8;
    c.wsb = (unsigned char*)ldptr(ptab, 14);
    c.Wt_in = (bf16*)(c.wsb + WS_WIN); c.Wt_out = (bf16*)(c.wsb + WS_WOUT); c.lbtab = (float*)(c.wsb + WS_MISC); c.proj = (bf16*)(c.wsb + WS_PROJ);
    c.ybuf = (bf16*)(c.wsb + WS_PROJ + (size_t)c.TOKG * (PW * 2)); c.xn = (bf16*)(c.wsb + WS_PROJ + (size_t)c.TOKG * (PW * 2 + MW * 2));
    c.row0 = (size_t)c.g * c.TOKG; return c;
}
#define ARGP(i) ((const float*)ldptr(ptab, (i)))
__global__ void __launch_bounds__(512, 2) fwd(Args a) {
    extern __shared__ __attribute__((aligned(16))) unsigned char lds[];
    cg::grid_group grid = cg::this_grid();
    LAS unsigned long long* ptab = (LAS unsigned long long*)((LAS unsigned char*)lds + 131072 + 1024);
    if (threadIdx.x == 0) {
#pragma unroll
        for (int i = 0; i < 13; ++i) ptab[i] = (unsigned long long)a.in[i];
        ptab[13] = (unsigned long long)a.out; ptab[14] = (unsigned long long)a.ws; ptab[15] = (unsigned long long)a.ngroups; ptab[16] = 0ull;
        ((LAS unsigned*)(ptab + 24))[0] = 0u; ((LAS unsigned*)(ptab + 24))[1] = 0u; }
    __syncthreads();
    (void)xcd_barrier_post((unsigned*)(ldptr(ptab, 14) + WS_BAR), (volatile LAS unsigned*)(ptab + 24));
#define GSYNC() do { XcdBarrier b_; b_.bar = (unsigned*)(ldptr(ptab, 14) + WS_BAR); b_.x = xb_xcc_id(); b_.st = (volatile LAS unsigned*)(ptab + 24); xcd_barrier(b_); } while (0)
    for (;;) {
        {
            const Ctx c = load_ctx(ptab);
            if (c.g == 0) {
                const float* w_in = (c.even ? ARGP(2) : ARGP(9)) + (size_t)c.j * D * PW;
                const float* ln = (c.even ? ARGP(1) : ARGP(8)) + (size_t)c.j * D;
                const float* w_out = (c.even ? ARGP(6) : ARGP(12)) + (size_t)c.j * MW * D;
                LAS float* scr = (LAS float*)((LAS unsigned char*)lds + c.wave * 16384);
                constexpr int I_IN = (D / 64) * (PW / 32), I_OUT = (MW / 64) * (D / 32);
                for (int it = c.gw; it < I_IN + I_OUT; it += c.ngw) {
                    if (it < I_IN) transpose_item(w_in, D, PW, ln, c.Wt_in, scr, it, c.lane);
                    else transpose_item(w_out, MW, D, nullptr, c.Wt_out, scr, it - I_IN, c.lane);
                }
                if (!c.even && c.bid == 0) { const float* lbp = ARGP(10);
                    for (int col = c.tid; col < 2048; col += 512) c.lbtab[col] = (c.j == 0) ? 0.f : 1.f / (1.f + expf(lbp[col] - lbp[2048 + col])); }
            }
            const float* xsrc = (c.layer == 0) ? ARGP(0) : ARGP(13);
            norm_rows(xsrc + c.row0 * D, c.xn, c.TOKG, c.gw, c.ngw, c.lane);
        }
        if ((int)ldptr(ptab, 16) == 0) grid.sync(); else GSYNC();
        {
            const Ctx c = load_ctx(ptab);
            pg8::Gemm gm{c.xn, c.Wt_in, c.TOKG, PW, D}; pg8::StaticOrder S; S.init(c.TOKG, PW, c.G, c.bid); EpiProj E{c.proj, c.even ? 0 : 1, c.lbtab};
            pg8::gemm_phase<EpiProj, pg8::StaticOrder, true, true>((PG8_LAS unsigned char*)lds, gm, S, E);
        }
        GSYNC();
        {
            const Ctx c = load_ctx(ptab);
            if (c.even) {
                attn_mfma(c.proj, c.xn, (float*)(c.xn + (size_t)c.TOKG * 3072), c.TOKG, ARGP(4) + c.j * 64, ARGP(5) + c.j * 64, ARGP(7), lds, c.tid, c.lane, c.wave, c.bid, c.G);
            } else {
                hgrn_h1(c.proj, c.xn, (float*)(c.wsb + WS_MISC + MiB), c.TOKG, lds, c.tid, c.lane, c.wave, c.bid, c.G);
            }
        }
        GSYNC();
        {
            const Ctx c = load_ctx(ptab);
            if (c.even) merge_conv(c.proj, c.xn, (const float*)(c.xn + (size_t)c.TOKG * 3072), c.ybuf, c.TOKG, ARGP(3) + c.j * 3 * 1024, c.lane, c.gw, c.ngw);
            else hgrn_h2(c.xn, (const float*)(c.wsb + WS_MISC + MiB), c.TOKG, c.tid, c.bid, c.G);
        }
        GSYNC();
        {
            const Ctx c = load_ctx(ptab);
            if (!c.even) hgrn_h3(c.proj, c.xn, c.ybuf, c.TOKG, ARGP(11) + c.j * MW, lds, c.tid, c.lane, c.wave, c.bid, c.G);
        }
        GSYNC();
        {
            const Ctx c = load_ctx(ptab);
            const float* xsrc = (c.layer == 0) ? ARGP(0) : ARGP(13);
            pg8::Gemm gm{c.ybuf, c.Wt_out, c.TOKG, D, MW}; pg8::StaticOrder S; S.init(c.TOKG, D, c.G, c.bid); EpiRes E{xsrc + c.row0 * D, (float*)ARGP(13) + c.row0 * D};
            pg8::gemm_phase<EpiRes, pg8::StaticOrder, true, true>((PG8_LAS unsigned char*)lds, gm, S, E);
        }
        GSYNC();
        const int step = (int)ldptr(ptab, 16), nsteps = 4 * (int)ldptr(ptab, 15);
        __syncthreads();
        if (threadIdx.x == 0) ptab[16] = (unsigned long long)(step + 1);
        __syncthreads();
        if (step + 1 >= nsteps) break;
    }
}

extern "C" void kernel_launch(void* const* d_in, const int* in_sizes, int n_in, void* d_out, int out_size, void* d_ws, size_t ws_size, hipStream_t stream) {
    static int grid = 0;
    if (grid == 0) {
        int dev = 0, cus = 0, per_cu = 0;
        if (hipGetDevice(&dev) != hipSuccess || hipDeviceGetAttribute(&cus, hipDeviceAttributeMultiprocessorCount, dev) != hipSuccess) { fprintf(stderr, "kernel_launch: device query failed\n"); grid = -1; return; }
        if (hipFuncSetAttribute((const void*)fwd, hipFuncAttributeMaxDynamicSharedMemorySize, LDS_BYTES) != hipSuccess) { fprintf(stderr, "kernel_launch: hipFuncSetAttribute failed\n"); grid = -1; return; }
        if (hipOccupancyMaxActiveBlocksPerMultiprocessor(&per_cu, (const void*)fwd, 512, LDS_BYTES) != hipSuccess || per_cu < 1) fprintf(stderr, "kernel_launch: occupancy query reports %d\n", per_cu);
        (void)hipGetLastError();
        grid = cus;
    }
    if (grid < 0) return;
    Args a{};
    for (int i = 0; i < 13; ++i) a.in[i] = (const float*)d_in[i];
    a.out = (float*)d_out; a.ws = (unsigned char*)d_ws;
    a.ngroups = (ws_size >= (size_t)472 * MiB) ? 2 : 4;
    if (hipMemsetAsync((char*)d_ws + WS_BAR, 0, 16384, stream) != hipSuccess) { fprintf(stderr, "kernel_launch: memset failed\n"); return; }
    void* args[] = {&a};
    hipError_t e = hipLaunchCooperativeKernel((const void*)fwd, dim3(grid), dim3(512), args, LDS_BYTES, stream);
    if (e != hipSuccess) fprintf(stderr, "kernel_launch: cooperative launch failed: %s (grid %d)\n", hipGetErrorString(e), grid);
}
```

```cpp
#include <hip/hip_runtime.h>
#include <hip/hip_cooperative_groups.h>
#include <cstdio>
#include <cstdint>
namespace cg = cooperative_groups;
namespace pg8 {
#define PG8_LAS __attribute__((address_space(3)))
typedef unsigned short bf16_t;
typedef short bf16x8 __attribute__((ext_vector_type(8)));
typedef float f32x4 __attribute__((ext_vector_type(4)));
typedef unsigned u32x4 __attribute__((ext_vector_type(4)));
constexpr int BM = 256, BK = 64, HALF = 128, HTB = HALF * BK * 2  , STAGE_BYTES = 8 * HTB, NXCD = 8, WGM = 8;

__host__ __device__ __forceinline__ int lds_byte(int r, int c) { const int st = (r >> 4) * 2 + (c >> 5), rr = r & 15, cc = c & 31, ob = rr * 64 + cc * 2; return st * 1024 + (ob ^ (((ob >> 9) & 1) << 5)); }
__host__ __device__ __forceinline__ void stage_rc(int b, int& R, int& C) { const int st = b / 1024, sb = b % 1024, swz = sb ^ (((sb >> 9) & 1) << 5); R = (st >> 1) * 16 + swz / 64; C = (st & 1) * 32 + (swz % 64) / 2; }
__host__ __device__ __forceinline__ int perm32(int rho) { const int n = rho >> 4, i = rho & 15; return 8 * (i >> 2) + 4 * n + (i & 3); }

struct Unit { int pm, pn; };
struct Gemm { const bf16_t* A; const bf16_t* Bt; int M, N, K; };

struct StaticOrder {
    int nM, nN, nwg, G, c;
    __host__ __device__ void init(int M, int N, int G_, int c_) { nM = M / BM; nN = N / BM; nwg = nM * nN; G = G_; c = c_; }
    __host__ __device__ bool next(int i, Unit& u) const {
        const long L = (long)i * G + c; if (L >= nwg) return false;
        int wgid = (int)L; { const int q = nwg / NXCD, r = nwg % NXCD, xcd = wgid % NXCD, off = wgid / NXCD; wgid = (xcd < r ? xcd * (q + 1) : r * (q + 1) + (xcd - r) * q) + off; }
        const int nig = WGM * nN, gid = wgid / nig, fm = gid * WGM, gsz = (nM - fm) < WGM ? (nM - fm) : WGM;
        u.pm = fm + ((wgid % nig) % gsz); u.pn = (wgid % nig) / gsz; return true;
    }
    __device__ __forceinline__ void a_ready(const Unit&) const {}
    __device__ __forceinline__ void done(const Unit&) const {}
};

__device__ __forceinline__ unsigned cvt_pk_bf16(float lo, float hi) { unsigned r; asm volatile("v_cvt_pk_bf16_f32 %0, %1, %2" : "=v"(r) : "v"(lo), "v"(hi)); return r; }
template <class Epi, class Sched, bool ALIGN_EPI = false, bool SP2 = false>
__device__ __forceinline__ void gemm_phase(PG8_LAS unsigned char* lds, const Gemm g, const Sched& S, const Epi& E) {
    int tid_raw = threadIdx.x; asm volatile("" : "+v"(tid_raw)); const int tid = tid_raw, wid = __builtin_amdgcn_readfirstlane(tid >> 6), lane = tid & 63, wr = wid >> 2, wc = wid & 3, fr = lane & 15, fq = lane >> 4;
    const int K = g.K, nt = K / BK;
    unsigned voffA[2], voffB[2];
#pragma unroll
    for (int i = 0; i < 2; ++i) { int R, C; stage_rc(tid * 16 + i * 8192, R, C); const int Rb = Epi::PERM ? ((R & ~31) + perm32(R & 31)) : R;
        voffA[i] = (unsigned)(R * K + C) * 2u; voffB[i] = (unsigned)(Rb * K + C) * 2u; }
    const size_t kstep = (size_t)(BK * 2);
    const size_t hstep = (size_t)HALF * K * 2;
    const size_t tstep = 2 * hstep;
    const unsigned ldsw = (unsigned)wid * 1024u;
    const int aoff = lds_byte(wr * 64 + fr, fq * 8), boff = lds_byte(wc * 32 + fr, fq * 8);
#define PG8_SA(b, h) (((b) * 2 + (h)) * HTB)
#define PG8_SB(b, h) ((4 + (b) * 2 + (h)) * HTB)
#define PG8_STAGE(bufoff, gbase, voff) do { _Pragma("unroll") for (int _i = 0; _i < 2; ++_i) \
        __builtin_amdgcn_global_load_lds((const unsigned*)((const char*)(gbase) + (voff)[_i]), (PG8_LAS unsigned*)(lds + (bufoff) + ldsw + _i * 8192), 16, 0, 0); } while (0)
#define PG8_LDA(dst, b, h) do { _Pragma("unroll") for (int m = 0; m < 4; ++m) _Pragma("unroll") for (int k = 0; k < 2; ++k) dst[m][k] = *(const PG8_LAS bf16x8*)(lds + PG8_SA(b, h) + aoff + m * 2048 + k * 1024); } while (0)
#define PG8_LDB(dst, b, h) do { _Pragma("unroll") for (int n = 0; n < 2; ++n) _Pragma("unroll") for (int k = 0; k < 2; ++k) dst[n][k] = *(const PG8_LAS bf16x8*)(lds + PG8_SB(b, h) + boff + n * 2048 + k * 1024); } while (0)
#define PG8_MMA(ai, bj, At, Bt) do { __builtin_amdgcn_s_setprio(1); _Pragma("unroll") for (int m = 0; m < 4; ++m) _Pragma("unroll") for (int n = 0; n < 2; ++n) _Pragma("unroll") for (int k = 0; k < 2; ++k) \
        acc[ai][bj][m][n] = __builtin_amdgcn_mfma_f32_16x16x32_bf16(Bt[n][k], At[m][k], acc[ai][bj][m][n], 0, 0, 0); __builtin_amdgcn_s_setprio(0); } while (0)
#define PG8_WAIT_V(n) asm volatile("s_waitcnt vmcnt(" #n ")" ::: "memory")
#define PG8_WAIT_L(n) asm volatile("s_waitcnt lgkmcnt(" #n ")" ::: "memory")
#define PG8_BAR __builtin_amdgcn_s_barrier()
#define PG8_SCHED __builtin_amdgcn_sched_barrier(0)
    Unit cur, nxt; int ui = 0;
    if (!S.next(0, cur)) return;
    f32x4 acc[2][2][4][2];
#pragma unroll
    for (int a = 0; a < 2; ++a)
#pragma unroll
        for (int b = 0; b < 2; ++b)
#pragma unroll
            for (int m = 0; m < 4; ++m)
#pragma unroll
                for (int n = 0; n < 2; ++n) acc[a][b][m][n] = (f32x4){0.f, 0.f, 0.f, 0.f};
    bf16x8 At[4][2], B0[2][2], B1[2][2];
    const char* cA = (const char*)g.A + (size_t)cur.pm * tstep; const char* cB = (const char*)g.Bt + (size_t)cur.pn * tstep;
    S.a_ready(cur);
    if constexpr (SP2) {
        PG8_STAGE(PG8_SB(0, 0), cB, voffB); PG8_STAGE(PG8_SB(0, 1), cB + hstep, voffB); PG8_STAGE(PG8_SA(0, 0), cA, voffA); PG8_STAGE(PG8_SA(0, 1), cA + hstep, voffA);
        if (wr == 1) PG8_BAR;
        PG8_WAIT_V(2); PG8_BAR;
        PG8_STAGE(PG8_SB(1, 0), cB + kstep, voffB); PG8_STAGE(PG8_SA(1, 0), cA + kstep, voffA); PG8_STAGE(PG8_SB(1, 1), cB + hstep + kstep, voffB);
        PG8_WAIT_V(6); PG8_BAR;
    } else {
        PG8_STAGE(PG8_SB(0, 0), cB, voffB); PG8_STAGE(PG8_SA(0, 0), cA, voffA); PG8_STAGE(PG8_SB(0, 1), cB + hstep, voffB); PG8_STAGE(PG8_SA(0, 1), cA + hstep, voffA);
        if (wr == 1) PG8_BAR;
        PG8_WAIT_V(4); PG8_BAR;
        PG8_STAGE(PG8_SB(1, 0), cB + kstep, voffB); PG8_STAGE(PG8_SA(1, 0), cA + kstep, voffA); PG8_STAGE(PG8_SB(1, 1), cB + hstep + kstep, voffB);
        PG8_WAIT_V(6); PG8_BAR;
    }
    for (;;) {
        const bool has_next = S.next(ui + 1, nxt);
        const char* nA = has_next ? (const char*)g.A + (size_t)nxt.pm * tstep : cA; const char* nB = has_next ? (const char*)g.Bt + (size_t)nxt.pn * tstep : cB;
        for (int t = 0; t < nt; t += 2) {
            const bool last = (t == nt - 2);
            const char* a1 = cA + (size_t)(t + 1) * kstep;
            const char* a2 = last ? nA : cA + (size_t)(t + 2) * kstep; const char* b2 = last ? nB : cB + (size_t)(t + 2) * kstep;
            const char* a3 = a2 + kstep; const char* b3 = b2 + kstep;
            if (last && has_next) S.a_ready(nxt);
            if constexpr (SP2) {
            PG8_LDB(B0, 0, 0); PG8_LDB(B1, 0, 1); PG8_SCHED; PG8_LDA(At, 0, 0); PG8_STAGE(PG8_SA(1, 1), a1 + hstep, voffA);
            PG8_WAIT_V(8); PG8_WAIT_L(0); PG8_BAR; PG8_MMA(0, 0, At, B0); PG8_MMA(0, 1, At, B1); PG8_BAR; PG8_SCHED;
            PG8_LDA(At, 0, 1); PG8_STAGE(PG8_SB(0, 0), b2, voffB); PG8_STAGE(PG8_SB(0, 1), b2 + hstep, voffB); PG8_STAGE(PG8_SA(0, 0), a2, voffA);
            PG8_WAIT_V(8); PG8_WAIT_L(0); PG8_BAR; PG8_MMA(1, 0, At, B0); PG8_MMA(1, 1, At, B1); PG8_BAR; PG8_SCHED;
            PG8_LDB(B0, 1, 0); PG8_LDB(B1, 1, 1); PG8_SCHED; PG8_LDA(At, 1, 0); PG8_STAGE(PG8_SA(0, 1), a2 + hstep, voffA);
            PG8_WAIT_V(8); PG8_WAIT_L(0); PG8_BAR; PG8_MMA(0, 0, At, B0); PG8_MMA(0, 1, At, B1); PG8_BAR; PG8_SCHED;
            PG8_LDA(At, 1, 1); PG8_STAGE(PG8_SB(1, 0), b3, voffB); PG8_STAGE(PG8_SB(1, 1), b3 + hstep, voffB); PG8_STAGE(PG8_SA(1, 0), a3, voffA);
            PG8_WAIT_V(8); PG8_WAIT_L(0); PG8_BAR; PG8_MMA(1, 0, At, B0); PG8_MMA(1, 1, At, B1); PG8_BAR; PG8_SCHED;
            } else {
            PG8_LDB(B0, 0, 0); PG8_SCHED; PG8_LDA(At, 0, 0); PG8_STAGE(PG8_SA(1, 1), a1 + hstep, voffA);
            PG8_WAIT_L(8); PG8_BAR; PG8_WAIT_L(0); PG8_MMA(0, 0, At, B0); PG8_BAR; PG8_SCHED;
            PG8_LDB(B1, 0, 1); PG8_STAGE(PG8_SB(0, 0), b2, voffB);
            PG8_BAR; PG8_WAIT_L(0); PG8_MMA(0, 1, At, B1); PG8_BAR;
            PG8_LDA(At, 0, 1); PG8_STAGE(PG8_SA(0, 0), a2, voffA);
            PG8_BAR; PG8_WAIT_L(0); PG8_MMA(1, 0, At, B0); PG8_BAR; PG8_SCHED;
            PG8_STAGE(PG8_SB(0, 1), b2 + hstep, voffB);
            PG8_WAIT_V(6); PG8_BAR; PG8_MMA(1, 1, At, B1); PG8_BAR;
            PG8_LDB(B0, 1, 0); PG8_SCHED; PG8_LDA(At, 1, 0); PG8_STAGE(PG8_SA(0, 1), a2 + hstep, voffA);
            PG8_WAIT_L(8); PG8_BAR; PG8_WAIT_L(0); PG8_MMA(0, 0, At, B0); PG8_BAR; PG8_SCHED;
            PG8_LDB(B1, 1, 1); PG8_STAGE(PG8_SB(1, 0), b3, voffB);
            PG8_BAR; PG8_WAIT_L(0); PG8_MMA(0, 1, At, B1); PG8_BAR;
            PG8_LDA(At, 1, 1); PG8_STAGE(PG8_SA(1, 0), a3, voffA);
            PG8_BAR; PG8_WAIT_L(0); PG8_MMA(1, 0, At, B0); PG8_BAR; PG8_SCHED;
            PG8_STAGE(PG8_SB(1, 1), b3 + hstep, voffB);
            PG8_WAIT_V(6); PG8_BAR; PG8_MMA(1, 1, At, B1); PG8_BAR;
            }
        }
        if constexpr (ALIGN_EPI) { if (wr == 0) PG8_BAR; }
        if constexpr (!Epi::AFTER_DRAIN) { E(acc, cur, wr, wc, fr, fq); S.done(cur); }
        if (!has_next) break;
#pragma unroll
        for (int a = 0; a < 2; ++a)
#pragma unroll
            for (int b = 0; b < 2; ++b)
#pragma unroll
                for (int m = 0; m < 4; ++m)
#pragma unroll
                    for (int n = 0; n < 2; ++n) acc[a][b][m][n] = (f32x4){0.f, 0.f, 0.f, 0.f};
        cur = nxt; cA = nA; cB = nB; ++ui;
        if constexpr (ALIGN_EPI) { if (wr == 1) PG8_BAR; }
    }
    PG8_WAIT_V(0);
    if constexpr (!ALIGN_EPI) { if (wr == 0) PG8_BAR; }
    PG8_BAR;
    if constexpr (Epi::AFTER_DRAIN) { E.fused(acc, cur, wr, wc, fr, fq, lds, wid, lane); S.done(cur); }
#undef PG8_SA
#undef PG8_SB
#undef PG8_STAGE
#undef PG8_LDA
#undef PG8_LDB
#undef PG8_MMA
#undef PG8_WAIT_V
#undef PG8_WAIT_L
#undef PG8_BAR
#undef PG8_SCHED
}
}

constexpr int D = 1024, SEQ = 8192, NBATCH = 4, NTOK = NBATCH * SEQ, PW = 8192, MW = 2048;
constexpr float EPS = 1e-6f;
constexpr size_t MiB = 1u << 20;
constexpr size_t WS_WIN = 0, WS_WOUT = 16 * MiB, WS_MISC = 20 * MiB, WS_BAR = 23 * MiB, WS_PROJ = 24 * MiB;
constexpr int LDS_BYTES = 147456;
typedef unsigned short bf16;
typedef unsigned v4u __attribute__((ext_vector_type(4)));
typedef float f32x4 __attribute__((ext_vector_type(4)));
#define LAS __attribute__((address_space(3)))

__device__ __forceinline__ float bf2f(unsigned short b) { return __uint_as_float(((unsigned)b) << 16); }
__device__ __forceinline__ unsigned f2bf(float f) { unsigned u = __float_as_uint(f); return (u + 0x7fffu + ((u >> 16) & 1u)) >> 16; }
__device__ __forceinline__ unsigned pk2(float lo, float hi) { return f2bf(lo) | (f2bf(hi) << 16); }
__device__ __forceinline__ float wave_sum(float v) {
#pragma unroll
    for (int o = 1; o < 64; o <<= 1) v += __shfl_xor(v, o);
    return v;
}
__device__ __forceinline__ float wave_max(float v) {
#pragma unroll
    for (int o = 1; o < 64; o <<= 1) v = fmaxf(v, __shfl_xor(v, o));
    return v;
}
__device__ __forceinline__ float silu_f(float x) { return x * __builtin_amdgcn_rcpf(1.f + __builtin_amdgcn_exp2f(x * -1.4426950408889634f)); }
__device__ __forceinline__ void unpack8(const v4u w, float (&f)[8]) {
    f[0] = __uint_as_float(w.x << 16); f[1] = __uint_as_float(w.x & 0xffff0000u);
    f[2] = __uint_as_float(w.y << 16); f[3] = __uint_as_float(w.y & 0xffff0000u);
    f[4] = __uint_as_float(w.z << 16); f[5] = __uint_as_float(w.z & 0xffff0000u);
    f[6] = __uint_as_float(w.w << 16); f[7] = __uint_as_float(w.w & 0xffff0000u);
}

struct EpiProj {
    static constexpr bool PERM = true, AFTER_DRAIN = false;
    pg8::bf16_t* O; int odd; const float* lb;
    __device__ __forceinline__ void operator()(const pg8::f32x4 (&acc)[2][2][4][2], const pg8::Unit& u, int wr, int wc, int fr, int fq) const {
        const int row0 = u.pm * 256 + wr * 64 + fr, col0 = u.pn * 256 + wc * 32 + 8 * fq;
        int act;
        if (!odd) act = (u.pn >= 24) ? 1 : 0; else act = (u.pn < 8) ? 1 : (u.pn < 16 ? 2 : (u.pn < 24 ? 0 : 1));
        pg8::f32x4 lbv[2][2];
#pragma unroll
        for (int bj = 0; bj < 2; ++bj)
#pragma unroll
            for (int n = 0; n < 2; ++n) lbv[bj][n] = (act == 2) ? *(const pg8::f32x4*)(lb + (col0 - 2048) + bj * 128 + 4 * n) : (pg8::f32x4){0.f, 0.f, 0.f, 0.f};
#pragma unroll
        for (int ai = 0; ai < 2; ++ai)
#pragma unroll
            for (int m = 0; m < 4; ++m) { pg8::bf16_t* rowp = O + (size_t)(row0 + ai * 128 + m * 16) * PW + col0;
#pragma unroll
                for (int bj = 0; bj < 2; ++bj) { pg8::f32x4 v0 = acc[ai][bj][m][0], v1 = acc[ai][bj][m][1];
                    if (act == 1) {
#pragma unroll
                        for (int e = 0; e < 4; ++e) { v0[e] = silu_f(v0[e]); v1[e] = silu_f(v1[e]); } }
                    else if (act == 2) {
#pragma unroll
                        for (int e = 0; e < 4; ++e) { const float s0 = __builtin_amdgcn_rcpf(1.f + __builtin_amdgcn_exp2f(v0[e] * -1.4426950408889634f)), s1 = __builtin_amdgcn_rcpf(1.f + __builtin_amdgcn_exp2f(v1[e] * -1.4426950408889634f));
                            v0[e] = __builtin_amdgcn_logf(lbv[bj][0][e] + (1.f - lbv[bj][0][e]) * s0) * 0.6931471805599453f; v1[e] = __builtin_amdgcn_logf(lbv[bj][1][e] + (1.f - lbv[bj][1][e]) * s1) * 0.6931471805599453f; } }
                    pg8::u32x4 w; w.x = pg8::cvt_pk_bf16(v0[0], v0[1]); w.y = pg8::cvt_pk_bf16(v0[2], v0[3]); w.z = pg8::cvt_pk_bf16(v1[0], v1[1]); w.w = pg8::cvt_pk_bf16(v1[2], v1[3]);
                    *(pg8::u32x4*)(rowp + bj * 128) = w; } }
    }
};
struct EpiRes {
    static constexpr bool PERM = false, AFTER_DRAIN = false;
    const float* base; float* out;
    __device__ __forceinline__ void operator()(const pg8::f32x4 (&acc)[2][2][4][2], const pg8::Unit& u, int wr, int wc, int fr, int fq) const {
        const int row0 = u.pm * 256 + wr * 64 + fr, col0 = u.pn * 256 + wc * 32 + 4 * fq;
#pragma unroll
        for (int ai = 0; ai < 2; ++ai)
#pragma unroll
            for (int m = 0; m < 4; ++m) { const size_t off = (size_t)(row0 + ai * 128 + m * 16) * D + col0;
#pragma unroll
                for (int bj = 0; bj < 2; ++bj)
#pragma unroll
                    for (int n = 0; n < 2; ++n) { const pg8::f32x4 b = *(const pg8::f32x4*)(base + off + bj * 128 + n * 16);
                        *(pg8::f32x4*)(out + off + bj * 128 + n * 16) = b + acc[ai][bj][m][n]; } }
    }
};

__device__ __forceinline__ void transpose_item(const float* W, int K, int N, const float* gain, bf16* WT, LAS float* scr, int item, int lane) {
    const int nblk = N / 32, kb = item / nblk, nb = item % nblk, k0 = 64 * kb, n0 = 32 * nb;
#pragma unroll 8
    for (int i = 0; i < 32; ++i) { const int kk = 2 * i + (lane >> 5); float w = W[(size_t)(k0 + kk) * N + n0 + (lane & 31)]; if (gain) w *= gain[k0 + kk]; scr[kk * 33 + (lane & 31)] = w; }
    asm volatile("s_waitcnt lgkmcnt(0)" ::: "memory");
    const int c = lane & 7;
#pragma unroll
    for (int j = 0; j < 4; ++j) { const int n = (lane >> 3) + 8 * j; const LAS float* s = scr + (8 * c) * 33 + n;
        v4u o; o.x = pk2(s[0 * 33], s[1 * 33]); o.y = pk2(s[2 * 33], s[3 * 33]); o.z = pk2(s[4 * 33], s[5 * 33]); o.w = pk2(s[6 * 33], s[7 * 33]);
        *(v4u*)(WT + (size_t)(n0 + n) * K + k0 + 8 * c) = o; }
    asm volatile("s_waitcnt lgkmcnt(0)" ::: "memory");
}
__device__ __forceinline__ void norm_rows(const float* x, bf16* xn, int nrows, int gw, int ngw, int lane) {
    for (int m = gw; m < nrows; m += ngw) {
        const f32x4* xr = (const f32x4*)(x + (size_t)m * D) + lane;
        f32x4 v[4]; float s = 0.f;
#pragma unroll
        for (int j = 0; j < 4; ++j) { v[j] = xr[64 * j]; s += (v[j].x * v[j].x + v[j].y * v[j].y) + (v[j].z * v[j].z + v[j].w * v[j].w); }
        const float rstd = rsqrtf(wave_sum(s) * (1.f / D) + EPS);
        unsigned long long* o8 = (unsigned long long*)(xn + (size_t)m * D) + lane;
#pragma unroll
        for (int j = 0; j < 4; ++j) o8[64 * j] = (unsigned long long)pk2(v[j].x * rstd, v[j].y * rstd) | ((unsigned long long)pk2(v[j].z * rstd, v[j].w * rstd) << 32);
    }
}

__device__ __forceinline__ void attn_scalar(const bf16* proj, bf16* y, int TOKG, const float* qgain, const float* kgain, const float* rel_bias,
                                            unsigned char* lds, int tid, int lane, int wave, int gw, int ngw) {
    int* btab = (int*)lds;
    float* wq = (float*)(lds + 2048 + wave * 2304);
    float* wp = wq + 64;
    for (int e = tid; e < 448; e += 512) {
        int bk = -1;
        if (e < 387) { const int p = e / 129, jj = e - 129 * p, dist = jj << (2 * p);
            if (dist < 16) bk = dist; else { const float sc = logf((float)dist / 16.f) / logf(128.f); int lg = 16 + (int)(sc * 16.f); bk = lg < 31 ? lg : 31; } }
        btab[e] = bk;
    }
    __syncthreads();
    const float qgl = qgain[lane] * 0.125f, kgl = kgain[lane];
    const int nitems = TOKG * 16;
    for (int it = gw; it < nitems; it += ngw) {
        const int t = it & (SEQ - 1), bh = it >> 13, h = bh & 15, bl = bh >> 4;
        const size_t rowb = (size_t)bl * SEQ;
        const bf16* prow = proj + (rowb + t) * PW;
        const float q = bf2f(prow[3072 + h * 64 + lane]);
        const float ss = wave_sum(q * q);
        wq[lane] = q * rsqrtf(ss * (1.f / 64.f) + EPS) * qgl * kgl;
        asm volatile("s_waitcnt lgkmcnt(0)" ::: "memory");
        float lg[7]; float mx = -INFINITY;
#pragma unroll
        for (int r = 0; r < 7; ++r) {
            const int e = lane + 64 * r; const int bk = btab[e];
            const int p = e / 129, jj = e - 129 * p; const int tk = t - (jj << (2 * p));
            float l = -INFINITY;
            if (bk >= 0 && tk >= 0) {
                const v4u* kr = (const v4u*)(proj + (rowb + tk) * PW + 4096 + h * 64);
                float dot = 0.f, ks = 0.f;
#pragma unroll
                for (int c8 = 0; c8 < 8; ++c8) { float f[8]; unpack8(kr[c8], f);
#pragma unroll
                    for (int i = 0; i < 8; ++i) { dot += wq[c8 * 8 + i] * f[i]; ks += f[i] * f[i]; } }
                l = dot * rsqrtf(ks * (1.f / 64.f) + EPS) + rel_bias[bk * 16 + h];
            }
            lg[r] = l; mx = fmaxf(mx, l);
        }
        mx = wave_max(mx);
        float sum = 0.f;
#pragma unroll
        for (int r = 0; r < 7; ++r) { const float pe = (lg[r] == -INFINITY) ? 0.f : __expf(lg[r] - mx); wp[lane + 64 * r] = pe; sum += pe; }
        sum = wave_sum(sum);
        asm volatile("s_waitcnt lgkmcnt(0)" ::: "memory");
        float o = 0.f;
        const bf16* vbase = proj + rowb * PW + 5120 + h * 64 + lane;
#pragma unroll
        for (int p = 0; p < 3; ++p) {
#pragma unroll 8
            for (int jj = 0; jj <= 128; ++jj) { int tk = t - (jj << (2 * p)); const float pe = wp[p * 129 + jj]; if (tk < 0) tk = t;
                o += pe * bf2f(vbase[(size_t)tk * PW]); }
        }
        const float z = bf2f(prow[6144 + 1024 + h * 64 + lane]);
        y[(rowb + t) * MW + 1024 + h * 64 + lane] = (bf16)f2bf(o / sum * z);
    }
}
__device__ __forceinline__ void conv_scalar(const bf16* proj, bf16* y, int TOKG, const float* convw, int lane, int gw, int ngw) {
    for (int it = gw; it < TOKG; it += ngw) {
        const int t = it & (SEQ - 1); const bf16* prow = proj + (size_t)it * PW;
#pragma unroll
        for (int i = 0; i < 2; ++i) { const int c0 = lane * 8 + 512 * i;
            float acc[8] = {0.f, 0.f, 0.f, 0.f, 0.f, 0.f, 0.f, 0.f};
#pragma unroll
            for (int dt = 0; dt < 3; ++dt) { const int tt = t - 2 + dt;
                if (tt >= 0) { const bf16* pr = prow - (size_t)(2 - dt) * PW; float gc[8], xa[8];
                    unpack8(*(const v4u*)(pr + 1024 + c0), gc); unpack8(*(const v4u*)(pr + 2048 + c0), xa);
#pragma unroll
                    for (int e = 0; e < 8; ++e) acc[e] += convw[dt * 1024 + c0 + e] * (gc[e] * xa[e]); } }
            float gb[8], z[8]; unpack8(*(const v4u*)(prow + c0), gb); unpack8(*(const v4u*)(prow + 6144 + c0), z);
            v4u o; o.x = pk2(gb[0] * acc[0] * z[0], gb[1] * acc[1] * z[1]); o.y = pk2(gb[2] * acc[2] * z[2], gb[3] * acc[3] * z[3]);
            o.z = pk2(gb[4] * acc[4] * z[4], gb[5] * acc[5] * z[5]); o.w = pk2(gb[6] * acc[6] * z[6], gb[7] * acc[7] * z[7]);
            *(v4u*)(y + (size_t)it * MW + c0) = o; }
    }
}


typedef short bf16x8 __attribute__((ext_vector_type(8)));
typedef float f32x16 __attribute__((ext_vector_type(16)));
typedef __bf16 bf16x2_t __attribute__((ext_vector_type(2)));
typedef float f32x2_t __attribute__((ext_vector_type(2)));
typedef unsigned v2u __attribute__((ext_vector_type(2)));
__device__ __forceinline__ unsigned pkbf(float lo, float hi) { const f32x2_t v = {lo, hi}; const bf16x2_t b = __builtin_convertvector(v, bf16x2_t); return __builtin_bit_cast(unsigned, b); }
constexpr int ATT_KS = 0, ATT_KSTR = 144, ATT_VT = 384 * 144, ATT_VSTR = 776, ATT_BIAS = ATT_VT + 64 * 776;
__device__ __forceinline__ void attn_mfma(const bf16* proj, bf16* part, float* lse, int TOKG, const float* qgain, const float* kgain, const float* rel_bias,
                                          unsigned char* lds, int tid, int lane, int wave, int bid, int G) {
    LAS unsigned char* L = (LAS unsigned char*)lds;
    const int nunits = (TOKG / SEQ) * 16 * 96;
    const int c = lane & 31, hh = lane >> 5, c8 = tid & 7;
    float kg[8];
#pragma unroll
    for (int e = 0; e < 8; ++e) kg[e] = kgain[c8 * 8 + e];
    for (int u = bid; u < nunits; u += G) {
        const int i = u & 31, pbh = u >> 5, p = pbh % 3, bh = pbh / 3, h = bh & 15, bl = bh >> 4;
        const int dsh = 2 * p, d = 1 << dsh, r = i & (d - 1), qb = i >> dsh, m0 = qb * 256;
        const size_t rowb = (size_t)bl * SEQ;
        __syncthreads();
        if (tid < 192) { float tv = -INFINITY; const int dl = 160 - tid;
            if (dl >= 0 && dl <= 128) { const int dist = dl << dsh; int bk;
                if (dist < 16) bk = dist; else { const float scl = logf((float)dist / 16.f) / logf(128.f); const int lg = 16 + (int)(scl * 16.f); bk = lg < 31 ? lg : 31; }
                tv = rel_bias[bk * 16 + h] * 1.4426950408889634f; }
            ((LAS float*)(L + ATT_BIAS))[tid] = tv; }
#pragma unroll 1
        for (int it = 0; it < 6; ++it) {
            const int kk = (tid + 512 * it) >> 3, m = m0 - 128 + kk;
            v4u kw = {0u, 0u, 0u, 0u}, vw = {0u, 0u, 0u, 0u};
            if (m >= 0) { const bf16* rp = proj + (rowb + ((size_t)m << dsh) + r) * PW + h * 64 + c8 * 8; kw = *(const v4u*)(rp + 4096); vw = *(const v4u*)(rp + 5120); }
            float f[8]; unpack8(kw, f); float ss = 0.f;
#pragma unroll
            for (int e = 0; e < 8; ++e) ss += f[e] * f[e];
            ss += __shfl_xor(ss, 1); ss += __shfl_xor(ss, 2); ss += __shfl_xor(ss, 4);
            const float rs = rsqrtf(ss * (1.f / 64.f) + EPS);
            v4u ko; ko.x = pkbf(f[0] * rs * kg[0], f[1] * rs * kg[1]); ko.y = pkbf(f[2] * rs * kg[2], f[3] * rs * kg[3]); ko.z = pkbf(f[4] * rs * kg[4], f[5] * rs * kg[5]); ko.w = pkbf(f[6] * rs * kg[6], f[7] * rs * kg[7]);
            *(LAS v4u*)(L + ATT_KS + kk * ATT_KSTR + c8 * 16) = ko;
            LAS unsigned short* vt = (LAS unsigned short*)(L + ATT_VT + (c8 * 8) * ATT_VSTR + kk * 2);
            vt[0 * (ATT_VSTR / 2)] = (unsigned short)(vw.x & 0xffffu); vt[1 * (ATT_VSTR / 2)] = (unsigned short)(vw.x >> 16);
            vt[2 * (ATT_VSTR / 2)] = (unsigned short)(vw.y & 0xffffu); vt[3 * (ATT_VSTR / 2)] = (unsigned short)(vw.y >> 16);
            vt[4 * (ATT_VSTR / 2)] = (unsigned short)(vw.z & 0xffffu); vt[5 * (ATT_VSTR / 2)] = (unsigned short)(vw.z >> 16);
            vt[6 * (ATT_VSTR / 2)] = (unsigned short)(vw.w & 0xffffu); vt[7 * (ATT_VSTR / 2)] = (unsigned short)(vw.w >> 16);
        }
        const size_t orow = rowb + ((size_t)(m0 + 32 * wave + c) << dsh) + r;
        bf16x8 qf[4];
        { const bf16* qp = proj + orow * PW + 3072 + h * 64 + 8 * hh; float qv[4][8]; float ss = 0.f;
#pragma unroll
            for (int s = 0; s < 4; ++s) { unpack8(*(const v4u*)(qp + 16 * s), qv[s]);
#pragma unroll
                for (int e = 0; e < 8; ++e) ss += qv[s][e] * qv[s][e]; }
            ss += __shfl_xor(ss, 32);
            const float rs = rsqrtf(ss * (1.f / 64.f) + EPS) * (0.125f * 1.4426950408889634f);
#pragma unroll
            for (int s = 0; s < 4; ++s) { const f32x4 g0 = *(const f32x4*)(qgain + 16 * s + 8 * hh), g1 = *(const f32x4*)(qgain + 16 * s + 8 * hh + 4);
                v4u w; w.x = pkbf(qv[s][0] * rs * g0.x, qv[s][1] * rs * g0.y); w.y = pkbf(qv[s][2] * rs * g0.z, qv[s][3] * rs * g0.w);
                w.z = pkbf(qv[s][4] * rs * g1.x, qv[s][5] * rs * g1.y); w.w = pkbf(qv[s][6] * rs * g1.z, qv[s][7] * rs * g1.w); qf[s] = __builtin_bit_cast(bf16x8, w); } }
        __syncthreads();
        f32x16 sc[5];
#pragma unroll
        for (int j = 0; j < 5; ++j) {
#pragma unroll
            for (int e = 0; e < 16; ++e) sc[j][e] = 0.f;
#pragma unroll
            for (int s = 0; s < 4; ++s) { const bf16x8 kf = *(const LAS bf16x8*)(L + ATT_KS + (32 * wave + 32 * j + c) * ATT_KSTR + (16 * s + 8 * hh) * 2);
                sc[j] = __builtin_amdgcn_mfma_f32_32x32x16_bf16(kf, qf[s], sc[j], 0, 0, 0); } }
        const LAS float* tb = (const LAS float*)(L + ATT_BIAS) + (32 + 4 * hh - c);
        float mx = -INFINITY;
#pragma unroll
        for (int j = 0; j < 5; ++j)
#pragma unroll
            for (int e = 0; e < 16; ++e) sc[j][e] += tb[32 * j + (e & 3) + 8 * (e >> 2)];
        if (m0 == 0 && wave < 4) {
#pragma unroll
            for (int j = 0; j < 5; ++j)
#pragma unroll
                for (int e = 0; e < 16; ++e) if (32 * wave + 4 * hh + 32 * j + (e & 3) + 8 * (e >> 2) < 128) sc[j][e] = -INFINITY; }
#pragma unroll
        for (int j = 0; j < 5; ++j)
#pragma unroll
            for (int e = 0; e < 16; ++e) mx = fmaxf(mx, sc[j][e]);
        mx = fmaxf(mx, __shfl_xor(mx, 32));
        float l = 0.f;
#pragma unroll
        for (int j = 0; j < 5; ++j)
#pragma unroll
            for (int e = 0; e < 16; ++e) { const float pe = __builtin_amdgcn_exp2f(sc[j][e] - mx); sc[j][e] = pe; l += pe; }
        l += __shfl_xor(l, 32);
        f32x16 o[2];
#pragma unroll
        for (int e = 0; e < 16; ++e) { o[0][e] = 0.f; o[1][e] = 0.f; }
#pragma unroll
        for (int j = 0; j < 5; ++j)
#pragma unroll
            for (int s2 = 0; s2 < 2; ++s2) {
                v4u pw; pw.x = pkbf(sc[j][8 * s2 + 0], sc[j][8 * s2 + 1]); pw.y = pkbf(sc[j][8 * s2 + 2], sc[j][8 * s2 + 3]); pw.z = pkbf(sc[j][8 * s2 + 4], sc[j][8 * s2 + 5]); pw.w = pkbf(sc[j][8 * s2 + 6], sc[j][8 * s2 + 7]);
                const bf16x8 pf = __builtin_bit_cast(bf16x8, pw);
                const int kb = 32 * wave + 32 * j + 16 * s2 + 4 * hh;
#pragma unroll
                for (int dt = 0; dt < 2; ++dt) { const LAS unsigned char* vp = L + ATT_VT + (32 * dt + c) * ATT_VSTR + kb * 2;
                    const v2u lo = *(const LAS v2u*)vp, hi = *(const LAS v2u*)(vp + 16);
                    v4u vw4; vw4.x = lo.x; vw4.y = lo.y; vw4.z = hi.x; vw4.w = hi.y;
                    o[dt] = __builtin_amdgcn_mfma_f32_32x32x16_bf16(__builtin_bit_cast(bf16x8, vw4), pf, o[dt], 0, 0, 0); } }
        const float inv = 1.f / l;
        bf16* op = part + ((size_t)p * TOKG + orow) * 1024 + h * 64 + 4 * hh;
#pragma unroll
        for (int dt = 0; dt < 2; ++dt)
#pragma unroll
            for (int g4 = 0; g4 < 4; ++g4) { v2u w; w.x = pkbf(o[dt][4 * g4] * inv, o[dt][4 * g4 + 1] * inv); w.y = pkbf(o[dt][4 * g4 + 2] * inv, o[dt][4 * g4 + 3] * inv);
                *(v2u*)(op + 32 * dt + 8 * g4) = w; }
        if (hh == 0) lse[((size_t)p * TOKG + orow) * 16 + h] = mx * 0.6931471805599453f + __logf(l);
    }
}
__device__ __forceinline__ void merge_conv(const bf16* proj, const bf16* part, const float* lse, bf16* y, int TOKG, const float* convw, int lane, int gw, int ngw) {
    for (int it = gw; it < TOKG; it += ngw) {
        const int t = it & (SEQ - 1); const bf16* prow = proj + (size_t)it * PW;
#pragma unroll
        for (int i = 0; i < 2; ++i) { const int c0 = lane * 8 + 512 * i;
            float acc[8] = {0.f, 0.f, 0.f, 0.f, 0.f, 0.f, 0.f, 0.f};
#pragma unroll
            for (int dt = 0; dt < 3; ++dt) { const int tt = t - 2 + dt;
                if (tt >= 0) { const bf16* pr = prow - (size_t)(2 - dt) * PW; float gc[8], xa[8];
                    unpack8(*(const v4u*)(pr + 1024 + c0), gc); unpack8(*(const v4u*)(pr + 2048 + c0), xa);
#pragma unroll
                    for (int e = 0; e < 8; ++e) acc[e] += convw[dt * 1024 + c0 + e] * (gc[e] * xa[e]); } }
            float gb[8], z[8]; unpack8(*(const v4u*)(prow + c0), gb); unpack8(*(const v4u*)(prow + 6144 + c0), z);
            v4u o; o.x = pk2(gb[0] * acc[0] * z[0], gb[1] * acc[1] * z[1]); o.y = pk2(gb[2] * acc[2] * z[2], gb[3] * acc[3] * z[3]);
            o.z = pk2(gb[4] * acc[4] * z[4], gb[5] * acc[5] * z[5]); o.w = pk2(gb[6] * acc[6] * z[6], gb[7] * acc[7] * z[7]);
            *(v4u*)(y + (size_t)it * MW + c0) = o; }
#pragma unroll
        for (int i = 0; i < 2; ++i) { const int c0 = lane * 8 + 512 * i, h = c0 >> 6;
            const float l0 = lse[((size_t)0 * TOKG + it) * 16 + h], l1 = lse[((size_t)1 * TOKG + it) * 16 + h], l2 = lse[((size_t)2 * TOKG + it) * 16 + h];
            const float mx = fmaxf(l0, fmaxf(l1, l2)); float w0 = __expf(l0 - mx), w1 = __expf(l1 - mx), w2 = __expf(l2 - mx); const float inv = 1.f / (w0 + w1 + w2); w0 *= inv; w1 *= inv; w2 *= inv;
            float a0[8], a1[8], a2[8], z[8];
            unpack8(*(const v4u*)(part + ((size_t)0 * TOKG + it) * 1024 + c0), a0); unpack8(*(const v4u*)(part + ((size_t)1 * TOKG + it) * 1024 + c0), a1); unpack8(*(const v4u*)(part + ((size_t)2 * TOKG + it) * 1024 + c0), a2);
            unpack8(*(const v4u*)(prow + 6144 + 1024 + c0), z);
            float r[8];
#pragma unroll
            for (int e = 0; e < 8; ++e) r[e] = (w0 * a0[e] + w1 * a1[e] + w2 * a2[e]) * z[e];
            v4u o; o.x = pk2(r[0], r[1]); o.y = pk2(r[2], r[3]); o.z = pk2(r[4], r[5]); o.w = pk2(r[6], r[7]);
            *(v4u*)(y + (size_t)it * MW + 1024 + c0) = o; }
    }
}

__device__ __forceinline__ void hgrn_scalar(const bf16* proj, bf16* y, int TOKG, const float* ogain, unsigned char* lds, int tid, int lane, int wave, int bid, int G) {
    float* sq = (float*)lds; float* sf = sq + 4096; float* sk = sf + 4096; float* sv = sk + 4096; float* sop = sv + 4096;
    const int nseq = (TOKG / SEQ) * 16;
    const int v = tid & 127, kq = tid >> 7;
    for (int s = bid; s < nseq; s += G) {
        const int bl = s >> 4, h = s & 15; const size_t rowb = (size_t)bl * SEQ;
        float S[32];
#pragma unroll
        for (int i = 0; i < 32; ++i) S[i] = 0.f;
        const float og0 = ogain[h * 128 + lane], og1 = ogain[h * 128 + 64 + lane];
        for (int t0 = 0; t0 < SEQ; t0 += 32) {
#pragma unroll
            for (int i = 0; i < 8; ++i) { const int idx = tid + 512 * i, tt = idx >> 7, col = idx & 127; const bf16* prow = proj + (rowb + t0 + tt) * PW + h * 128 + col;
                sq[idx] = bf2f(prow[0]); const float f = __expf(bf2f(prow[2048])); sf[idx] = f; sk[idx] = 1.f - f; sv[idx] = bf2f(prow[4096]); }
            __syncthreads();
            for (int tt = 0; tt < 32; ++tt) {
                const float vv = sv[tt * 128 + v]; float acc = 0.f;
                const f32x4* pf = (const f32x4*)(sf + tt * 128 + kq * 32); const f32x4* pk = (const f32x4*)(sk + tt * 128 + kq * 32); const f32x4* pq = (const f32x4*)(sq + tt * 128 + kq * 32);
#pragma unroll
                for (int i4 = 0; i4 < 8; ++i4) { const f32x4 f = pf[i4], k = pk[i4], q = pq[i4];
#pragma unroll
                    for (int e = 0; e < 4; ++e) { S[i4 * 4 + e] = f[e] * S[i4 * 4 + e] + k[e] * vv; acc += q[e] * S[i4 * 4 + e]; } }
                sop[(kq * 32 + tt) * 128 + v] = acc;
            }
            __syncthreads();
#pragma unroll
            for (int i2 = 0; i2 < 4; ++i2) { const int tt = wave + 8 * i2;
                float o0 = 0.f, o1 = 0.f;
#pragma unroll
                for (int k4 = 0; k4 < 4; ++k4) { o0 += sop[(k4 * 32 + tt) * 128 + lane]; o1 += sop[(k4 * 32 + tt) * 128 + 64 + lane]; }
                const float rstd = rsqrtf(wave_sum(o0 * o0 + o1 * o1) * (1.f / 128.f) + EPS);
                const bf16* prow = proj + (rowb + t0 + tt) * PW + 6144 + h * 128;
                bf16* yr = y + (rowb + t0 + tt) * MW + h * 128;
                yr[lane] = (bf16)f2bf(o0 * rstd * og0 * bf2f(prow[lane])); yr[64 + lane] = (bf16)f2bf(o1 * rstd * og1 * bf2f(prow[64 + lane])); }
            __syncthreads();
        }
    }
}


typedef float f32x4h __attribute__((ext_vector_type(4)));
typedef float f32x2h __attribute__((ext_vector_type(2)));
#define MFMA16(a, b, c) __builtin_amdgcn_mfma_f32_16x16x32_bf16((a), (b), (c), 0, 0, 0)
constexpr float LOG2E = 1.4426950408889634f;
constexpr int HS = 144, HQS = 272;
constexpr int H1_KT = 0, H1_VT = 128 * HS, H1_SEG = 2 * 128 * HS;
constexpr int H3_QH = 0, H3_QM = 64 * HQS, H3_KM = 2 * 64 * HQS, H3_VT = 3 * 64 * HQS, H3_AM = H3_VT + 128 * HS, H3_SEG = H3_AM + 64 * HS, H3_RED = H3_SEG + 4096;
__device__ __forceinline__ float lo16(unsigned w) { return __uint_as_float(w << 16); }
__device__ __forceinline__ float hi16(unsigned w) { return __uint_as_float(w & 0xffff0000u); }
__device__ __forceinline__ void hgrn_h1(const bf16* proj, bf16* ST, float* dec, int TOKG, unsigned char* lds, int tid, int lane, int wave, int bid, int G) {
    LAS unsigned char* L = (LAS unsigned char*)lds;
    LAS float* segtot = (LAS float*)(L + H1_SEG);
    const int nunits = (TOKG / SEQ) * 16 * 128;
    const int fr = lane & 15, fq = lane >> 4;
    unsigned rg[8], rv[8];
#define H1_LOAD(u_) do { const int cch_ = (u_) & 127, seq_ = (u_) >> 7; const unsigned* pb_ = (const unsigned*)(proj + ((size_t)(seq_ >> 4) * SEQ + cch_ * 64 + wave * 8) * PW + (seq_ & 15) * 128) + lane; \
        _Pragma("unroll") for (int i = 0; i < 8; ++i) { rg[i] = pb_[(size_t)i * (PW / 2) + 1024]; rv[i] = pb_[(size_t)i * (PW / 2) + 2048]; } } while (0)
    if (bid < nunits) H1_LOAD(bid);
    for (int u = bid; u < nunits; u += G) {
        float gc0[8], gc1[8], kv0[8], kv1[8]; float run0 = 0.f, run1 = 0.f; v4u vv0, vv1;
#pragma unroll
        for (int i = 0; i < 8; ++i) { const float g0 = lo16(rg[i]) * LOG2E, g1 = hi16(rg[i]) * LOG2E; run0 += g0; run1 += g1; gc0[i] = run0; gc1[i] = run1;
            kv0[i] = 1.f - __builtin_amdgcn_exp2f(g0); kv1[i] = 1.f - __builtin_amdgcn_exp2f(g1); }
        vv0.x = (rv[0] & 0xffffu) | (rv[1] << 16); vv0.y = (rv[2] & 0xffffu) | (rv[3] << 16); vv0.z = (rv[4] & 0xffffu) | (rv[5] << 16); vv0.w = (rv[6] & 0xffffu) | (rv[7] << 16);
        vv1.x = (rv[0] >> 16) | (rv[1] & 0xffff0000u); vv1.y = (rv[2] >> 16) | (rv[3] & 0xffff0000u); vv1.z = (rv[4] >> 16) | (rv[5] & 0xffff0000u); vv1.w = (rv[6] >> 16) | (rv[7] & 0xffff0000u);
        if (u + G < nunits) H1_LOAD(u + G);
        __syncthreads();
        *(LAS f32x2h*)(segtot + wave * 128 + 2 * lane) = (f32x2h){run0, run1};
        *(LAS v4u*)(L + H1_VT + (2 * lane) * HS + wave * 16) = vv0; *(LAS v4u*)(L + H1_VT + (2 * lane + 1) * HS + wave * 16) = vv1;
        __syncthreads();
        float pre0 = 0.f, pre1 = 0.f, tot0 = 0.f, tot1 = 0.f;
#pragma unroll
        for (int s8 = 0; s8 < 8; ++s8) { const f32x2h t = *(const LAS f32x2h*)(segtot + s8 * 128 + 2 * lane); tot0 += t.x; tot1 += t.y; pre0 += (s8 < wave) ? t.x : 0.f; pre1 += (s8 < wave) ? t.y : 0.f; }
        { v4u a, b; const float e0 = tot0 - pre0, e1 = tot1 - pre1;
          a.x = pkbf(kv0[0] * __builtin_amdgcn_exp2f(e0 - gc0[0]), kv0[1] * __builtin_amdgcn_exp2f(e0 - gc0[1])); a.y = pkbf(kv0[2] * __builtin_amdgcn_exp2f(e0 - gc0[2]), kv0[3] * __builtin_amdgcn_exp2f(e0 - gc0[3]));
          a.z = pkbf(kv0[4] * __builtin_amdgcn_exp2f(e0 - gc0[4]), kv0[5] * __builtin_amdgcn_exp2f(e0 - gc0[5])); a.w = pkbf(kv0[6] * __builtin_amdgcn_exp2f(e0 - gc0[6]), kv0[7] * __builtin_amdgcn_exp2f(e0 - gc0[7]));
          b.x = pkbf(kv1[0] * __builtin_amdgcn_exp2f(e1 - gc1[0]), kv1[1] * __builtin_amdgcn_exp2f(e1 - gc1[1])); b.y = pkbf(kv1[2] * __builtin_amdgcn_exp2f(e1 - gc1[2]), kv1[3] * __builtin_amdgcn_exp2f(e1 - gc1[3]));
          b.z = pkbf(kv1[4] * __builtin_amdgcn_exp2f(e1 - gc1[4]), kv1[5] * __builtin_amdgcn_exp2f(e1 - gc1[5])); b.w = pkbf(kv1[6] * __builtin_amdgcn_exp2f(e1 - gc1[6]), kv1[7] * __builtin_amdgcn_exp2f(e1 - gc1[7]));
          *(LAS v4u*)(L + H1_KT + (2 * lane) * HS + wave * 16) = a; *(LAS v4u*)(L + H1_KT + (2 * lane + 1) * HS + wave * 16) = b; }
        if (wave == 0) *(f32x2h*)(dec + (size_t)u * 128 + 2 * lane) = (f32x2h){__builtin_amdgcn_exp2f(tot0), __builtin_amdgcn_exp2f(tot1)};
        __syncthreads();
        f32x4h acc[8];
#pragma unroll
        for (int nk = 0; nk < 8; ++nk) acc[nk] = (f32x4h){0.f, 0.f, 0.f, 0.f};
        bf16x8 vf[2];
#pragma unroll
        for (int ks = 0; ks < 2; ++ks) vf[ks] = *(const LAS bf16x8*)(L + H1_VT + (16 * wave + fr) * HS + (32 * ks + 8 * fq) * 2);
#pragma unroll
        for (int nk = 0; nk < 8; ++nk)
#pragma unroll
            for (int ks = 0; ks < 2; ++ks) { const bf16x8 kf = *(const LAS bf16x8*)(L + H1_KT + (16 * nk + fr) * HS + (32 * ks + 8 * fq) * 2); acc[nk] = MFMA16(kf, vf[ks], acc[nk]); }
        bf16* sp = ST + (size_t)u * 16384 + (16 * wave + fr) * 128 + 4 * fq;
#pragma unroll
        for (int nk = 0; nk < 8; ++nk) { v2u w; w.x = pkbf(acc[nk][0], acc[nk][1]); w.y = pkbf(acc[nk][2], acc[nk][3]); *(v2u*)(sp + 16 * nk) = w; }
    }
#undef H1_LOAD
}
__device__ __forceinline__ void hgrn_h2(bf16* ST, const float* dec, int TOKG, int tid, int bid, int G) {
    const int nitems = (TOKG / SEQ) * 16 * 4096;
    for (int item = bid * 512 + tid; item < nitems; item += G * 512) {
        const int seq = item >> 12, rem = item & 4095;
        bf16* p = ST + (size_t)seq * (128 * 16384) + rem * 4;
        const float* dp = dec + (size_t)seq * (128 * 128) + (rem & 31) * 4;
        f32x4 S = {0.f, 0.f, 0.f, 0.f};
        for (int c0 = 0; c0 < 128; c0 += 8) {
            v2u uw[8]; f32x4 dv[8];
#pragma unroll
            for (int i = 0; i < 8; ++i) { uw[i] = *(const v2u*)(p + (size_t)(c0 + i) * 16384); dv[i] = *(const f32x4*)(dp + (c0 + i) * 128); }
#pragma unroll
            for (int i = 0; i < 8; ++i) { v2u o; o.x = pkbf(S.x, S.y); o.y = pkbf(S.z, S.w); *(v2u*)(p + (size_t)(c0 + i) * 16384) = o;
                S.x = S.x * dv[i].x + lo16(uw[i].x); S.y = S.y * dv[i].y + hi16(uw[i].x); S.z = S.z * dv[i].z + lo16(uw[i].y); S.w = S.w * dv[i].w + hi16(uw[i].y); }
        }
    }
}
__device__ __forceinline__ void hgrn_h3(const bf16* proj, const bf16* ST, bf16* y, int TOKG, const float* ogain, unsigned char* lds, int tid, int lane, int wave, int bid, int G) {
    LAS unsigned char* L = (LAS unsigned char*)lds;
    LAS float* segtot = (LAS float*)(L + H3_SEG); LAS float* red = (LAS float*)(L + H3_RED);
    const int nunits = (TOKG / SEQ) * 16 * 128;
    const int fr = lane & 15, fq = lane >> 4;
    unsigned rq[8], rg[8], rv[8];
#define H3_LOAD(u_) do { const int cch_ = (u_) & 127, seq_ = (u_) >> 7; const unsigned* pb_ = (const unsigned*)(proj + ((size_t)(seq_ >> 4) * SEQ + cch_ * 64 + wave * 8) * PW + (seq_ & 15) * 128) + lane; \
        _Pragma("unroll") for (int i = 0; i < 8; ++i) { rq[i] = pb_[(size_t)i * (PW / 2)]; rg[i] = pb_[(size_t)i * (PW / 2) + 1024]; rv[i] = pb_[(size_t)i * (PW / 2) + 2048]; } } while (0)
    if (bid < nunits) H3_LOAD(bid);
    for (int u = bid; u < nunits; u += G) {
        const int cch = u & 127, seq = u >> 7, h = seq & 15, bl = seq >> 4;
        const size_t rowc = (size_t)bl * SEQ + cch * 64;
        const int v0 = 16 * wave + 4 * fq;
        bf16x8 sf[4]; v2u zw[4];
        { const bf16* sp = ST + (size_t)u * 16384 + (16 * wave + fr) * 128 + 8 * fq;
#pragma unroll
          for (int ks = 0; ks < 4; ++ks) sf[ks] = *(const bf16x8*)(sp + 32 * ks);
#pragma unroll
          for (int t2 = 0; t2 < 4; ++t2) zw[t2] = *(const v2u*)(proj + (rowc + 16 * t2 + fr) * PW + 6144 + h * 128 + v0); }
        float gc0[8], gc1[8], kv0[8], kv1[8], qv0[8], qv1[8]; float run0 = 0.f, run1 = 0.f; v4u vv0, vv1;
#pragma unroll
        for (int i = 0; i < 8; ++i) { const float g0 = lo16(rg[i]) * LOG2E, g1 = hi16(rg[i]) * LOG2E; run0 += g0; run1 += g1; gc0[i] = run0; gc1[i] = run1;
            kv0[i] = 1.f - __builtin_amdgcn_exp2f(g0); kv1[i] = 1.f - __builtin_amdgcn_exp2f(g1); qv0[i] = lo16(rq[i]); qv1[i] = hi16(rq[i]); }
        vv0.x = (rv[0] & 0xffffu) | (rv[1] << 16); vv0.y = (rv[2] & 0xffffu) | (rv[3] << 16); vv0.z = (rv[4] & 0xffffu) | (rv[5] << 16); vv0.w = (rv[6] & 0xffffu) | (rv[7] << 16);
        vv1.x = (rv[0] >> 16) | (rv[1] & 0xffff0000u); vv1.y = (rv[2] >> 16) | (rv[3] & 0xffff0000u); vv1.z = (rv[4] >> 16) | (rv[5] & 0xffff0000u); vv1.w = (rv[6] >> 16) | (rv[7] & 0xffff0000u);
        if (u + G < nunits) H3_LOAD(u + G);
        __syncthreads();
        *(LAS f32x2h*)(segtot + wave * 128 + 2 * lane) = (f32x2h){run0, run1};
        *(LAS v4u*)(L + H3_VT + (2 * lane) * HS + wave * 16) = vv0; *(LAS v4u*)(L + H3_VT + (2 * lane + 1) * HS + wave * 16) = vv1;
        __syncthreads();
        { float pre0 = 0.f, pre1 = 0.f, gr0 = 0.f, gr1 = 0.f;
#pragma unroll
          for (int s8 = 0; s8 < 8; ++s8) { const f32x2h t = *(const LAS f32x2h*)(segtot + s8 * 128 + 2 * lane); pre0 += (s8 < wave) ? t.x : 0.f; pre1 += (s8 < wave) ? t.y : 0.f; if (s8 < 4) { gr0 += t.x; gr1 += t.y; } }
#pragma unroll
          for (int i = 0; i < 8; ++i) { const float c0 = pre0 + gc0[i], c1 = pre1 + gc1[i]; const int s = wave * 8 + i;
              *(LAS unsigned*)(L + H3_QH + s * HQS + lane * 4) = pkbf(qv0[i] * __builtin_amdgcn_exp2f(c0), qv1[i] * __builtin_amdgcn_exp2f(c1));
              *(LAS unsigned*)(L + H3_QM + s * HQS + lane * 4) = pkbf(qv0[i] * __builtin_amdgcn_exp2f(fminf(c0 - gr0, 115.f)), qv1[i] * __builtin_amdgcn_exp2f(fminf(c1 - gr1, 115.f)));
              *(LAS unsigned*)(L + H3_KM + s * HQS + lane * 4) = pkbf(kv0[i] * __builtin_amdgcn_exp2f(fminf(gr0 - c0, 115.f)), kv1[i] * __builtin_amdgcn_exp2f(fminf(gr1 - c1, 115.f))); } }
        __syncthreads();
        { const int tt = wave >> 1;
#pragma unroll
          for (int ss2 = 0; ss2 < 2; ++ss2) { const int ss = 2 * (wave & 1) + ss2; f32x4h a = {0.f, 0.f, 0.f, 0.f};
              if (ss <= tt) {
#pragma unroll
                  for (int ks = 0; ks < 4; ++ks) { const bf16x8 kmf = *(const LAS bf16x8*)(L + H3_KM + (16 * ss + fr) * HQS + (32 * ks + 8 * fq) * 2);
                      const bf16x8 qmf = *(const LAS bf16x8*)(L + H3_QM + (16 * tt + fr) * HQS + (32 * ks + 8 * fq) * 2); a = MFMA16(kmf, qmf, a); } }
              const int t = 16 * tt + fr, s0 = 16 * ss + 4 * fq;
              v2u w; w.x = pkbf(s0 <= t ? a[0] : 0.f, s0 + 1 <= t ? a[1] : 0.f); w.y = pkbf(s0 + 2 <= t ? a[2] : 0.f, s0 + 3 <= t ? a[3] : 0.f);
              *(LAS v2u*)(L + H3_AM + t * HS + s0 * 2) = w; } }
        __syncthreads();
        f32x4h acc[4];
#pragma unroll
        for (int t2 = 0; t2 < 4; ++t2) acc[t2] = (f32x4h){0.f, 0.f, 0.f, 0.f};
#pragma unroll
        for (int t2 = 0; t2 < 4; ++t2)
#pragma unroll
            for (int ks = 0; ks < 4; ++ks) { const bf16x8 qf = *(const LAS bf16x8*)(L + H3_QH + (16 * t2 + fr) * HQS + (32 * ks + 8 * fq) * 2); acc[t2] = MFMA16(sf[ks], qf, acc[t2]); }
        bf16x8 vf[2];
#pragma unroll
        for (int ks = 0; ks < 2; ++ks) vf[ks] = *(const LAS bf16x8*)(L + H3_VT + (16 * wave + fr) * HS + (32 * ks + 8 * fq) * 2);
#pragma unroll
        for (int t2 = 0; t2 < 4; ++t2)
#pragma unroll
            for (int ks = 0; ks < 2; ++ks) { const bf16x8 af = *(const LAS bf16x8*)(L + H3_AM + (16 * t2 + fr) * HS + (32 * ks + 8 * fq) * 2); acc[t2] = MFMA16(vf[ks], af, acc[t2]); }
#pragma unroll
        for (int t2 = 0; t2 < 4; ++t2) { float ss = acc[t2][0] * acc[t2][0] + acc[t2][1] * acc[t2][1] + acc[t2][2] * acc[t2][2] + acc[t2][3] * acc[t2][3];
            ss += __shfl_xor(ss, 16); ss += __shfl_xor(ss, 32); if (fq == 0) red[wave * 64 + 16 * t2 + fr] = ss; }
        __syncthreads();
        const f32x4 og = *(const f32x4*)(ogain + h * 128 + v0);
#pragma unroll
        for (int t2 = 0; t2 < 4; ++t2) { const int t = 16 * t2 + fr; float tot = 0.f;
#pragma unroll
            for (int w8 = 0; w8 < 8; ++w8) tot += red[w8 * 64 + t];
            const float rstd = rsqrtf(tot * (1.f / 128.f) + EPS);
            v2u w; w.x = pkbf(acc[t2][0] * rstd * og.x * lo16(zw[t2].x), acc[t2][1] * rstd * og.y * hi16(zw[t2].x));
            w.y = pkbf(acc[t2][2] * rstd * og.z * lo16(zw[t2].y), acc[t2][3] * rstd * og.w * hi16(zw[t2].y));
            *(v2u*)(y + (rowc + t) * MW + h * 128 + v0) = w; }
    }
#undef H3_LOAD
}

#define XB_TMO      128
#define XB_XCNT(j)  (256  + 64 * (j))
#define XB_XSUB(j)  (1280 + 64 * (j))
#define XB_XGEN(j)  (2304 + 64 * (j))
#define XB_TOP      3328
#define XB_TOPGEN   3392
#define XCD_BAR_WORDS 3456
#define XB_SPIN_CAP (1u << 18)

__device__ __forceinline__ unsigned xb_ld(unsigned* p)              { return __hip_atomic_load(p, __ATOMIC_RELAXED, __HIP_MEMORY_SCOPE_AGENT); }
__device__ __forceinline__ unsigned xb_add(unsigned* p, unsigned v) { return __hip_atomic_fetch_add(p, v, __ATOMIC_RELAXED, __HIP_MEMORY_SCOPE_AGENT); }
__device__ __forceinline__ unsigned xb_xcc_id() { return (unsigned)__builtin_amdgcn_s_getreg((3 << 11) | 20) & 0xFu; }
#define XB_SPIN(cond, bar) do { unsigned _sp = 0; while (cond) { __builtin_amdgcn_s_sleep(1); \
    if ((++_sp & 255u) == 0u) { if (xb_ld(&(bar)[XB_TMO])) break; if (_sp > XB_SPIN_CAP) { atomicAdd(&(bar)[XB_TMO], 1u); break; } } } } while (0)

struct XcdBarrier {
    unsigned* bar; unsigned x;
    volatile LAS unsigned* st;
};

__device__ __forceinline__ XcdBarrier xcd_barrier_post(unsigned* bar, volatile LAS unsigned* st) {
    XcdBarrier b; b.bar = bar; b.x = xb_xcc_id(); b.st = st;
    if (threadIdx.x == 0) (void)xb_add(&bar[XB_XCNT(b.x)], 1u);
    return b;
}
__device__ __forceinline__ void xcd_barrier_complete(unsigned* bar, unsigned x, unsigned& nloc, unsigned& nx) {
    const unsigned G = gridDim.x * gridDim.y * gridDim.z;
    unsigned sum, cnt, mine, sp = 0u;
    for (;;) {
        sum = 0u; cnt = 0u; mine = 0u;
#pragma unroll
        for (unsigned j = 0; j < 16; ++j) { const unsigned c = xb_ld(&bar[XB_XCNT(j)]); sum += c; cnt += (c > 0u) ? 1u : 0u; mine = (j == x) ? c : mine; }
        if (sum == G) break;
        __builtin_amdgcn_s_sleep(1);
        if ((++sp & 255u) == 0u) { if (xb_ld(&bar[XB_TMO])) break; if (sp > XB_SPIN_CAP) { atomicAdd(&bar[XB_TMO], 1u); break; } }
    }
    nloc = mine > 0u ? mine : 1u; nx = cnt > 0u ? cnt : 1u;
}

__device__ __forceinline__ void xcd_barrier(const XcdBarrier& b) {
    asm volatile("s_waitcnt vmcnt(0)" ::: "memory");
    __syncthreads();
    if (threadIdx.x == 0) {
        unsigned* bar = b.bar;
        __builtin_amdgcn_s_waitcnt(0);
        unsigned nloc = b.st[0], nx = b.st[1];
        if (nloc == 0u) { xcd_barrier_complete(bar, b.x, nloc, nx); b.st[0] = nloc; b.st[1] = nx; }
        const unsigned old = xb_add(&bar[XB_XSUB(b.x)], 1u);
        const unsigned gen = old / nloc;
        if (old + 1u == (gen + 1u) * nloc) {
            __builtin_amdgcn_fence(__ATOMIC_RELEASE, "agent");
            asm volatile("s_waitcnt vmcnt(0)" ::: "memory");
            const unsigned og = xb_add(&bar[XB_TOP], 1u);
            const unsigned tg = og / nx;
            if (og + 1u == (tg + 1u) * nx) xb_add(&bar[XB_TOPGEN], 1u);
            else XB_SPIN(xb_ld(&bar[XB_TOPGEN]) == tg, bar);
            __builtin_amdgcn_fence(__ATOMIC_ACQUIRE, "agent");
            xb_add(&bar[XB_XGEN(b.x)], 1u);
            asm volatile("s_waitcnt vmcnt(0)" ::: "memory");
        } else {
            XB_SPIN(xb_ld(&bar[XB_XGEN(b.x)]) == gen, bar);
            __builtin_amdgcn_fence(__ATOMIC_ACQUIRE, "agent");
            asm volatile("s_waitcnt vmcnt(0)" ::: "memory");
        }
    }
    __syncthreads();
}

__device__ __forceinline__ unsigned long long ldptr(LAS unsigned long long* tab, int i) { asm volatile("" ::: "memory"); const unsigned long long v = tab[i];
    const unsigned lo = __builtin_amdgcn_readfirstlane((unsigned)v), hi = __builtin_amdgcn_readfirstlane((unsigned)(v >> 32)); return ((unsigned long long)hi << 32) | lo; }
struct Args { const float* in[13]; float* out; unsigned char* ws; int ngroups; int pad; };
struct Ctx { int layer, g, NG, TOKG, j, even, tid, lane, wave, G, bid, gw, ngw; unsigned char* wsb; bf16 *Wt_in, *Wt_out, *proj, *ybuf, *xn; float* lbtab; size_t row0; };
__device__ __forceinline__ Ctx load_ctx(LAS unsigned long long* ptab) {
    Ctx c; const int step = (int)ldptr(ptab, 16); c.NG = (int)ldptr(ptab, 15); c.layer = step / c.NG; c.g = step - c.layer * c.NG; c.TOKG = NTOK / c.NG; c.j = c.layer >> 1; c.even = !(c.layer & 1);
    int tid_raw = threadIdx.x; asm volatile("" : "+v"(tid_raw)); c.tid = tid_raw; c.lane = c.tid & 63; c.wave = __builtin_amdgcn_readfirstlane(c.tid >> 6);
    c.G = gridDim.x; c.bid = blockIdx.x; c.gw = c.bid * 8 + c.wave; c.ngw = c.G * 8;
    c.wsb = (unsigned char*)ldptr(ptab, 14);
    c.Wt_in = (bf16*)(c.wsb + WS_WIN); c.Wt_out = (bf16*)(c.wsb + WS_WOUT); c.lbtab = (float*)(c.wsb + WS_MISC); c.proj = (bf16*)(c.wsb + WS_PROJ);
    c.ybuf = (bf16*)(c.wsb + WS_PROJ + (size_t)c.TOKG * (PW * 2)); c.xn = (bf16*)(c.wsb + WS_PROJ + (size_t)c.TOKG * (PW * 2 + MW * 2));
    c.row0 = (size_t)c.g * c.TOKG; return c;
}
#define ARGP(i) ((const float*)ldptr(ptab, (i)))
__global__ void __launch_bounds__(512, 2) fwd(Args a) {
    extern __shared__ __attribute__((aligned(16))) unsigned char lds[];
    cg::grid_group grid = cg::this_grid();
    LAS unsigned long long* ptab = (LAS unsigned long long*)((LAS unsigned char*)lds + 131072 + 1024);
    if (threadIdx.x == 0) {
#pragma unroll
        for (int i = 0; i < 13; ++i) ptab[i] = (unsigned long long)a.in[i];
        ptab[13] = (unsigned long long)a.out; ptab[14] = (unsigned long long)a.ws; ptab[15] = (unsigned long long)a.ngroups; ptab[16] = 0ull;
        ((LAS unsigned*)(ptab + 24))[0] = 0u; ((LAS unsigned*)(ptab + 24))[1] = 0u; }
    __syncthreads();
    (void)xcd_barrier_post((unsigned*)(ldptr(ptab, 14) + WS_BAR), (volatile LAS unsigned*)(ptab + 24));
#define GSYNC() do { XcdBarrier b_; b_.bar = (unsigned*)(ldptr(ptab, 14) + WS_BAR); b_.x = xb_xcc_id(); b_.st = (volatile LAS unsigned*)(ptab + 24); xcd_barrier(b_); } while (0)
    for (;;) {
        {
            const Ctx c = load_ctx(ptab);
            if (c.g == 0) {
                const float* w_in = (c.even ? ARGP(2) : ARGP(9)) + (size_t)c.j * D * PW;
                const float* ln = (c.even ? ARGP(1) : ARGP(8)) + (size_t)c.j * D;
                const float* w_out = (c.even ? ARGP(6) : ARGP(12)) + (size_t)c.j * MW * D;
                LAS float* scr = (LAS float*)((LAS unsigned char*)lds + c.wave * 16384);
                constexpr int I_IN = (D / 64) * (PW / 32), I_OUT = (MW / 64) * (D / 32);
                for (int it = c.gw; it < I_IN + I_OUT; it += c.ngw) {
                    if (it < I_IN) transpose_item(w_in, D, PW, ln, c.Wt_in, scr, it, c.lane);
                    else transpose_item(w_out, MW, D, nullptr, c.Wt_out, scr, it - I_IN, c.lane);
                }
                if (!c.even && c.bid == 0) { const float* lbp = ARGP(10);
                    for (int col = c.tid; col < 2048; col += 512) c.lbtab[col] = (c.j == 0) ? 0.f : 1.f / (1.f + expf(lbp[col] - lbp[2048 + col])); }
            }
            const float* xsrc = (c.layer == 0) ? ARGP(0) : ARGP(13);
            norm_rows(xsrc + c.row0 * D, c.xn, c.TOKG, c.gw, c.ngw, c.lane);
        }
        if ((int)ldptr(ptab, 16) == 0) grid.sync(); else GSYNC();
        {
            const Ctx c = load_ctx(ptab);
            pg8::Gemm gm{c.xn, c.Wt_in, c.TOKG, PW, D}; pg8::StaticOrder S; S.init(c.TOKG, PW, c.G, c.bid); EpiProj E{c.proj, c.even ? 0 : 1, c.lbtab};
            pg8::gemm_phase<EpiProj, pg8::StaticOrder, true, true>((PG8_LAS unsigned char*)lds, gm, S, E);
        }
        GSYNC();
        {
            const Ctx c = load_ctx(ptab);
            if (c.even) {
                attn_mfma(c.proj, c.xn, (float*)(c.xn + (size_t)c.TOKG * 3072), c.TOKG, ARGP(4) + c.j * 64, ARGP(5) + c.j * 64, ARGP(7), lds, c.tid, c.lane, c.wave, c.bid, c.G);
            } else {
                hgrn_h1(c.proj, c.xn, (float*)(c.wsb + WS_MISC + MiB), c.TOKG, lds, c.tid, c.lane, c.wave, c.bid, c.G);
            }
        }
        GSYNC();
        {
            const Ctx c = load_ctx(ptab);
            if (c.even) merge_conv(c.proj, c.xn, (const float*)(c.xn + (size_t)c.TOKG * 3072), c.ybuf, c.TOKG, ARGP(3) + c.j * 3 * 1024, c.lane, c.gw, c.ngw);
            else hgrn_h2(c.xn, (const float*)(c.wsb + WS_MISC + MiB), c.TOKG, c.tid, c.bid, c.G);
        }
        GSYNC();
        {
            const Ctx c = load_ctx(ptab);
            if (!c.even) hgrn_h3(c.proj, c.xn, c.ybuf, c.TOKG, ARGP(11) + c.j * MW, lds, c.tid, c.lane, c.wave, c.bid, c.G);
        }
        GSYNC();
        {
            const Ctx c = load_ctx(ptab);
            const float* xsrc = (c.layer == 0) ? ARGP(0) : ARGP(13);
            pg8::Gemm gm{c.ybuf, c.Wt_out, c.TOKG, D, MW}; pg8::StaticOrder S; S.init(c.TOKG, D, c.G, c.bid); EpiRes E{xsrc + c.row0 * D, (float*)ARGP(13) + c.row0 * D};
            pg8::gemm_phase<EpiRes, pg8::StaticOrder, true, true>((PG8_LAS unsigned char*)lds, gm, S, E);
        }
        GSYNC();
        const int step = (int)ldptr(ptab, 16), nsteps = 4 * (int)ldptr(ptab, 15);
        __syncthreads();
        if (threadIdx.x == 0) ptab[16] = (unsigned long long)(step + 1);
        __syncthreads();
        if (step + 1 >= nsteps) break;
    }
}

extern "C" void kernel_launch(void* const* d_in, const int* in_sizes, int n_in, void* d_out, int out_size, void* d_ws, size_t ws_size, hipStream_t stream) {
    static int grid = 0;
    if (grid == 0) {
        int dev = 0, cus = 0, per_cu = 0;
        if (hipGetDevice(&dev) != hipSuccess || hipDeviceGetAttribute(&cus, hipDeviceAttributeMultiprocessorCount, dev) != hipSuccess) { fprintf(stderr, "kernel_launch: device query failed\n"); grid = -1; return; }
        if (hipFuncSetAttribute((const void*)fwd, hipFuncAttributeMaxDynamicSharedMemorySize, LDS_BYTES) != hipSuccess) { fprintf(stderr, "kernel_launch: hipFuncSetAttribute failed\n"); grid = -1; return; }
        if (hipOccupancyMaxActiveBlocksPerMultiprocessor(&per_cu, (const void*)fwd, 512, LDS_BYTES) != hipSuccess || per_cu < 1) fprintf(stderr, "kernel_launch: occupancy query reports %d\n", per_cu);
        (void)hipGetLastError();
        grid = cus;
    }
    if (grid < 0) return;
    Args a{};
    for (int i = 0; i < 13; ++i) a.in[i] = (const float*)d_in[i];
    a.out = (float*)d_out; a.ws = (unsigned char*)d_ws;
    a.ngroups = (ws_size >= (size_t)472 * MiB) ? 2 : 4;
    if (hipMemsetAsync((char*)d_ws + WS_BAR, 0, 16384, stream) != hipSuccess) { fprintf(stderr, "kernel_launch: memset failed\n"); return; }
    void* args[] = {&a};
    hipError_t e = hipLaunchCooperativeKernel((const void*)fwd, dim3(grid), dim3(512), args, LDS_BYTES, stream);
    if (e != hipSuccess) fprintf(stderr, "kernel_launch: cooperative launch failed: %s (grid %d)\n", hipGetErrorString(e), grid);
}
```

```cpp
#include <hip/hip_runtime.h>
#include <hip/hip_cooperative_groups.h>
#include <cstdio>
#include <cstdint>
namespace cg = cooperative_groups;
namespace pg8 {
#define PG8_LAS __attribute__((address_space(3)))
typedef unsigned short bf16_t;
typedef short bf16x8 __attribute__((ext_vector_type(8)));
typedef float f32x4 __attribute__((ext_vector_type(4)));
typedef unsigned u32x4 __attribute__((ext_vector_type(4)));
constexpr int BM = 256, BK = 64, HALF = 128, HTB = HALF * BK * 2  , STAGE_BYTES = 8 * HTB, NXCD = 8, WGM = 8;

__host__ __device__ __forceinline__ int lds_byte(int r, int c) { const int st = (r >> 4) * 2 + (c >> 5), rr = r & 15, cc = c & 31, ob = rr * 64 + cc * 2; return st * 1024 + (ob ^ (((ob >> 9) & 1) << 5)); }
__host__ __device__ __forceinline__ void stage_rc(int b, int& R, int& C) { const int st = b / 1024, sb = b % 1024, swz = sb ^ (((sb >> 9) & 1) << 5); R = (st >> 1) * 16 + swz / 64; C = (st & 1) * 32 + (swz % 64) / 2; }
__host__ __device__ __forceinline__ int perm32(int rho) { const int n = rho >> 4, i = rho & 15; return 8 * (i >> 2) + 4 * n + (i & 3); }

struct Unit { int pm, pn; };
struct Gemm { const bf16_t* A; const bf16_t* Bt; int M, N, K; };

struct StaticOrder {
    int nM, nN, nwg, G, c;
    __host__ __device__ void init(int M, int N, int G_, int c_) { nM = M / BM; nN = N / BM; nwg = nM * nN; G = G_; c = c_; }
    __host__ __device__ bool next(int i, Unit& u) const {
        const long L = (long)i * G + c; if (L >= nwg) return false;
        int wgid = (int)L; { const int q = nwg / NXCD, r = nwg % NXCD, xcd = wgid % NXCD, off = wgid / NXCD; wgid = (xcd < r ? xcd * (q + 1) : r * (q + 1) + (xcd - r) * q) + off; }
        const int nig = WGM * nN, gid = wgid / nig, fm = gid * WGM, gsz = (nM - fm) < WGM ? (nM - fm) : WGM;
        u.pm = fm + ((wgid % nig) % gsz); u.pn = (wgid % nig) / gsz; return true;
    }
    __device__ __forceinline__ void a_ready(const Unit&) const {}
    __device__ __forceinline__ void done(const Unit&) const {}
};

__device__ __forceinline__ unsigned cvt_pk_bf16(float lo, float hi) { unsigned r; asm volatile("v_cvt_pk_bf16_f32 %0, %1, %2" : "=v"(r) : "v"(lo), "v"(hi)); return r; }
template <class Epi, class Sched, bool ALIGN_EPI = false, bool SP2 = false>
__device__ __forceinline__ void gemm_phase(PG8_LAS unsigned char* lds, const Gemm g, const Sched& S, const Epi& E) {
    int tid_raw = threadIdx.x; asm volatile("" : "+v"(tid_raw)); const int tid = tid_raw, wid = __builtin_amdgcn_readfirstlane(tid >> 6), lane = tid & 63, wr = wid >> 2, wc = wid & 3, fr = lane & 15, fq = lane >> 4;
    const int K = g.K, nt = K / BK;
    unsigned voffA[2], voffB[2];
#pragma unroll
    for (int i = 0; i < 2; ++i) { int R, C; stage_rc(tid * 16 + i * 8192, R, C); const int Rb = Epi::PERM ? ((R & ~31) + perm32(R & 31)) : R;
        voffA[i] = (unsigned)(R * K + C) * 2u; voffB[i] = (unsigned)(Rb * K + C) * 2u; }
    const size_t kstep = (size_t)(BK * 2);
    const size_t hstep = (size_t)HALF * K * 2;
    const size_t tstep = 2 * hstep;
    const unsigned ldsw = (unsigned)wid * 1024u;
    const int aoff = lds_byte(wr * 64 + fr, fq * 8), boff = lds_byte(wc * 32 + fr, fq * 8);
#define PG8_SA(b, h) (((b) * 2 + (h)) * HTB)
#define PG8_SB(b, h) ((4 + (b) * 2 + (h)) * HTB)
#define PG8_STAGE(bufoff, gbase, voff) do { _Pragma("unroll") for (int _i = 0; _i < 2; ++_i) \
        __builtin_amdgcn_global_load_lds((const unsigned*)((const char*)(gbase) + (voff)[_i]), (PG8_LAS unsigned*)(lds + (bufoff) + ldsw + _i * 8192), 16, 0, 0); } while (0)
#define PG8_LDA(dst, b, h) do { _Pragma("unroll") for (int m = 0; m < 4; ++m) _Pragma("unroll") for (int k = 0; k < 2; ++k) dst[m][k] = *(const PG8_LAS bf16x8*)(lds + PG8_SA(b, h) + aoff + m * 2048 + k * 1024); } while (0)
#define PG8_LDB(dst, b, h) do { _Pragma("unroll") for (int n = 0; n < 2; ++n) _Pragma("unroll") for (int k = 0; k < 2; ++k) dst[n][k] = *(const PG8_LAS bf16x8*)(lds + PG8_SB(b, h) + boff + n * 2048 + k * 1024); } while (0)
#define PG8_MMA(ai, bj, At, Bt) do { __builtin_amdgcn_s_setprio(1); _Pragma("unroll") for (int m = 0; m < 4; ++m) _Pragma("unroll") for (int n = 0; n < 2; ++n) _Pragma("unroll") for (int k = 0; k < 2; ++k) \
        acc[ai][bj][m][n] = __builtin_amdgcn_mfma_f32_16x16x32_bf16(Bt[n][k], At[m][k], acc[ai][bj][m][n], 0, 0, 0); __builtin_amdgcn_s_setprio(0); } while (0)
#define PG8_WAIT_V(n) asm volatile("s_waitcnt vmcnt(" #n ")" ::: "memory")
#define PG8_WAIT_L(n) asm volatile("s_waitcnt lgkmcnt(" #n ")" ::: "memory")
#define PG8_BAR __builtin_amdgcn_s_barrier()
#define PG8_SCHED __builtin_amdgcn_sched_barrier(0)
    Unit cur, nxt; int ui = 0;
    if (!S.next(0, cur)) return;
    f32x4 acc[2][2][4][2];
#pragma unroll
    for (int a = 0; a < 2; ++a)
#pragma unroll
        for (int b = 0; b < 2; ++b)
#pragma unroll
            for (int m = 0; m < 4; ++m)
#pragma unroll
                for (int n = 0; n < 2; ++n) acc[a][b][m][n] = (f32x4){0.f, 0.f, 0.f, 0.f};
    bf16x8 At[4][2], B0[2][2], B1[2][2];
    const char* cA = (const char*)g.A + (size_t)cur.pm * tstep; const char* cB = (const char*)g.Bt + (size_t)cur.pn * tstep;
    S.a_ready(cur);
    if constexpr (SP2) {
        PG8_STAGE(PG8_SB(0, 0), cB, voffB); PG8_STAGE(PG8_SB(0, 1), cB + hstep, voffB); PG8_STAGE(PG8_SA(0, 0), cA, voffA); PG8_STAGE(PG8_SA(0, 1), cA + hstep, voffA);
        if (wr == 1) PG8_BAR;
        PG8_WAIT_V(2); PG8_BAR;
        PG8_STAGE(PG8_SB(1, 0), cB + kstep, voffB); PG8_STAGE(PG8_SA(1, 0), cA + kstep, voffA); PG8_STAGE(PG8_SB(1, 1), cB + hstep + kstep, voffB);
        PG8_WAIT_V(6); PG8_BAR;
    } else {
        PG8_STAGE(PG8_SB(0, 0), cB, voffB); PG8_STAGE(PG8_SA(0, 0), cA, voffA); PG8_STAGE(PG8_SB(0, 1), cB + hstep, voffB); PG8_STAGE(PG8_SA(0, 1), cA + hstep, voffA);
        if (wr == 1) PG8_BAR;
        PG8_WAIT_V(4); PG8_BAR;
        PG8_STAGE(PG8_SB(1, 0), cB + kstep, voffB); PG8_STAGE(PG8_SA(1, 0), cA + kstep, voffA); PG8_STAGE(PG8_SB(1, 1), cB + hstep + kstep, voffB);
        PG8_WAIT_V(6); PG8_BAR;
    }
    for (;;) {
        const bool has_next = S.next(ui + 1, nxt);
        const char* nA = has_next ? (const char*)g.A + (size_t)nxt.pm * tstep : cA; const char* nB = has_next ? (const char*)g.Bt + (size_t)nxt.pn * tstep : cB;
        for (int t = 0; t < nt; t += 2) {
            const bool last = (t == nt - 2);
            const char* a1 = cA + (size_t)(t + 1) * kstep;
            const char* a2 = last ? nA : cA + (size_t)(t + 2) * kstep; const char* b2 = last ? nB : cB + (size_t)(t + 2) * kstep;
            const char* a3 = a2 + kstep; const char* b3 = b2 + kstep;
            if (last && has_next) S.a_ready(nxt);
            if constexpr (SP2) {
            PG8_LDB(B0, 0, 0); PG8_LDB(B1, 0, 1); PG8_SCHED; PG8_LDA(At, 0, 0); PG8_STAGE(PG8_SA(1, 1), a1 + hstep, voffA);
            PG8_WAIT_V(8); PG8_WAIT_L(0); PG8_BAR; PG8_MMA(0, 0, At, B0); PG8_MMA(0, 1, At, B1); PG8_BAR; PG8_SCHED;
            PG8_LDA(At, 0, 1); PG8_STAGE(PG8_SB(0, 0), b2, voffB); PG8_STAGE(PG8_SB(0, 1), b2 + hstep, voffB); PG8_STAGE(PG8_SA(0, 0), a2, voffA);
            PG8_WAIT_V(8); PG8_WAIT_L(0); PG8_BAR; PG8_MMA(1, 0, At, B0); PG8_MMA(1, 1, At, B1); PG8_BAR; PG8_SCHED;
            PG8_LDB(B0, 1, 0); PG8_LDB(B1, 1, 1); PG8_SCHED; PG8_LDA(At, 1, 0); PG8_STAGE(PG8_SA(0, 1), a2 + hstep, voffA);
            PG8_WAIT_V(8); PG8_WAIT_L(0); PG8_BAR; PG8_MMA(0, 0, At, B0); PG8_MMA(0, 1, At, B1); PG8_BAR; PG8_SCHED;
            PG8_LDA(At, 1, 1); PG8_STAGE(PG8_SB(1, 0), b3, voffB); PG8_STAGE(PG8_SB(1, 1), b3 + hstep, voffB); PG8_STAGE(PG8_SA(1, 0), a3, voffA);
            PG8_WAIT_V(8); PG8_WAIT_L(0); PG8_BAR; PG8_MMA(1, 0, At, B0); PG8_MMA(1, 1, At, B1); PG8_BAR; PG8_SCHED;
            } else {
            PG8_LDB(B0, 0, 0); PG8_SCHED; PG8_LDA(At, 0, 0); PG8_STAGE(PG8_SA(1, 1), a1 + hstep, voffA);
            PG8_WAIT_L(8); PG8_BAR; PG8_WAIT_L(0); PG8_MMA(0, 0, At, B0); PG8_BAR; PG8_SCHED;
            PG8_LDB(B1, 0, 1); PG8_STAGE(PG8_SB(0, 0), b2, voffB);
            PG8_BAR; PG8_WAIT_L(0); PG8_MMA(0, 1, At, B1); PG8_BAR;
            PG8_LDA(At, 0, 1); PG8_STAGE(PG8_SA(0, 0), a2, voffA);
            PG8_BAR; PG8_WAIT_L(0); PG8_MMA(1, 0, At, B0); PG8_BAR; PG8_SCHED;
            PG8_STAGE(PG8_SB(0, 1), b2 + hstep, voffB);
            PG8_WAIT_V(6); PG8_BAR; PG8_MMA(1, 1, At, B1); PG8_BAR;
            PG8_LDB(B0, 1, 0); PG8_SCHED; PG8_LDA(At, 1, 0); PG8_STAGE(PG8_SA(0, 1), a2 + hstep, voffA);
            PG8_WAIT_L(8); PG8_BAR; PG8_WAIT_L(0); PG8_MMA(0, 0, At, B0); PG8_BAR; PG8_SCHED;
            PG8_LDB(B1, 1, 1); PG8_STAGE(PG8_SB(1, 0), b3, voffB);
            PG8_BAR; PG8_WAIT_L(0); PG8_MMA(0, 1, At, B1); PG8_BAR;
            PG8_LDA(At, 1, 1); PG8_STAGE(PG8_SA(1, 0), a3, voffA);
            PG8_BAR; PG8_WAIT_L(0); PG8_MMA(1, 0, At, B0); PG8_BAR; PG8_SCHED;
            PG8_STAGE(PG8_SB(1, 1), b3 + hstep, voffB);
            PG8_WAIT_V(6); PG8_BAR; PG8_MMA(1, 1, At, B1); PG8_BAR;
            }
        }
        if constexpr (ALIGN_EPI) { if (wr == 0) PG8_BAR; }
        if constexpr (!Epi::AFTER_DRAIN) { E(acc, cur, wr, wc, fr, fq); S.done(cur); }
        if (!has_next) break;
#pragma unroll
        for (int a = 0; a < 2; ++a)
#pragma unroll
            for (int b = 0; b < 2; ++b)
#pragma unroll
                for (int m = 0; m < 4; ++m)
#pragma unroll
                    for (int n = 0; n < 2; ++n) acc[a][b][m][n] = (f32x4){0.f, 0.f, 0.f, 0.f};
        cur = nxt; cA = nA; cB = nB; ++ui;
        if constexpr (ALIGN_EPI) { if (wr == 1) PG8_BAR; }
    }
    PG8_WAIT_V(0);
    if constexpr (!ALIGN_EPI) { if (wr == 0) PG8_BAR; }
    PG8_BAR;
    if constexpr (Epi::AFTER_DRAIN) { E.fused(acc, cur, wr, wc, fr, fq, lds, wid, lane); S.done(cur); }
#undef PG8_SA
#undef PG8_SB
#undef PG8_STAGE
#undef PG8_LDA
#undef PG8_LDB
#undef PG8_MMA
#undef PG8_WAIT_V
#undef PG8_WAIT_L
#undef PG8_BAR
#undef PG8_SCHED
}
}

constexpr int D = 1024, SEQ = 8192, NBATCH = 4, NTOK = NBATCH * SEQ, PW = 8192, MW = 2048;
constexpr float EPS = 1e-6f;
constexpr size_t MiB = 1u << 20;
constexpr size_t WS_WIN = 0, WS_WOUT = 16 * MiB, WS_MISC = 20 * MiB, WS_BAR = 23 * MiB, WS_PROJ = 24 * MiB;
constexpr int LDS_BYTES = 159744, PTAB_OFF = 155648;
typedef unsigned short bf16;
typedef unsigned v4u __attribute__((ext_vector_type(4)));
typedef float f32x4 __attribute__((ext_vector_type(4)));
#define LAS __attribute__((address_space(3)))
#define GAS __attribute__((address_space(1)))

__device__ __forceinline__ float bf2f(unsigned short b) { return __uint_as_float(((unsigned)b) << 16); }
__device__ __forceinline__ unsigned f2bf(float f) { unsigned u = __float_as_uint(f); return (u + 0x7fffu + ((u >> 16) & 1u)) >> 16; }
__device__ __forceinline__ unsigned pk2(float lo, float hi) { return f2bf(lo) | (f2bf(hi) << 16); }
__device__ __forceinline__ float wave_sum(float v) {
#pragma unroll
    for (int o = 1; o < 64; o <<= 1) v += __shfl_xor(v, o);
    return v;
}
__device__ __forceinline__ float wave_max(float v) {
#pragma unroll
    for (int o = 1; o < 64; o <<= 1) v = fmaxf(v, __shfl_xor(v, o));
    return v;
}
__device__ __forceinline__ float silu_f(float x) { return x * __builtin_amdgcn_rcpf(1.f + __builtin_amdgcn_exp2f(x * -1.4426950408889634f)); }
__device__ __forceinline__ void unpack8(const v4u w, float (&f)[8]) {
    f[0] = __uint_as_float(w.x << 16); f[1] = __uint_as_float(w.x & 0xffff0000u);
    f[2] = __uint_as_float(w.y << 16); f[3] = __uint_as_float(w.y & 0xffff0000u);
    f[4] = __uint_as_float(w.z << 16); f[5] = __uint_as_float(w.z & 0xffff0000u);
    f[6] = __uint_as_float(w.w << 16); f[7] = __uint_as_float(w.w & 0xffff0000u);
}

struct EpiProj {
    static constexpr bool PERM = true, AFTER_DRAIN = false;
    GAS pg8::bf16_t* O; int odd; const GAS float* lb;
    __device__ __forceinline__ void operator()(const pg8::f32x4 (&acc)[2][2][4][2], const pg8::Unit& u, int wr, int wc, int fr, int fq) const {
        const int row0 = u.pm * 256 + wr * 64 + fr, col0 = u.pn * 256 + wc * 32 + 8 * fq;
        int act;
        if (!odd) act = (u.pn >= 24) ? 1 : 0; else act = (u.pn < 8) ? 1 : (u.pn < 16 ? 2 : (u.pn < 24 ? 0 : 1));
        pg8::f32x4 lbv[2][2];
#pragma unroll
        for (int bj = 0; bj < 2; ++bj)
#pragma unroll
            for (int n = 0; n < 2; ++n) lbv[bj][n] = (act == 2) ? *(const GAS pg8::f32x4*)(lb + (col0 - 2048) + bj * 128 + 4 * n) : (pg8::f32x4){0.f, 0.f, 0.f, 0.f};
#pragma unroll
        for (int ai = 0; ai < 2; ++ai)
#pragma unroll
            for (int m = 0; m < 4; ++m) { GAS pg8::bf16_t* rowp = O + (size_t)(row0 + ai * 128 + m * 16) * PW + col0;
#pragma unroll
                for (int bj = 0; bj < 2; ++bj) { pg8::f32x4 v0 = acc[ai][bj][m][0], v1 = acc[ai][bj][m][1];
                    if (act == 1) {
#pragma unroll
                        for (int e = 0; e < 4; ++e) { v0[e] = silu_f(v0[e]); v1[e] = silu_f(v1[e]); } }
                    else if (act == 2) {
#pragma unroll
                        for (int e = 0; e < 4; ++e) { const float s0 = __builtin_amdgcn_rcpf(1.f + __builtin_amdgcn_exp2f(v0[e] * -1.4426950408889634f)), s1 = __builtin_amdgcn_rcpf(1.f + __builtin_amdgcn_exp2f(v1[e] * -1.4426950408889634f));
                            v0[e] = __builtin_amdgcn_logf(lbv[bj][0][e] + (1.f - lbv[bj][0][e]) * s0) * 0.6931471805599453f; v1[e] = __builtin_amdgcn_logf(lbv[bj][1][e] + (1.f - lbv[bj][1][e]) * s1) * 0.6931471805599453f; } }
                    pg8::u32x4 w; w.x = pg8::cvt_pk_bf16(v0[0], v0[1]); w.y = pg8::cvt_pk_bf16(v0[2], v0[3]); w.z = pg8::cvt_pk_bf16(v1[0], v1[1]); w.w = pg8::cvt_pk_bf16(v1[2], v1[3]);
                    *(GAS pg8::u32x4*)(rowp + bj * 128) = w; } }
    }
};
struct EpiRes {
    static constexpr bool PERM = false, AFTER_DRAIN = false;
    const GAS float* base; GAS float* out;
    __device__ __forceinline__ void operator()(const pg8::f32x4 (&acc)[2][2][4][2], const pg8::Unit& u, int wr, int wc, int fr, int fq) const {
        const int row0 = u.pm * 256 + wr * 64 + fr, col0 = u.pn * 256 + wc * 32 + 4 * fq;
#pragma unroll
        for (int ai = 0; ai < 2; ++ai)
#pragma unroll
            for (int m = 0; m < 4; ++m) { const size_t off = (size_t)(row0 + ai * 128 + m * 16) * D + col0;
#pragma unroll
                for (int bj = 0; bj < 2; ++bj)
#pragma unroll
                    for (int n = 0; n < 2; ++n) { const pg8::f32x4 b = *(const GAS pg8::f32x4*)(base + off + bj * 128 + n * 16);
                        *(GAS pg8::f32x4*)(out + off + bj * 128 + n * 16) = b + acc[ai][bj][m][n]; } }
    }
};

__device__ __forceinline__ void transpose_item(const GAS float* W, int K, int N, const GAS float* gain, GAS bf16* WT, LAS float* scr, int item, int lane) {
    const int nblk = N / 32, kb = item / nblk, nb = item % nblk, k0 = 64 * kb, n0 = 32 * nb;
#pragma unroll 8
    for (int i = 0; i < 32; ++i) { const int kk = 2 * i + (lane >> 5); float w = W[(size_t)(k0 + kk) * N + n0 + (lane & 31)]; if (gain) w *= gain[k0 + kk]; scr[kk * 33 + (lane & 31)] = w; }
    asm volatile("s_waitcnt lgkmcnt(0)" ::: "memory");
    const int c = lane & 7;
#pragma unroll
    for (int j = 0; j < 4; ++j) { const int n = (lane >> 3) + 8 * j; const LAS float* s = scr + (8 * c) * 33 + n;
        v4u o; o.x = pk2(s[0 * 33], s[1 * 33]); o.y = pk2(s[2 * 33], s[3 * 33]); o.z = pk2(s[4 * 33], s[5 * 33]); o.w = pk2(s[6 * 33], s[7 * 33]);
        *(GAS v4u*)(WT + (size_t)(n0 + n) * K + k0 + 8 * c) = o; }
    asm volatile("s_waitcnt lgkmcnt(0)" ::: "memory");
}
__device__ __forceinline__ void norm_rows(const GAS float* x, GAS bf16* xn, int nrows, int gw, int ngw, int lane) {
    for (int m = gw; m < nrows; m += ngw) {
        const GAS f32x4* xr = (const GAS f32x4*)(x + (size_t)m * D) + lane;
        f32x4 v[4]; float s = 0.f;
#pragma unroll
        for (int j = 0; j < 4; ++j) { v[j] = xr[64 * j]; s += (v[j].x * v[j].x + v[j].y * v[j].y) + (v[j].z * v[j].z + v[j].w * v[j].w); }
        const float rstd = rsqrtf(wave_sum(s) * (1.f / D) + EPS);
        GAS unsigned long long* o8 = (GAS unsigned long long*)(xn + (size_t)m * D) + lane;
#pragma unroll
        for (int j = 0; j < 4; ++j) o8[64 * j] = (unsigned long long)pk2(v[j].x * rstd, v[j].y * rstd) | ((unsigned long long)pk2(v[j].z * rstd, v[j].w * rstd) << 32);
    }
}

typedef short bf16x8 __attribute__((ext_vector_type(8)));
typedef float f32x16 __attribute__((ext_vector_type(16)));
typedef __bf16 bf16x2_t __attribute__((ext_vector_type(2)));
typedef float f32x2_t __attribute__((ext_vector_type(2)));
typedef unsigned v2u __attribute__((ext_vector_type(2)));
__device__ __forceinline__ unsigned pkbf(float lo, float hi) { const f32x2_t v = {lo, hi}; const bf16x2_t b = __builtin_convertvector(v, bf16x2_t); return __builtin_bit_cast(unsigned, b); }
constexpr int ATT_KS = 0, ATT_KSTR = 144, ATT_VT = 384 * 144, ATT_VSTR = 776, ATT_BIAS = ATT_VT + 64 * 776;
__device__ __forceinline__ void attn_mfma(const GAS bf16* proj, GAS bf16* part, GAS float* lse, int TOKG, const GAS float* qgain, const GAS float* kgain, const GAS float* rel_bias,
                                          unsigned char* lds, int tid, int lane, int wave, int bid, int G) {
    LAS unsigned char* L = (LAS unsigned char*)lds;
    const int nunits = (TOKG / SEQ) * 16 * 96;
    const int c = lane & 31, hh = lane >> 5, c8 = tid & 7;
    float kg[8];
#pragma unroll
    for (int e = 0; e < 8; ++e) kg[e] = kgain[c8 * 8 + e];
    for (int u = bid; u < nunits; u += G) {
        const int i = u & 31, pbh = u >> 5, p = pbh % 3, bh = pbh / 3, h = bh & 15, bl = bh >> 4;
        const int dsh = 2 * p, d = 1 << dsh, r = i & (d - 1), qb = i >> dsh, m0 = qb * 256;
        const size_t rowb = (size_t)bl * SEQ;
        __syncthreads();
        if (tid < 192) { float tv = -INFINITY; const int dl = 160 - tid;
            if (dl >= 0 && dl <= 128) { const int dist = dl << dsh; int bk;
                if (dist < 16) bk = dist; else { const float scl = logf((float)dist / 16.f) / logf(128.f); const int lg = 16 + (int)(scl * 16.f); bk = lg < 31 ? lg : 31; }
                tv = rel_bias[bk * 16 + h] * 1.4426950408889634f; }
            ((LAS float*)(L + ATT_BIAS))[tid] = tv; }
#pragma unroll 1
        for (int it = 0; it < 6; ++it) {
            const int kk = (tid + 512 * it) >> 3, m = m0 - 128 + kk;
            v4u kw = {0u, 0u, 0u, 0u}, vw = {0u, 0u, 0u, 0u};
            if (m >= 0) { const GAS bf16* rp = proj + (rowb + ((size_t)m << dsh) + r) * PW + h * 64 + c8 * 8; kw = *(const GAS v4u*)(rp + 4096); vw = *(const GAS v4u*)(rp + 5120); }
            float f[8]; unpack8(kw, f); float ss = 0.f;
#pragma unroll
            for (int e = 0; e < 8; ++e) ss += f[e] * f[e];
            ss += __shfl_xor(ss, 1); ss += __shfl_xor(ss, 2); ss += __shfl_xor(ss, 4);
            const float rs = rsqrtf(ss * (1.f / 64.f) + EPS);
            v4u ko; ko.x = pkbf(f[0] * rs * kg[0], f[1] * rs * kg[1]); ko.y = pkbf(f[2] * rs * kg[2], f[3] * rs * kg[3]); ko.z = pkbf(f[4] * rs * kg[4], f[5] * rs * kg[5]); ko.w = pkbf(f[6] * rs * kg[6], f[7] * rs * kg[7]);
            *(LAS v4u*)(L + ATT_KS + kk * ATT_KSTR + c8 * 16) = ko;
            LAS unsigned short* vt = (LAS unsigned short*)(L + ATT_VT + (c8 * 8) * ATT_VSTR + kk * 2);
            vt[0 * (ATT_VSTR / 2)] = (unsigned short)(vw.x & 0xffffu); vt[1 * (ATT_VSTR / 2)] = (unsigned short)(vw.x >> 16);
            vt[2 * (ATT_VSTR / 2)] = (unsigned short)(vw.y & 0xffffu); vt[3 * (ATT_VSTR / 2)] = (unsigned short)(vw.y >> 16);
            vt[4 * (ATT_VSTR / 2)] = (unsigned short)(vw.z & 0xffffu); vt[5 * (ATT_VSTR / 2)] = (unsigned short)(vw.z >> 16);
            vt[6 * (ATT_VSTR / 2)] = (unsigned short)(vw.w & 0xffffu); vt[7 * (ATT_VSTR / 2)] = (unsigned short)(vw.w >> 16);
        }
        const size_t orow = rowb + ((size_t)(m0 + 32 * wave + c) << dsh) + r;
        bf16x8 qf[4];
        { const GAS bf16* qp = proj + orow * PW + 3072 + h * 64 + 8 * hh; float qv[4][8]; float ss = 0.f;
#pragma unroll
            for (int s = 0; s < 4; ++s) { unpack8(*(const GAS v4u*)(qp + 16 * s), qv[s]);
#pragma unroll
                for (int e = 0; e < 8; ++e) ss += qv[s][e] * qv[s][e]; }
            ss += __shfl_xor(ss, 32);
            const float rs = rsqrtf(ss * (1.f / 64.f) + EPS) * (0.125f * 1.4426950408889634f);
#pragma unroll
            for (int s = 0; s < 4; ++s) { const f32x4 g0 = *(const GAS f32x4*)(qgain + 16 * s + 8 * hh), g1 = *(const GAS f32x4*)(qgain + 16 * s + 8 * hh + 4);
                v4u w; w.x = pkbf(qv[s][0] * rs * g0.x, qv[s][1] * rs * g0.y); w.y = pkbf(qv[s][2] * rs * g0.z, qv[s][3] * rs * g0.w);
                w.z = pkbf(qv[s][4] * rs * g1.x, qv[s][5] * rs * g1.y); w.w = pkbf(qv[s][6] * rs * g1.z, qv[s][7] * rs * g1.w); qf[s] = __builtin_bit_cast(bf16x8, w); } }
        __syncthreads();
        f32x16 sc[5];
#pragma unroll
        for (int j = 0; j < 5; ++j) {
#pragma unroll
            for (int e = 0; e < 16; ++e) sc[j][e] = 0.f;
#pragma unroll
            for (int s = 0; s < 4; ++s) { const bf16x8 kf = *(const LAS bf16x8*)(L + ATT_KS + (32 * wave + 32 * j + c) * ATT_KSTR + (16 * s + 8 * hh) * 2);
                sc[j] = __builtin_amdgcn_mfma_f32_32x32x16_bf16(kf, qf[s], sc[j], 0, 0, 0); } }
        const LAS float* tb = (const LAS float*)(L + ATT_BIAS) + (32 + 4 * hh - c);
        float mx = -INFINITY;
#pragma unroll
        for (int j = 0; j < 5; ++j)
#pragma unroll
            for (int e = 0; e < 16; ++e) sc[j][e] += tb[32 * j + (e & 3) + 8 * (e >> 2)];
        if (m0 == 0 && wave < 4) {
#pragma unroll
            for (int j = 0; j < 5; ++j)
#pragma unroll
                for (int e = 0; e < 16; ++e) if (32 * wave + 4 * hh + 32 * j + (e & 3) + 8 * (e >> 2) < 128) sc[j][e] = -INFINITY; }
#pragma unroll
        for (int j = 0; j < 5; ++j)
#pragma unroll
            for (int e = 0; e < 16; ++e) mx = fmaxf(mx, sc[j][e]);
        mx = fmaxf(mx, __shfl_xor(mx, 32));
        float l = 0.f;
#pragma unroll
        for (int j = 0; j < 5; ++j)
#pragma unroll
            for (int e = 0; e < 16; ++e) { const float pe = __builtin_amdgcn_exp2f(sc[j][e] - mx); sc[j][e] = pe; l += pe; }
        l += __shfl_xor(l, 32);
        f32x16 o[2];
#pragma unroll
        for (int e = 0; e < 16; ++e) { o[0][e] = 0.f; o[1][e] = 0.f; }
#pragma unroll
        for (int j = 0; j < 5; ++j)
#pragma unroll
            for (int s2 = 0; s2 < 2; ++s2) {
                v4u pw; pw.x = pkbf(sc[j][8 * s2 + 0], sc[j][8 * s2 + 1]); pw.y = pkbf(sc[j][8 * s2 + 2], sc[j][8 * s2 + 3]); pw.z = pkbf(sc[j][8 * s2 + 4], sc[j][8 * s2 + 5]); pw.w = pkbf(sc[j][8 * s2 + 6], sc[j][8 * s2 + 7]);
                const bf16x8 pf = __builtin_bit_cast(bf16x8, pw);
                const int kb = 32 * wave + 32 * j + 16 * s2 + 4 * hh;
#pragma unroll
                for (int dt = 0; dt < 2; ++dt) { const LAS unsigned char* vp = L + ATT_VT + (32 * dt + c) * ATT_VSTR + kb * 2;
                    const v2u lo = *(const LAS v2u*)vp, hi = *(const LAS v2u*)(vp + 16);
                    v4u vw4; vw4.x = lo.x; vw4.y = lo.y; vw4.z = hi.x; vw4.w = hi.y;
                    o[dt] = __builtin_amdgcn_mfma_f32_32x32x16_bf16(__builtin_bit_cast(bf16x8, vw4), pf, o[dt], 0, 0, 0); } }
        const float inv = 1.f / l;
        GAS bf16* op = part + ((size_t)p * TOKG + orow) * 1024 + h * 64 + 4 * hh;
#pragma unroll
        for (int dt = 0; dt < 2; ++dt)
#pragma unroll
            for (int g4 = 0; g4 < 4; ++g4) { v2u w; w.x = pkbf(o[dt][4 * g4] * inv, o[dt][4 * g4 + 1] * inv); w.y = pkbf(o[dt][4 * g4 + 2] * inv, o[dt][4 * g4 + 3] * inv);
                *(GAS v2u*)(op + 32 * dt + 8 * g4) = w; }
        if (hh == 0) lse[((size_t)p * TOKG + orow) * 16 + h] = mx * 0.6931471805599453f + __logf(l);
    }
}
__device__ __forceinline__ void merge_conv(const GAS bf16* proj, const GAS bf16* part, const GAS float* lse, GAS bf16* y, int TOKG, const GAS float* convw, int lane, int gw, int ngw) {
    for (int it = gw; it < TOKG; it += ngw) {
        const int t = it & (SEQ - 1); const GAS bf16* prow = proj + (size_t)it * PW;
#pragma unroll
        for (int i = 0; i < 2; ++i) { const int c0 = lane * 8 + 512 * i;
            float acc[8] = {0.f, 0.f, 0.f, 0.f, 0.f, 0.f, 0.f, 0.f};
#pragma unroll
            for (int dt = 0; dt < 3; ++dt) { const int tt = t - 2 + dt;
                if (tt >= 0) { const GAS bf16* pr = prow - (size_t)(2 - dt) * PW; float gc[8], xa[8];
                    unpack8(*(const GAS v4u*)(pr + 1024 + c0), gc); unpack8(*(const GAS v4u*)(pr + 2048 + c0), xa);
#pragma unroll
                    for (int e = 0; e < 8; ++e) acc[e] += convw[dt * 1024 + c0 + e] * (gc[e] * xa[e]); } }
            float gb[8], z[8]; unpack8(*(const GAS v4u*)(prow + c0), gb); unpack8(*(const GAS v4u*)(prow + 6144 + c0), z);
            v4u o; o.x = pk2(gb[0] * acc[0] * z[0], gb[1] * acc[1] * z[1]); o.y = pk2(gb[2] * acc[2] * z[2], gb[3] * acc[3] * z[3]);
            o.z = pk2(gb[4] * acc[4] * z[4], gb[5] * acc[5] * z[5]); o.w = pk2(gb[6] * acc[6] * z[6], gb[7] * acc[7] * z[7]);
            *(GAS v4u*)(y + (size_t)it * MW + c0) = o; }
#pragma unroll
        for (int i = 0; i < 2; ++i) { const int c0 = lane * 8 + 512 * i, h = c0 >> 6;
            const float l0 = lse[((size_t)0 * TOKG + it) * 16 + h], l1 = lse[((size_t)1 * TOKG + it) * 16 + h], l2 = lse[((size_t)2 * TOKG + it) * 16 + h];
            const float mx = fmaxf(l0, fmaxf(l1, l2)); float w0 = __expf(l0 - mx), w1 = __expf(l1 - mx), w2 = __expf(l2 - mx); const float inv = 1.f / (w0 + w1 + w2); w0 *= inv; w1 *= inv; w2 *= inv;
            float a0[8], a1[8], a2[8], z[8];
            unpack8(*(const GAS v4u*)(part + ((size_t)0 * TOKG + it) * 1024 + c0), a0); unpack8(*(const GAS v4u*)(part + ((size_t)1 * TOKG + it) * 1024 + c0), a1); unpack8(*(const GAS v4u*)(part + ((size_t)2 * TOKG + it) * 1024 + c0), a2);
            unpack8(*(const GAS v4u*)(prow + 6144 + 1024 + c0), z);
            float r[8];
#pragma unroll
            for (int e = 0; e < 8; ++e) r[e] = (w0 * a0[e] + w1 * a1[e] + w2 * a2[e]) * z[e];
            v4u o; o.x = pk2(r[0], r[1]); o.y = pk2(r[2], r[3]); o.z = pk2(r[4], r[5]); o.w = pk2(r[6], r[7]);
            *(GAS v4u*)(y + (size_t)it * MW + 1024 + c0) = o; }
    }
}

typedef float f32x4h __attribute__((ext_vector_type(4)));
typedef float f32x2h __attribute__((ext_vector_type(2)));
#define MFMA16(a, b, c) __builtin_amdgcn_mfma_f32_16x16x32_bf16((a), (b), (c), 0, 0, 0)
constexpr float LOG2E = 1.4426950408889634f;
constexpr int HS = 144, HQS = 272, RUNC = 16;
constexpr int H1_KT = 0, H1_VT = 128 * HS, H1_SEG = 2 * 128 * HS, H1_DEC = H1_SEG + 4096;
constexpr int H3_QH = 0, H3_QM = 64 * HQS, H3_KM = 2 * 64 * HQS, H3_VT = 3 * 64 * HQS, H3_AM = H3_VT + 128 * HS, H3_SEG = H3_AM + 64 * HS, H3_RED = H3_SEG + 4096, H3_KT = H3_RED + 2048, H3_DEC = H3_KT + 128 * HS, H3_SL = H3_DEC + 512;
static_assert(H3_SL + 128 * HQS <= 150 * 1024, "HGRN LDS map");
__device__ __forceinline__ float lo16(unsigned w) { return __uint_as_float(w << 16); }
__device__ __forceinline__ float hi16(unsigned w) { return __uint_as_float(w & 0xffff0000u); }
__device__ __forceinline__ void hgrn_r1(const GAS bf16* proj, GAS float* RU, GAS float* RD, int TOKG, unsigned char* lds, int tid, int lane, int wave, int bid, int G) {
    LAS unsigned char* L = (LAS unsigned char*)lds;
    LAS float* segtot = (LAS float*)(L + H1_SEG); LAS float* decl = (LAS float*)(L + H1_DEC);
    const int nruns = (TOKG / SEQ) * 16 * (128 / RUNC);
    const int fr = lane & 15, fq = lane >> 4;
    unsigned rg[8], rv[8];
#define H1_LOAD(u_) do { const int cch_ = (u_) & 127, seq_ = (u_) >> 7; const GAS unsigned* pb_ = (const GAS unsigned*)(proj + ((size_t)(seq_ >> 4) * SEQ + cch_ * 64 + wave * 8) * PW + (seq_ & 15) * 128) + lane; \
        _Pragma("unroll") for (int i = 0; i < 8; ++i) { rg[i] = pb_[(size_t)i * (PW / 2) + 1024]; rv[i] = pb_[(size_t)i * (PW / 2) + 2048]; } } while (0)
    for (int run = bid; run < nruns; run += G) {
        const int u0 = run * RUNC;
        H1_LOAD(u0);
        f32x4h acc[8];
#pragma unroll
        for (int nk = 0; nk < 8; ++nk) acc[nk] = (f32x4h){0.f, 0.f, 0.f, 0.f};
        float sum0 = 0.f, sum1 = 0.f;
        for (int ci = 0; ci < RUNC; ++ci) {
            const int u = u0 + ci;
            float gc0[8], gc1[8], kv0[8], kv1[8]; float run0 = 0.f, run1 = 0.f; v4u vv0, vv1;
#pragma unroll
            for (int i = 0; i < 8; ++i) { const float g0 = lo16(rg[i]) * LOG2E, g1 = hi16(rg[i]) * LOG2E; run0 += g0; run1 += g1; gc0[i] = run0; gc1[i] = run1;
                kv0[i] = 1.f - __builtin_amdgcn_exp2f(g0); kv1[i] = 1.f - __builtin_amdgcn_exp2f(g1); }
            vv0.x = (rv[0] & 0xffffu) | (rv[1] << 16); vv0.y = (rv[2] & 0xffffu) | (rv[3] << 16); vv0.z = (rv[4] & 0xffffu) | (rv[5] << 16); vv0.w = (rv[6] & 0xffffu) | (rv[7] << 16);
            vv1.x = (rv[0] >> 16) | (rv[1] & 0xffff0000u); vv1.y = (rv[2] >> 16) | (rv[3] & 0xffff0000u); vv1.z = (rv[4] >> 16) | (rv[5] & 0xffff0000u); vv1.w = (rv[6] >> 16) | (rv[7] & 0xffff0000u);
            if (ci + 1 < RUNC) H1_LOAD(u + 1);
            __syncthreads();
            *(LAS f32x2h*)(segtot + wave * 128 + 2 * lane) = (f32x2h){run0, run1};
            *(LAS v4u*)(L + H1_VT + (2 * lane) * HS + wave * 16) = vv0; *(LAS v4u*)(L + H1_VT + (2 * lane + 1) * HS + wave * 16) = vv1;
            __syncthreads();
            float pre0 = 0.f, pre1 = 0.f, tot0 = 0.f, tot1 = 0.f;
#pragma unroll
            for (int s8 = 0; s8 < 8; ++s8) { const f32x2h t = *(const LAS f32x2h*)(segtot + s8 * 128 + 2 * lane); tot0 += t.x; tot1 += t.y; pre0 += (s8 < wave) ? t.x : 0.f; pre1 += (s8 < wave) ? t.y : 0.f; }
            { v4u a, b; const float e0 = tot0 - pre0, e1 = tot1 - pre1;
              a.x = pkbf(kv0[0] * __builtin_amdgcn_exp2f(e0 - gc0[0]), kv0[1] * __builtin_amdgcn_exp2f(e0 - gc0[1])); a.y = pkbf(kv0[2] * __builtin_amdgcn_exp2f(e0 - gc0[2]), kv0[3] * __builtin_amdgcn_exp2f(e0 - gc0[3]));
              a.z = pkbf(kv0[4] * __builtin_amdgcn_exp2f(e0 - gc0[4]), kv0[5] * __builtin_amdgcn_exp2f(e0 - gc0[5])); a.w = pkbf(kv0[6] * __builtin_amdgcn_exp2f(e0 - gc0[6]), kv0[7] * __builtin_amdgcn_exp2f(e0 - gc0[7]));
              b.x = pkbf(kv1[0] * __builtin_amdgcn_exp2f(e1 - gc1[0]), kv1[1] * __builtin_amdgcn_exp2f(e1 - gc1[1])); b.y = pkbf(kv1[2] * __builtin_amdgcn_exp2f(e1 - gc1[2]), kv1[3] * __builtin_amdgcn_exp2f(e1 - gc1[3]));
              b.z = pkbf(kv1[4] * __builtin_amdgcn_exp2f(e1 - gc1[4]), kv1[5] * __builtin_amdgcn_exp2f(e1 - gc1[5])); b.w = pkbf(kv1[6] * __builtin_amdgcn_exp2f(e1 - gc1[6]), kv1[7] * __builtin_amdgcn_exp2f(e1 - gc1[7]));
              *(LAS v4u*)(L + H1_KT + (2 * lane) * HS + wave * 16) = a; *(LAS v4u*)(L + H1_KT + (2 * lane + 1) * HS + wave * 16) = b; }
            sum0 += tot0; sum1 += tot1;
            if (wave == 0) *(LAS f32x2h*)(decl + 2 * lane) = (f32x2h){__builtin_amdgcn_exp2f(tot0), __builtin_amdgcn_exp2f(tot1)};
            __syncthreads();
            bf16x8 vf[2];
#pragma unroll
            for (int ks = 0; ks < 2; ++ks) vf[ks] = *(const LAS bf16x8*)(L + H1_VT + (16 * wave + fr) * HS + (32 * ks + 8 * fq) * 2);
#pragma unroll
            for (int nk = 0; nk < 8; ++nk) { const f32x4h dk = *(const LAS f32x4h*)(decl + 16 * nk + 4 * fq); acc[nk] = acc[nk] * dk;
#pragma unroll
                for (int ks = 0; ks < 2; ++ks) { const bf16x8 kf = *(const LAS bf16x8*)(L + H1_KT + (16 * nk + fr) * HS + (32 * ks + 8 * fq) * 2); acc[nk] = MFMA16(kf, vf[ks], acc[nk]); } }
        }
        GAS float* sp = RU + (size_t)run * 16384 + (16 * wave + fr) * 128 + 4 * fq;
#pragma unroll
        for (int nk = 0; nk < 8; ++nk) *(GAS f32x4h*)(sp + 16 * nk) = acc[nk];
        if (wave == 0) *(GAS f32x2h*)(RD + (size_t)run * 128 + 2 * lane) = (f32x2h){__builtin_amdgcn_exp2f(sum0), __builtin_amdgcn_exp2f(sum1)};
    }
#undef H1_LOAD
}
__device__ __forceinline__ void hgrn_r3(const GAS bf16* proj, const GAS float* RU, const GAS float* RD, GAS bf16* y, int TOKG, const GAS float* ogain, unsigned char* lds, int tid, int lane, int wave, int bid, int G) {
    LAS unsigned char* L = (LAS unsigned char*)lds;
    LAS float* segtot = (LAS float*)(L + H3_SEG); LAS float* red = (LAS float*)(L + H3_RED); LAS float* decl = (LAS float*)(L + H3_DEC);
    const int nruns = (TOKG / SEQ) * 16 * (128 / RUNC);
    const int fr = lane & 15, fq = lane >> 4;
    unsigned rq[8], rg[8], rv[8];
#define H3_LOAD(u_) do { const int cch_ = (u_) & 127, seq_ = (u_) >> 7; const GAS unsigned* pb_ = (const GAS unsigned*)(proj + ((size_t)(seq_ >> 4) * SEQ + cch_ * 64 + wave * 8) * PW + (seq_ & 15) * 128) + lane; \
        _Pragma("unroll") for (int i = 0; i < 8; ++i) { rq[i] = pb_[(size_t)i * (PW / 2)]; rg[i] = pb_[(size_t)i * (PW / 2) + 1024]; rv[i] = pb_[(size_t)i * (PW / 2) + 2048]; } } while (0)
    for (int run = bid; run < nruns; run += G) {
        const int u0 = run * RUNC, seq = run / (128 / RUNC), rr = run - seq * (128 / RUNC), h = seq & 15, bl = seq >> 4;
        H3_LOAD(u0);
        const int v0 = 16 * wave + 4 * fq;
        const f32x4 og = *(const GAS f32x4*)(ogain + h * 128 + v0);
        f32x4h Sm[8];
#pragma unroll
        for (int nk = 0; nk < 8; ++nk) Sm[nk] = (f32x4h){0.f, 0.f, 0.f, 0.f};
        for (int r2 = 0; r2 < rr; ++r2) { const int rn = run - rr + r2;
            const GAS float* up = RU + (size_t)rn * 16384 + (16 * wave + fr) * 128 + 4 * fq; const GAS float* dp = RD + (size_t)rn * 128 + 4 * fq;
#pragma unroll
            for (int nk = 0; nk < 8; ++nk) { const f32x4h uu = *(const GAS f32x4h*)(up + 16 * nk), dd = *(const GAS f32x4h*)(dp + 16 * nk); Sm[nk] = Sm[nk] * dd + uu; } }
        for (int ci = 0; ci < RUNC; ++ci) {
            const int u = u0 + ci, cch = u & 127;
            const size_t rowc = (size_t)bl * SEQ + cch * 64;
            v2u zw[4];
#pragma unroll
            for (int t2 = 0; t2 < 4; ++t2) zw[t2] = *(const GAS v2u*)(proj + (rowc + 16 * t2 + fr) * PW + 6144 + h * 128 + v0);
            bf16x8 sf[4];
            { LAS unsigned char* sl = L + H3_SL + (16 * wave + fr) * HQS;
#pragma unroll
              for (int nk = 0; nk < 8; ++nk) { v2u w; w.x = pkbf(Sm[nk][0], Sm[nk][1]); w.y = pkbf(Sm[nk][2], Sm[nk][3]); *(LAS v2u*)(sl + (16 * nk + 4 * fq) * 2) = w; }
#pragma unroll
              for (int ks = 0; ks < 4; ++ks) sf[ks] = *(const LAS bf16x8*)(sl + (32 * ks + 8 * fq) * 2); }
            float gc0[8], gc1[8], kv0[8], kv1[8], qv0[8], qv1[8]; float run0 = 0.f, run1 = 0.f; v4u vv0, vv1;
#pragma unroll
            for (int i = 0; i < 8; ++i) { const float g0 = lo16(rg[i]) * LOG2E, g1 = hi16(rg[i]) * LOG2E; run0 += g0; run1 += g1; gc0[i] = run0; gc1[i] = run1;
                kv0[i] = 1.f - __builtin_amdgcn_exp2f(g0); kv1[i] = 1.f - __builtin_amdgcn_exp2f(g1); qv0[i] = lo16(rq[i]); qv1[i] = hi16(rq[i]); }
            vv0.x = (rv[0] & 0xffffu) | (rv[1] << 16); vv0.y = (rv[2] & 0xffffu) | (rv[3] << 16); vv0.z = (rv[4] & 0xffffu) | (rv[5] << 16); vv0.w = (rv[6] & 0xffffu) | (rv[7] << 16);
            vv1.x = (rv[0] >> 16) | (rv[1] & 0xffff0000u); vv1.y = (rv[2] >> 16) | (rv[3] & 0xffff0000u); vv1.z = (rv[4] >> 16) | (rv[5] & 0xffff0000u); vv1.w = (rv[6] >> 16) | (rv[7] & 0xffff0000u);
            if (ci + 1 < RUNC) H3_LOAD(u + 1);
            *(LAS f32x2h*)(segtot + wave * 128 + 2 * lane) = (f32x2h){run0, run1};
            *(LAS v4u*)(L + H3_VT + (2 * lane) * HS + wave * 16) = vv0; *(LAS v4u*)(L + H3_VT + (2 * lane + 1) * HS + wave * 16) = vv1;
            __syncthreads();
            { float pre0 = 0.f, pre1 = 0.f, gr0 = 0.f, gr1 = 0.f, tot0 = 0.f, tot1 = 0.f;
#pragma unroll
              for (int s8 = 0; s8 < 8; ++s8) { const f32x2h t = *(const LAS f32x2h*)(segtot + s8 * 128 + 2 * lane); tot0 += t.x; tot1 += t.y; pre0 += (s8 < wave) ? t.x : 0.f; pre1 += (s8 < wave) ? t.y : 0.f; if (s8 < 4) { gr0 += t.x; gr1 += t.y; } }
              unsigned kw0[4], kw1[4];
#pragma unroll
              for (int i = 0; i < 8; ++i) { const float c0 = pre0 + gc0[i], c1 = pre1 + gc1[i]; const int s = wave * 8 + i;
                  *(LAS unsigned*)(L + H3_QH + s * HQS + lane * 4) = pkbf(qv0[i] * __builtin_amdgcn_exp2f(c0), qv1[i] * __builtin_amdgcn_exp2f(c1));
                  *(LAS unsigned*)(L + H3_QM + s * HQS + lane * 4) = pkbf(qv0[i] * __builtin_amdgcn_exp2f(fminf(c0 - gr0, 115.f)), qv1[i] * __builtin_amdgcn_exp2f(fminf(c1 - gr1, 115.f)));
                  *(LAS unsigned*)(L + H3_KM + s * HQS + lane * 4) = pkbf(kv0[i] * __builtin_amdgcn_exp2f(fminf(gr0 - c0, 115.f)), kv1[i] * __builtin_amdgcn_exp2f(fminf(gr1 - c1, 115.f)));
                  kv0[i] = kv0[i] * __builtin_amdgcn_exp2f(tot0 - c0); kv1[i] = kv1[i] * __builtin_amdgcn_exp2f(tot1 - c1); }
#pragma unroll
              for (int i = 0; i < 4; ++i) { kw0[i] = pkbf(kv0[2 * i], kv0[2 * i + 1]); kw1[i] = pkbf(kv1[2 * i], kv1[2 * i + 1]); }
              { v4u a, b; a.x = kw0[0]; a.y = kw0[1]; a.z = kw0[2]; a.w = kw0[3]; b.x = kw1[0]; b.y = kw1[1]; b.z = kw1[2]; b.w = kw1[3];
                *(LAS v4u*)(L + H3_KT + (2 * lane) * HS + wave * 16) = a; *(LAS v4u*)(L + H3_KT + (2 * lane + 1) * HS + wave * 16) = b; }
              if (wave == 0) *(LAS f32x2h*)(decl + 2 * lane) = (f32x2h){__builtin_amdgcn_exp2f(tot0), __builtin_amdgcn_exp2f(tot1)}; }
            __syncthreads();
            { const int tt = wave >> 1;
#pragma unroll
              for (int ss2 = 0; ss2 < 2; ++ss2) { const int ss = 2 * (wave & 1) + ss2; f32x4h a = {0.f, 0.f, 0.f, 0.f};
                  if (ss <= tt) {
#pragma unroll
                      for (int ks = 0; ks < 4; ++ks) { const bf16x8 kmf = *(const LAS bf16x8*)(L + H3_KM + (16 * ss + fr) * HQS + (32 * ks + 8 * fq) * 2);
                          const bf16x8 qmf = *(const LAS bf16x8*)(L + H3_QM + (16 * tt + fr) * HQS + (32 * ks + 8 * fq) * 2); a = MFMA16(kmf, qmf, a); } }
                  const int t = 16 * tt + fr, s0 = 16 * ss + 4 * fq;
                  v2u w; w.x = pkbf(s0 <= t ? a[0] : 0.f, s0 + 1 <= t ? a[1] : 0.f); w.y = pkbf(s0 + 2 <= t ? a[2] : 0.f, s0 + 3 <= t ? a[3] : 0.f);
                  *(LAS v2u*)(L + H3_AM + t * HS + s0 * 2) = w; } }
            f32x4h acc[4];
#pragma unroll
            for (int t2 = 0; t2 < 4; ++t2) acc[t2] = (f32x4h){0.f, 0.f, 0.f, 0.f};
#pragma unroll
            for (int t2 = 0; t2 < 4; ++t2)
#pragma unroll
                for (int ks = 0; ks < 4; ++ks) { const bf16x8 qf = *(const LAS bf16x8*)(L + H3_QH + (16 * t2 + fr) * HQS + (32 * ks + 8 * fq) * 2); acc[t2] = MFMA16(sf[ks], qf, acc[t2]); }
            bf16x8 vf[2];
#pragma unroll
            for (int ks = 0; ks < 2; ++ks) vf[ks] = *(const LAS bf16x8*)(L + H3_VT + (16 * wave + fr) * HS + (32 * ks + 8 * fq) * 2);
#pragma unroll
            for (int nk = 0; nk < 8; ++nk) { const f32x4h dk = *(const LAS f32x4h*)(decl + 16 * nk + 4 * fq); Sm[nk] = Sm[nk] * dk;
#pragma unroll
                for (int ks = 0; ks < 2; ++ks) { const bf16x8 kf = *(const LAS bf16x8*)(L + H3_KT + (16 * nk + fr) * HS + (32 * ks + 8 * fq) * 2); Sm[nk] = MFMA16(kf, vf[ks], Sm[nk]); } }
            __syncthreads();
#pragma unroll
            for (int t2 = 0; t2 < 4; ++t2)
#pragma unroll
                for (int ks = 0; ks < 2; ++ks) { const bf16x8 af = *(const LAS bf16x8*)(L + H3_AM + (16 * t2 + fr) * HS + (32 * ks + 8 * fq) * 2); acc[t2] = MFMA16(vf[ks], af, acc[t2]); }
#pragma unroll
            for (int t2 = 0; t2 < 4; ++t2) { float ss = acc[t2][0] * acc[t2][0] + acc[t2][1] * acc[t2][1] + acc[t2][2] * acc[t2][2] + acc[t2][3] * acc[t2][3];
                ss += __shfl_xor(ss, 16); ss += __shfl_xor(ss, 32); if (fq == 0) red[wave * 64 + 16 * t2 + fr] = ss; }
            __syncthreads();
#pragma unroll
            for (int t2 = 0; t2 < 4; ++t2) { const int t = 16 * t2 + fr; float tot = 0.f;
#pragma unroll
                for (int w8 = 0; w8 < 8; ++w8) tot += red[w8 * 64 + t];
                const float rstd = rsqrtf(tot * (1.f / 128.f) + EPS);
                v2u w; w.x = pkbf(acc[t2][0] * rstd * og.x * lo16(zw[t2].x), acc[t2][1] * rstd * og.y * hi16(zw[t2].x));
                w.y = pkbf(acc[t2][2] * rstd * og.z * lo16(zw[t2].y), acc[t2][3] * rstd * og.w * hi16(zw[t2].y));
                *(GAS v2u*)(y + (rowc + t) * MW + h * 128 + v0) = w; }
        }
    }
#undef H3_LOAD
}

#define XB_TMO      128
#define XB_XCNT(j)  (256  + 64 * (j))
#define XB_XSUB(j)  (1280 + 64 * (j))
#define XB_XGEN(j)  (2304 + 64 * (j))
#define XB_TOP      3328
#define XB_TOPGEN   3392
#define XCD_BAR_WORDS 3456
#define XB_SPIN_CAP (1u << 18)

__device__ __forceinline__ unsigned xb_ld(unsigned* p)              { return __hip_atomic_load(p, __ATOMIC_RELAXED, __HIP_MEMORY_SCOPE_AGENT); }
__device__ __forceinline__ unsigned xb_add(unsigned* p, unsigned v) { return __hip_atomic_fetch_add(p, v, __ATOMIC_RELAXED, __HIP_MEMORY_SCOPE_AGENT); }
__device__ __forceinline__ unsigned xb_xcc_id() { return (unsigned)__builtin_amdgcn_s_getreg((3 << 11) | 20) & 0xFu; }
#define XB_SPIN(cond, bar) do { unsigned _sp = 0; while (cond) { __builtin_amdgcn_s_sleep(1); \
    if ((++_sp & 255u) == 0u) { if (xb_ld(&(bar)[XB_TMO])) break; if (_sp > XB_SPIN_CAP) { atomicAdd(&(bar)[XB_TMO], 1u); break; } } } } while (0)

struct XcdBarrier {
    unsigned* bar; unsigned x;
    volatile LAS unsigned* st;
};

__device__ __forceinline__ XcdBarrier xcd_barrier_post(unsigned* bar, volatile LAS unsigned* st) {
    XcdBarrier b; b.bar = bar; b.x = xb_xcc_id(); b.st = st;
    if (threadIdx.x == 0) (void)xb_add(&bar[XB_XCNT(b.x)], 1u);
    return b;
}
__device__ __forceinline__ void xcd_barrier_complete(unsigned* bar, unsigned x, unsigned& nloc, unsigned& nx) {
    const unsigned G = gridDim.x * gridDim.y * gridDim.z;
    unsigned sum, cnt, mine, sp = 0u;
    for (;;) {
        sum = 0u; cnt = 0u; mine = 0u;
#pragma unroll
        for (unsigned j = 0; j < 16; ++j) { const unsigned c = xb_ld(&bar[XB_XCNT(j)]); sum += c; cnt += (c > 0u) ? 1u : 0u; mine = (j == x) ? c : mine; }
        if (sum == G) break;
        __builtin_amdgcn_s_sleep(1);
        if ((++sp & 255u) == 0u) { if (xb_ld(&bar[XB_TMO])) break; if (sp > XB_SPIN_CAP) { atomicAdd(&bar[XB_TMO], 1u); break; } }
    }
    nloc = mine > 0u ? mine : 1u; nx = cnt > 0u ? cnt : 1u;
}

__device__ __forceinline__ void xcd_barrier(const XcdBarrier& b) {
    asm volatile("s_waitcnt vmcnt(0)" ::: "memory");
    __syncthreads();
    if (threadIdx.x == 0) {
        unsigned* bar = b.bar;
        __builtin_amdgcn_s_waitcnt(0);
        unsigned nloc = b.st[0], nx = b.st[1];
        if (nloc == 0u) { xcd_barrier_complete(bar, b.x, nloc, nx); b.st[0] = nloc; b.st[1] = nx; }
        const unsigned old = xb_add(&bar[XB_XSUB(b.x)], 1u);
        const unsigned gen = old / nloc;
        if (old + 1u == (gen + 1u) * nloc) {
            __builtin_amdgcn_fence(__ATOMIC_RELEASE, "agent");
            asm volatile("s_waitcnt vmcnt(0)" ::: "memory");
            const unsigned og = xb_add(&bar[XB_TOP], 1u);
            const unsigned tg = og / nx;
            if (og + 1u == (tg + 1u) * nx) xb_add(&bar[XB_TOPGEN], 1u);
            else XB_SPIN(xb_ld(&bar[XB_TOPGEN]) == tg, bar);
            __builtin_amdgcn_fence(__ATOMIC_ACQUIRE, "agent");
            xb_add(&bar[XB_XGEN(b.x)], 1u);
            asm volatile("s_waitcnt vmcnt(0)" ::: "memory");
        } else {
            XB_SPIN(xb_ld(&bar[XB_XGEN(b.x)]) == gen, bar);
            __builtin_amdgcn_fence(__ATOMIC_ACQUIRE, "agent");
            asm volatile("s_waitcnt vmcnt(0)" ::: "memory");
        }
    }
    __syncthreads();
}

__device__ __forceinline__ unsigned long long ldptr(LAS unsigned long long* tab, int i) { asm volatile("" ::: "memory"); const unsigned long long v = tab[i];
    const unsigned lo = __builtin_amdgcn_readfirstlane((unsigned)v), hi = __builtin_amdgcn_readfirstlane((unsigned)(v >> 32)); return ((unsigned long long)hi << 32) | lo; }
struct Args { const float* in[13]; float* out; unsigned char* ws; int ngroups; int pad; };
struct Ctx { int layer, g, NG, TOKG, j, even, tid, lane, wave, G, bid, gw, ngw; GAS unsigned char* wsb; GAS bf16 *Wt_in, *Wt_out, *proj, *ybuf, *xn; GAS float* lbtab; size_t row0; };
__device__ __forceinline__ Ctx load_ctx(LAS unsigned long long* ptab) {
    Ctx c; const int step = (int)ldptr(ptab, 16); c.NG = (int)ldptr(ptab, 15); c.layer = step / c.NG; c.g = step - c.layer * c.NG; c.TOKG = NTOK / c.NG; c.j = c.layer >> 1; c.even = !(c.layer & 1);
    int tid_raw = threadIdx.x; asm volatile("" : "+v"(tid_raw)); c.tid = tid_raw; c.lane = c.tid & 63; c.wave = __builtin_amdgcn_readfirstlane(c.tid >> 6);
    c.G = gridDim.x; c.bid = blockIdx.x; c.gw = c.bid * 8 + c.wave; c.ngw = c.G * 8;
    c.wsb = (GAS unsigned char*)ldptr(ptab, 14);
    c.Wt_in = (GAS bf16*)(c.wsb + WS_WIN); c.Wt_out = (GAS bf16*)(c.wsb + WS_WOUT); c.lbtab = (GAS float*)(c.wsb + WS_MISC); c.proj = (GAS bf16*)(c.wsb + WS_PROJ);
    c.ybuf = (GAS bf16*)(c.wsb + WS_PROJ + (size_t)c.TOKG * (PW * 2)); c.xn = (GAS bf16*)(c.wsb + WS_PROJ + (size_t)c.TOKG * (PW * 2 + MW * 2));
    c.row0 = (size_t)c.g * c.TOKG; return c;
}
#define ARGP(i) ((const GAS float*)ldptr(ptab, (i)))
__global__ void __launch_bounds__(512, 2) fwd(Args a) {
    extern __shared__ __attribute__((aligned(16))) unsigned char lds[];
    cg::grid_group grid = cg::this_grid();
    LAS unsigned long long* ptab = (LAS unsigned long long*)((LAS unsigned char*)lds + PTAB_OFF);
    if (threadIdx.x == 0) {
#pragma unroll
        for (int i = 0; i < 13; ++i) ptab[i] = (unsigned long long)a.in[i];
        ptab[13] = (unsigned long long)a.out; ptab[14] = (unsigned long long)a.ws; ptab[15] = (unsigned long long)a.ngroups; ptab[16] = 0ull;
        ((LAS unsigned*)(ptab + 24))[0] = 0u; ((LAS unsigned*)(ptab + 24))[1] = 0u; }
    __syncthreads();
    (void)xcd_barrier_post((unsigned*)(ldptr(ptab, 14) + WS_BAR), (volatile LAS unsigned*)(ptab + 24));
#define GSYNC() do { XcdBarrier b_; b_.bar = (unsigned*)(ldptr(ptab, 14) + WS_BAR); b_.x = xb_xcc_id(); b_.st = (volatile LAS unsigned*)(ptab + 24); xcd_barrier(b_); } while (0)
    for (;;) {
        {
            const Ctx c = load_ctx(ptab);
            if (c.g == 0) {
                const GAS float* w_in = (c.even ? ARGP(2) : ARGP(9)) + (size_t)c.j * D * PW;
                const GAS float* ln = (c.even ? ARGP(1) : ARGP(8)) + (size_t)c.j * D;
                const GAS float* w_out = (c.even ? ARGP(6) : ARGP(12)) + (size_t)c.j * MW * D;
                LAS float* scr = (LAS float*)((LAS unsigned char*)lds + c.wave * 16384);
                constexpr int I_IN = (D / 64) * (PW / 32), I_OUT = (MW / 64) * (D / 32);
                for (int it = c.gw; it < I_IN + I_OUT; it += c.ngw) {
                    if (it < I_IN) transpose_item(w_in, D, PW, ln, c.Wt_in, scr, it, c.lane);
                    else transpose_item(w_out, MW, D, nullptr, c.Wt_out, scr, it - I_IN, c.lane);
                }
                if (!c.even && c.bid == 0) { const GAS float* lbp = ARGP(10);
                    for (int col = c.tid; col < 2048; col += 512) c.lbtab[col] = (c.j == 0) ? 0.f : 1.f / (1.f + expf(lbp[col] - lbp[2048 + col])); }
            }
            const GAS float* xsrc = (c.layer == 0) ? ARGP(0) : ARGP(13);
            norm_rows(xsrc + c.row0 * D, c.xn, c.TOKG, c.gw, c.ngw, c.lane);
        }
        if ((int)ldptr(ptab, 16) == 0) grid.sync(); else GSYNC();
        {
            const Ctx c = load_ctx(ptab);
            pg8::Gemm gm{(const pg8::bf16_t*)c.xn, (const pg8::bf16_t*)c.Wt_in, c.TOKG, PW, D}; pg8::StaticOrder S; S.init(c.TOKG, PW, c.G, c.bid); EpiProj E{c.proj, c.even ? 0 : 1, c.lbtab};
            pg8::gemm_phase<EpiProj, pg8::StaticOrder, true, true>((PG8_LAS unsigned char*)lds, gm, S, E);
        }
        GSYNC();
        {
            const Ctx c = load_ctx(ptab);
            if (c.even) {
                attn_mfma(c.proj, c.xn, (GAS float*)(c.xn + (size_t)c.TOKG * 3072), c.TOKG, ARGP(4) + c.j * 64, ARGP(5) + c.j * 64, ARGP(7), lds, c.tid, c.lane, c.wave, c.bid, c.G);
            } else {
                hgrn_r1(c.proj, (GAS float*)c.xn, (GAS float*)(c.wsb + WS_MISC + MiB), c.TOKG, lds, c.tid, c.lane, c.wave, c.bid, c.G);
            }
        }
        GSYNC();
        {
            const Ctx c = load_ctx(ptab);
            if (c.even) merge_conv(c.proj, c.xn, (const GAS float*)(c.xn + (size_t)c.TOKG * 3072), c.ybuf, c.TOKG, ARGP(3) + c.j * 3 * 1024, c.lane, c.gw, c.ngw);
            else hgrn_r3(c.proj, (const GAS float*)c.xn, (const GAS float*)(c.wsb + WS_MISC + MiB), c.ybuf, c.TOKG, ARGP(11) + c.j * MW, lds, c.tid, c.lane, c.wave, c.bid, c.G);
        }
        GSYNC();
        {
            const Ctx c = load_ctx(ptab);
            const GAS float* xsrc = (c.layer == 0) ? ARGP(0) : ARGP(13);
            pg8::Gemm gm{(const pg8::bf16_t*)c.ybuf, (const pg8::bf16_t*)c.Wt_out, c.TOKG, D, MW}; pg8::StaticOrder S; S.init(c.TOKG, D, c.G, c.bid); EpiRes E{xsrc + c.row0 * D, (GAS float*)ARGP(13) + c.row0 * D};
            pg8::gemm_phase<EpiRes, pg8::StaticOrder, true, true>((PG8_LAS unsigned char*)lds, gm, S, E);
        }
        GSYNC();
        const int step = (int)ldptr(ptab, 16), nsteps = 4 * (int)ldptr(ptab, 15);
        __syncthreads();
        if (threadIdx.x == 0) ptab[16] = (unsigned long long)(step + 1);
        __syncthreads();
        if (step + 1 >= nsteps) break;
    }
}

extern "C" void kernel_launch(void* const* d_in, const int* in_sizes, int n_in, void* d_out, int out_size, void* d_ws, size_t ws_size, hipStream_t stream) {
    static int grid = 0;
    if (grid == 0) {
        int dev = 0, cus = 0, per_cu = 0;
        if (hipGetDevice(&dev) != hipSuccess || hipDeviceGetAttribute(&cus, hipDeviceAttributeMultiprocessorCount, dev) != hipSuccess) { fprintf(stderr, "kernel_launch: device query failed\n"); grid = -1; return; }
        if (hipFuncSetAttribute((const void*)fwd, hipFuncAttributeMaxDynamicSharedMemorySize, LDS_BYTES) != hipSuccess) { fprintf(stderr, "kernel_launch: hipFuncSetAttribute failed\n"); grid = -1; return; }
        if (hipOccupancyMaxActiveBlocksPerMultiprocessor(&per_cu, (const void*)fwd, 512, LDS_BYTES) != hipSuccess || per_cu < 1) fprintf(stderr, "kernel_launch: occupancy query reports %d\n", per_cu);
        (void)hipGetLastError();
        grid = cus;
    }
    if (grid < 0) return;
    Args a{};
    for (int i = 0; i < 13; ++i) a.in[i] = (const float*)d_in[i];
    a.out = (float*)d_out; a.ws = (unsigned char*)d_ws;
    a.ngroups = (ws_size >= (size_t)472 * MiB) ? 2 : 4;
    if (hipMemsetAsync((char*)d_ws + WS_BAR, 0, 16384, stream) != hipSuccess) { fprintf(stderr, "kernel_launch: memset failed\n"); return; }
    void* args[] = {&a};
    hipError_t e = hipLaunchCooperativeKernel((const void*)fwd, dim3(grid), dim3(512), args, LDS_BYTES, stream);
    if (e != hipSuccess) fprintf(stderr, "kernel_launch: cooperative launch failed: %s (grid %d)\n", hipGetErrorString(e), grid);
}
```

```cpp
#include <hip/hip_runtime.h>
#include <hip/hip_cooperative_groups.h>
#include <cstdio>
#include <cstdint>
namespace cg = cooperative_groups;
namespace pg8 {
#define PG8_LAS __attribute__((address_space(3)))
typedef unsigned short bf16_t;
typedef short bf16x8 __attribute__((ext_vector_type(8)));
typedef float f32x4 __attribute__((ext_vector_type(4)));
typedef unsigned u32x4 __attribute__((ext_vector_type(4)));
constexpr int BM = 256, BK = 64, HALF = 128, HTB = HALF * BK * 2  , STAGE_BYTES = 8 * HTB, NXCD = 8, WGM = 8;

__host__ __device__ __forceinline__ int lds_byte(int r, int c) { const int st = (r >> 4) * 2 + (c >> 5), rr = r & 15, cc = c & 31, ob = rr * 64 + cc * 2; return st * 1024 + (ob ^ (((ob >> 9) & 1) << 5)); }
__host__ __device__ __forceinline__ void stage_rc(int b, int& R, int& C) { const int st = b / 1024, sb = b % 1024, swz = sb ^ (((sb >> 9) & 1) << 5); R = (st >> 1) * 16 + swz / 64; C = (st & 1) * 32 + (swz % 64) / 2; }
__host__ __device__ __forceinline__ int perm32(int rho) { const int n = rho >> 4, i = rho & 15; return 8 * (i >> 2) + 4 * n + (i & 3); }

struct Unit { int pm, pn; };
struct Gemm { const bf16_t* A; const bf16_t* Bt; int M, N, K; };

struct StaticOrder {
    int nM, nN, nwg, G, c;
    __host__ __device__ void init(int M, int N, int G_, int c_) { nM = M / BM; nN = N / BM; nwg = nM * nN; G = G_; c = c_; }
    __host__ __device__ bool next(int i, Unit& u) const {
        const long L = (long)i * G + c; if (L >= nwg) return false;
        int wgid = (int)L; { const int q = nwg / NXCD, r = nwg % NXCD, xcd = wgid % NXCD, off = wgid / NXCD; wgid = (xcd < r ? xcd * (q + 1) : r * (q + 1) + (xcd - r) * q) + off; }
        const int nig = WGM * nN, gid = wgid / nig, fm = gid * WGM, gsz = (nM - fm) < WGM ? (nM - fm) : WGM;
        u.pm = fm + ((wgid % nig) % gsz); u.pn = (wgid % nig) / gsz; return true;
    }
    __device__ __forceinline__ void a_ready(const Unit&) const {}
    __device__ __forceinline__ void done(const Unit&) const {}
};

__device__ __forceinline__ unsigned cvt_pk_bf16(float lo, float hi) { unsigned r; asm volatile("v_cvt_pk_bf16_f32 %0, %1, %2" : "=v"(r) : "v"(lo), "v"(hi)); return r; }
template <class Epi, class Sched, bool ALIGN_EPI = false, bool SP2 = false>
__device__ __forceinline__ void gemm_phase(PG8_LAS unsigned char* lds, const Gemm g, const Sched& S, const Epi& E) {
    int tid_raw = threadIdx.x; asm volatile("" : "+v"(tid_raw)); const int tid = tid_raw, wid = __builtin_amdgcn_readfirstlane(tid >> 6), lane = tid & 63, wr = wid >> 2, wc = wid & 3, fr = lane & 15, fq = lane >> 4;
    const int K = g.K, nt = K / BK;
    unsigned voffA[2], voffB[2];
#pragma unroll
    for (int i = 0; i < 2; ++i) { int R, C; stage_rc(tid * 16 + i * 8192, R, C); const int Rb = Epi::PERM ? ((R & ~31) + perm32(R & 31)) : R;
        voffA[i] = (unsigned)(R * K + C) * 2u; voffB[i] = (unsigned)(Rb * K + C) * 2u; }
    const size_t kstep = (size_t)(BK * 2);
    const size_t hstep = (size_t)HALF * K * 2;
    const size_t tstep = 2 * hstep;
    const unsigned ldsw = (unsigned)wid * 1024u;
    const int aoff = lds_byte(wr * 64 + fr, fq * 8), boff = lds_byte(wc * 32 + fr, fq * 8);
#define PG8_SA(b, h) (((b) * 2 + (h)) * HTB)
#define PG8_SB(b, h) ((4 + (b) * 2 + (h)) * HTB)
#define PG8_STAGE(bufoff, gbase, voff) do { _Pragma("unroll") for (int _i = 0; _i < 2; ++_i) \
        __builtin_amdgcn_global_load_lds((const unsigned*)((const char*)(gbase) + (voff)[_i]), (PG8_LAS unsigned*)(lds + (bufoff) + ldsw + _i * 8192), 16, 0, 0); } while (0)
#define PG8_LDA(dst, b, h) do { _Pragma("unroll") for (int m = 0; m < 4; ++m) _Pragma("unroll") for (int k = 0; k < 2; ++k) dst[m][k] = *(const PG8_LAS bf16x8*)(lds + PG8_SA(b, h) + aoff + m * 2048 + k * 1024); } while (0)
#define PG8_LDB(dst, b, h) do { _Pragma("unroll") for (int n = 0; n < 2; ++n) _Pragma("unroll") for (int k = 0; k < 2; ++k) dst[n][k] = *(const PG8_LAS bf16x8*)(lds + PG8_SB(b, h) + boff + n * 2048 + k * 1024); } while (0)
#define PG8_MMA(ai, bj, At, Bt) do { __builtin_amdgcn_s_setprio(1); _Pragma("unroll") for (int m = 0; m < 4; ++m) _Pragma("unroll") for (int n = 0; n < 2; ++n) _Pragma("unroll") for (int k = 0; k < 2; ++k) \
        acc[ai][bj][m][n] = __builtin_amdgcn_mfma_f32_16x16x32_bf16(Bt[n][k], At[m][k], acc[ai][bj][m][n], 0, 0, 0); __builtin_amdgcn_s_setprio(0); } while (0)
#define PG8_WAIT_V(n) asm volatile("s_waitcnt vmcnt(" #n ")" ::: "memory")
#define PG8_WAIT_L(n) asm volatile("s_waitcnt lgkmcnt(" #n ")" ::: "memory")
#define PG8_WAIT_VR(rx) do { static_assert(Epi::NVM == 0 || Epi::NVM == 16, "relaxed wait is written for 16 epilogue stores"); const int rx_ = __builtin_amdgcn_readfirstlane(rx); asm volatile("s_cmp_lg_u32 %0, 0\n\ts_cbranch_scc1 .Lrelax%=\n\ts_waitcnt vmcnt(8)\n.Lrelax%=:\n\ts_waitcnt vmcnt(24)" :: "s"(rx_) : "scc", "memory"); } while (0)
#define PG8_BAR __builtin_amdgcn_s_barrier()
#define PG8_SCHED __builtin_amdgcn_sched_barrier(0)
    Unit cur, nxt; int ui = 0;
    if (!S.next(0, cur)) return;
    f32x4 acc[2][2][4][2];
#pragma unroll
    for (int a = 0; a < 2; ++a)
#pragma unroll
        for (int b = 0; b < 2; ++b)
#pragma unroll
            for (int m = 0; m < 4; ++m)
#pragma unroll
                for (int n = 0; n < 2; ++n) acc[a][b][m][n] = (f32x4){0.f, 0.f, 0.f, 0.f};
    bf16x8 At[4][2], B0[2][2], B1[2][2];
    const char* cA = (const char*)g.A + (size_t)cur.pm * tstep; const char* cB = (const char*)g.Bt + (size_t)cur.pn * tstep;
    S.a_ready(cur);
    if constexpr (SP2) {
        PG8_STAGE(PG8_SB(0, 0), cB, voffB); PG8_STAGE(PG8_SB(0, 1), cB + hstep, voffB); PG8_STAGE(PG8_SA(0, 0), cA, voffA); PG8_STAGE(PG8_SA(0, 1), cA + hstep, voffA);
        if (wr == 1) PG8_BAR;
        PG8_WAIT_V(2); PG8_BAR;
        PG8_STAGE(PG8_SB(1, 0), cB + kstep, voffB); PG8_STAGE(PG8_SA(1, 0), cA + kstep, voffA); PG8_STAGE(PG8_SB(1, 1), cB + hstep + kstep, voffB);
        PG8_WAIT_V(6); PG8_BAR;
    } else {
        PG8_STAGE(PG8_SB(0, 0), cB, voffB); PG8_STAGE(PG8_SA(0, 0), cA, voffA); PG8_STAGE(PG8_SB(0, 1), cB + hstep, voffB); PG8_STAGE(PG8_SA(0, 1), cA + hstep, voffA);
        if (wr == 1) PG8_BAR;
        PG8_WAIT_V(4); PG8_BAR;
        PG8_STAGE(PG8_SB(1, 0), cB + kstep, voffB); PG8_STAGE(PG8_SA(1, 0), cA + kstep, voffA); PG8_STAGE(PG8_SB(1, 1), cB + hstep + kstep, voffB);
        PG8_WAIT_V(6); PG8_BAR;
    }
    for (;;) {
        const bool has_next = S.next(ui + 1, nxt);
        const char* nA = has_next ? (const char*)g.A + (size_t)nxt.pm * tstep : cA; const char* nB = has_next ? (const char*)g.Bt + (size_t)nxt.pn * tstep : cB;
        for (int t = 0; t < nt; t += 2) {
            const bool last = (t == nt - 2);
            const char* a1 = cA + (size_t)(t + 1) * kstep;
            const char* a2 = last ? nA : cA + (size_t)(t + 2) * kstep; const char* b2 = last ? nB : cB + (size_t)(t + 2) * kstep;
            const char* a3 = a2 + kstep; const char* b3 = b2 + kstep;
            if (last && has_next) S.a_ready(nxt);
            if constexpr (SP2) {
            PG8_LDB(B0, 0, 0); PG8_LDB(B1, 0, 1); PG8_SCHED; PG8_LDA(At, 0, 0); PG8_STAGE(PG8_SA(1, 1), a1 + hstep, voffA);
            PG8_WAIT_VR((Epi::NVM > 0 && ui > 0 && t == 0) ? 1 : 0);
            PG8_WAIT_L(0); PG8_BAR; PG8_MMA(0, 0, At, B0); PG8_MMA(0, 1, At, B1); PG8_BAR; PG8_SCHED;
            PG8_LDA(At, 0, 1); PG8_STAGE(PG8_SB(0, 0), b2, voffB); PG8_STAGE(PG8_SB(0, 1), b2 + hstep, voffB); PG8_STAGE(PG8_SA(0, 0), a2, voffA);
            PG8_WAIT_VR((Epi::NVM > 0 && ui > 0 && t == 0) ? 1 : 0);
            PG8_WAIT_L(0); PG8_BAR; PG8_MMA(1, 0, At, B0); PG8_MMA(1, 1, At, B1); PG8_BAR; PG8_SCHED;
            PG8_LDB(B0, 1, 0); PG8_LDB(B1, 1, 1); PG8_SCHED; PG8_LDA(At, 1, 0); PG8_STAGE(PG8_SA(0, 1), a2 + hstep, voffA);
            PG8_WAIT_V(8); PG8_WAIT_L(0); PG8_BAR; PG8_MMA(0, 0, At, B0); PG8_MMA(0, 1, At, B1); PG8_BAR; PG8_SCHED;
            PG8_LDA(At, 1, 1); PG8_STAGE(PG8_SB(1, 0), b3, voffB); PG8_STAGE(PG8_SB(1, 1), b3 + hstep, voffB); PG8_STAGE(PG8_SA(1, 0), a3, voffA);
            PG8_WAIT_V(8); PG8_WAIT_L(0); PG8_BAR; PG8_MMA(1, 0, At, B0); PG8_MMA(1, 1, At, B1); PG8_BAR; PG8_SCHED;
            } else {
            PG8_LDB(B0, 0, 0); PG8_SCHED; PG8_LDA(At, 0, 0); PG8_STAGE(PG8_SA(1, 1), a1 + hstep, voffA);
            PG8_WAIT_L(8); PG8_BAR; PG8_WAIT_L(0); PG8_MMA(0, 0, At, B0); PG8_BAR; PG8_SCHED;
            PG8_LDB(B1, 0, 1); PG8_STAGE(PG8_SB(0, 0), b2, voffB);
            PG8_BAR; PG8_WAIT_L(0); PG8_MMA(0, 1, At, B1); PG8_BAR;
            PG8_LDA(At, 0, 1); PG8_STAGE(PG8_SA(0, 0), a2, voffA);
            PG8_BAR; PG8_WAIT_L(0); PG8_MMA(1, 0, At, B0); PG8_BAR; PG8_SCHED;
            PG8_STAGE(PG8_SB(0, 1), b2 + hstep, voffB);
            PG8_WAIT_V(6); PG8_BAR; PG8_MMA(1, 1, At, B1); PG8_BAR;
            PG8_LDB(B0, 1, 0); PG8_SCHED; PG8_LDA(At, 1, 0); PG8_STAGE(PG8_SA(0, 1), a2 + hstep, voffA);
            PG8_WAIT_L(8); PG8_BAR; PG8_WAIT_L(0); PG8_MMA(0, 0, At, B0); PG8_BAR; PG8_SCHED;
            PG8_LDB(B1, 1, 1); PG8_STAGE(PG8_SB(1, 0), b3, voffB);
            PG8_BAR; PG8_WAIT_L(0); PG8_MMA(0, 1, At, B1); PG8_BAR;
            PG8_LDA(At, 1, 1); PG8_STAGE(PG8_SA(1, 0), a3, voffA);
            PG8_BAR; PG8_WAIT_L(0); PG8_MMA(1, 0, At, B0); PG8_BAR; PG8_SCHED;
            PG8_STAGE(PG8_SB(1, 1), b3 + hstep, voffB);
            PG8_WAIT_V(6); PG8_BAR; PG8_MMA(1, 1, At, B1); PG8_BAR;
            }
        }
        if constexpr (ALIGN_EPI) { if (wr == 0) PG8_BAR; }
        if constexpr (!Epi::AFTER_DRAIN) { E(acc, cur, wr, wc, fr, fq); S.done(cur); }
        if (!has_next) break;
#pragma unroll
        for (int a = 0; a < 2; ++a)
#pragma unroll
            for (int b = 0; b < 2; ++b)
#pragma unroll
                for (int m = 0; m < 4; ++m)
#pragma unroll
                    for (int n = 0; n < 2; ++n) acc[a][b][m][n] = (f32x4){0.f, 0.f, 0.f, 0.f};
        cur = nxt; cA = nA; cB = nB; ++ui;
        if constexpr (ALIGN_EPI) { if (wr == 1) PG8_BAR; }
    }
    PG8_WAIT_V(0);
    if constexpr (!ALIGN_EPI) { if (wr == 0) PG8_BAR; }
    PG8_BAR;
    if constexpr (Epi::AFTER_DRAIN) { E.fused(acc, cur, wr, wc, fr, fq, lds, wid, lane); S.done(cur); }
#undef PG8_SA
#undef PG8_SB
#undef PG8_STAGE
#undef PG8_LDA
#undef PG8_LDB
#undef PG8_MMA
#undef PG8_WAIT_V
#undef PG8_WAIT_L
#undef PG8_WAIT_VR
#undef PG8_BAR
#undef PG8_SCHED
}
}

constexpr int D = 1024, SEQ = 8192, NBATCH = 4, NTOK = NBATCH * SEQ, PW = 8192, MW = 2048;
constexpr float EPS = 1e-6f;
constexpr size_t MiB = 1u << 20;
constexpr size_t WS_WIN = 0, WS_WOUT = 16 * MiB, WS_MISC = 20 * MiB, WS_RD = 20 * MiB + 65536, WS_BAR = 20 * MiB + 524288, WS_SSQ = 21 * MiB, WS_PROJ = 24 * MiB;
constexpr size_t AUX_PER_TOK = 6400;
constexpr int LDS_BYTES = 159744, PTAB_OFF = 155648;
typedef unsigned short bf16;
typedef unsigned v4u __attribute__((ext_vector_type(4)));
typedef unsigned v2u __attribute__((ext_vector_type(2)));
typedef float f32x4 __attribute__((ext_vector_type(4)));
#define LAS __attribute__((address_space(3)))
#define GAS __attribute__((address_space(1)))

__device__ __forceinline__ float bf2f(unsigned short b) { return __uint_as_float(((unsigned)b) << 16); }
__device__ __forceinline__ unsigned f2bf(float f) { unsigned u = __float_as_uint(f); return (u + 0x7fffu + ((u >> 16) & 1u)) >> 16; }
typedef __bf16 bf16x2_t __attribute__((ext_vector_type(2)));
typedef float f32x2_t __attribute__((ext_vector_type(2)));
__device__ __forceinline__ unsigned pk2(float lo, float hi) { const f32x2_t v = {lo, hi}; const bf16x2_t b = __builtin_convertvector(v, bf16x2_t); return __builtin_bit_cast(unsigned, b); }
__device__ __forceinline__ float wave_sum(float v) {
#pragma unroll
    for (int o = 1; o < 64; o <<= 1) v += __shfl_xor(v, o);
    return v;
}
__device__ __forceinline__ float wave_max(float v) {
#pragma unroll
    for (int o = 1; o < 64; o <<= 1) v = fmaxf(v, __shfl_xor(v, o));
    return v;
}
__device__ __forceinline__ float silu_f(float x) { return x * __builtin_amdgcn_rcpf(1.f + __builtin_amdgcn_exp2f(x * -1.4426950408889634f)); }
__device__ __forceinline__ void unpack8(const v4u w, float (&f)[8]) {
    f[0] = __uint_as_float(w.x << 16); f[1] = __uint_as_float(w.x & 0xffff0000u);
    f[2] = __uint_as_float(w.y << 16); f[3] = __uint_as_float(w.y & 0xffff0000u);
    f[4] = __uint_as_float(w.z << 16); f[5] = __uint_as_float(w.z & 0xffff0000u);
    f[6] = __uint_as_float(w.w << 16); f[7] = __uint_as_float(w.w & 0xffff0000u);
}

struct EpiProj {
    static constexpr bool PERM = true, AFTER_DRAIN = false; static constexpr int NVM = 16;
    GAS pg8::bf16_t* O; int odd; const GAS float* lb; const LAS float* qk; const LAS float* rstd;
    __device__ __forceinline__ void operator()(const pg8::f32x4 (&acc)[2][2][4][2], const pg8::Unit& u, int wr, int wc, int fr, int fq) const {
        const int row0 = u.pm * 256 + wr * 64 + fr, col0 = u.pn * 256 + wc * 32 + 8 * fq;
        float rsr[2][4];
#pragma unroll
        for (int ai = 0; ai < 2; ++ai)
#pragma unroll
            for (int m = 0; m < 4; ++m) rsr[ai][m] = rstd[wr * 64 + fr + ai * 128 + m * 16];
        if (!odd && u.pn >= 12 && u.pn < 20) {
            const LAS float* gt = qk + ((u.pn >= 16) ? 64 : 0) + 8 * fq;
            pg8::f32x4 gv[2][2];
#pragma unroll
            for (int bj = 0; bj < 2; ++bj)
#pragma unroll
                for (int n = 0; n < 2; ++n) gv[bj][n] = *(const LAS pg8::f32x4*)(gt + 32 * bj + 4 * n);
            const int ncol = u.pn * 256 + 64 * wc + 8 * fq;
#pragma unroll
            for (int ai = 0; ai < 2; ++ai)
#pragma unroll
                for (int m = 0; m < 4; ++m) { float ss = 0.f;
#pragma unroll
                    for (int bj = 0; bj < 2; ++bj)
#pragma unroll
                        for (int n = 0; n < 2; ++n) { const pg8::f32x4 v = acc[ai][bj][m][n] * rsr[ai][m]; ss += (v[0] * v[0] + v[1] * v[1]) + (v[2] * v[2] + v[3] * v[3]); }
                    ss += __shfl_xor(ss, 16); ss += __shfl_xor(ss, 32);
                    const float rs = rsqrtf(ss * (1.f / 64.f) + EPS);
                    GAS pg8::bf16_t* rowp = O + (size_t)(row0 + ai * 128 + m * 16) * PW + ncol;
#pragma unroll
                    for (int bj = 0; bj < 2; ++bj) { const pg8::f32x4 v0 = acc[ai][bj][m][0] * (rs * rsr[ai][m]) * gv[bj][0], v1 = acc[ai][bj][m][1] * (rs * rsr[ai][m]) * gv[bj][1];
                        pg8::u32x4 w; w.x = pg8::cvt_pk_bf16(v0[0], v0[1]); w.y = pg8::cvt_pk_bf16(v0[2], v0[3]); w.z = pg8::cvt_pk_bf16(v1[0], v1[1]); w.w = pg8::cvt_pk_bf16(v1[2], v1[3]);
                        *(GAS pg8::u32x4*)(rowp + 32 * bj) = w; } }
            return;
        }
        int act;
        if (!odd) act = (u.pn >= 24) ? 1 : 0; else act = (u.pn < 8) ? 1 : (u.pn < 16 ? 2 : (u.pn < 24 ? 0 : 1));
        pg8::f32x4 lbv[2][2];
#pragma unroll
        for (int bj = 0; bj < 2; ++bj)
#pragma unroll
            for (int n = 0; n < 2; ++n) lbv[bj][n] = (act == 2) ? *(const GAS pg8::f32x4*)(lb + (col0 - 2048) + bj * 128 + 4 * n) : (pg8::f32x4){0.f, 0.f, 0.f, 0.f};
#pragma unroll
        for (int ai = 0; ai < 2; ++ai)
#pragma unroll
            for (int m = 0; m < 4; ++m) { GAS pg8::bf16_t* rowp = O + (size_t)(row0 + ai * 128 + m * 16) * PW + col0;
#pragma unroll
                for (int bj = 0; bj < 2; ++bj) { pg8::f32x4 v0 = acc[ai][bj][m][0] * rsr[ai][m], v1 = acc[ai][bj][m][1] * rsr[ai][m];
                    if (act == 1) {
#pragma unroll
                        for (int e = 0; e < 4; ++e) { v0[e] = silu_f(v0[e]); v1[e] = silu_f(v1[e]); } }
                    else if (act == 2) {
#pragma unroll
                        for (int e = 0; e < 4; ++e) { const float s0 = __builtin_amdgcn_rcpf(1.f + __builtin_amdgcn_exp2f(v0[e] * -1.4426950408889634f)), s1 = __builtin_amdgcn_rcpf(1.f + __builtin_amdgcn_exp2f(v1[e] * -1.4426950408889634f));
                            v0[e] = __builtin_amdgcn_logf(lbv[bj][0][e] + (1.f - lbv[bj][0][e]) * s0); v1[e] = __builtin_amdgcn_logf(lbv[bj][1][e] + (1.f - lbv[bj][1][e]) * s1);     } }
                    pg8::u32x4 w; w.x = pg8::cvt_pk_bf16(v0[0], v0[1]); w.y = pg8::cvt_pk_bf16(v0[2], v0[3]); w.z = pg8::cvt_pk_bf16(v1[0], v1[1]); w.w = pg8::cvt_pk_bf16(v1[2], v1[3]);
                    *(GAS pg8::u32x4*)(rowp + bj * 128) = w; } }
    }
};
struct EpiRes {
    static constexpr bool PERM = false, AFTER_DRAIN = false; static constexpr int NVM = 0;
    const GAS float* base32; GAS bf16* xres; GAS float* out32; GAS float* ssq; int first, last;
    __device__ __forceinline__ void operator()(const pg8::f32x4 (&acc)[2][2][4][2], const pg8::Unit& u, int wr, int wc, int fr, int fq) const {
        const int row0 = u.pm * 256 + wr * 64 + fr, col0 = u.pn * 256 + wc * 32 + 4 * fq;
#pragma unroll
        for (int ai = 0; ai < 2; ++ai)
#pragma unroll
            for (int m = 0; m < 4; ++m) { const int row = row0 + ai * 128 + m * 16; const size_t off = (size_t)row * D + col0; float ss = 0.f;
#pragma unroll
                for (int bj = 0; bj < 2; ++bj)
#pragma unroll
                    for (int n = 0; n < 2; ++n) { const size_t o = off + bj * 128 + n * 16; pg8::f32x4 b;
                        if (first) b = *(const GAS pg8::f32x4*)(base32 + o);
                        else { const v2u w = *(const GAS v2u*)(xres + o); b = (pg8::f32x4){__uint_as_float(w.x << 16), __uint_as_float(w.x & 0xffff0000u), __uint_as_float(w.y << 16), __uint_as_float(w.y & 0xffff0000u)}; }
                        const pg8::f32x4 xv = b + acc[ai][bj][m][n];
                        if (last) *(GAS pg8::f32x4*)(out32 + o) = xv;
                        else { v2u w; w.x = pg8::cvt_pk_bf16(xv[0], xv[1]); w.y = pg8::cvt_pk_bf16(xv[2], xv[3]); *(GAS v2u*)(xres + o) = w;
                            const float r0 = __uint_as_float(w.x << 16), r1 = __uint_as_float(w.x & 0xffff0000u), r2 = __uint_as_float(w.y << 16), r3 = __uint_as_float(w.y & 0xffff0000u); ss += (r0 * r0 + r1 * r1) + (r2 * r2 + r3 * r3); } }
                if (!last) { ss += __shfl_xor(ss, 16); ss += __shfl_xor(ss, 32); if (fq == 0) ssq[(size_t)row * 16 + u.pn * 4 + wc] = ss; } }
    }
};

__device__ __forceinline__ void transpose_item(const GAS float* W, int K, int N, const GAS float* gain, GAS bf16* WT, LAS float* scr, int item, int lane, int remap) {
    const int nblk = N / 32, kb = item / nblk, nb = item % nblk, k0 = 64 * kb, n0 = 32 * nb;
    int ns = n0;
    if (remap && n0 >= 3072 && n0 < 5120) { const int T = (n0 - 3072) >> 8, rho = (n0 - 3072) & 255; ns = 3072 + 256 * T + 64 * ((rho >> 5) & 3) + 32 * (rho >> 7); }
#pragma unroll 8
    for (int i = 0; i < 32; ++i) { const int kk = 2 * i + (lane >> 5); float w = W[(size_t)(k0 + kk) * N + ns + (lane & 31)]; if (gain) w *= gain[k0 + kk]; scr[kk * 33 + (lane & 31)] = w; }
    asm volatile("s_waitcnt lgkmcnt(0)" ::: "memory");
    const int c = lane & 7;
#pragma unroll
    for (int j = 0; j < 4; ++j) { const int n = (lane >> 3) + 8 * j; const LAS float* s = scr + (8 * c) * 33 + n;
        v4u o; o.x = pk2(s[0 * 33], s[1 * 33]); o.y = pk2(s[2 * 33], s[3 * 33]); o.z = pk2(s[4 * 33], s[5 * 33]); o.w = pk2(s[6 * 33], s[7 * 33]);
        *(GAS v4u*)(WT + (size_t)(n0 + n) * K + k0 + 8 * c) = o; }
    asm volatile("s_waitcnt lgkmcnt(0)" ::: "memory");
}
__device__ __forceinline__ void init_rows(const GAS float* x, GAS bf16* xres, GAS float* ssq, int nrows, int gw, int ngw, int lane) {
    for (int m0 = 2 * gw; m0 < nrows; m0 += 2 * ngw) {
        f32x4 v[2][4];
#pragma unroll
        for (int q = 0; q < 2; ++q) { const GAS f32x4* xr = (const GAS f32x4*)(x + (size_t)(m0 + q) * D) + lane;
#pragma unroll
            for (int j = 0; j < 4; ++j) v[q][j] = xr[64 * j]; }
#pragma unroll
        for (int q = 0; q < 2; ++q) { float s = 0.f; GAS unsigned long long* o8 = (GAS unsigned long long*)(xres + (size_t)(m0 + q) * D) + lane;
#pragma unroll
            for (int j = 0; j < 4; ++j) { const unsigned w0 = pk2(v[q][j].x, v[q][j].y), w1 = pk2(v[q][j].z, v[q][j].w); o8[64 * j] = (unsigned long long)w0 | ((unsigned long long)w1 << 32);
                const float a0 = __uint_as_float(w0 << 16), a1 = __uint_as_float(w0 & 0xffff0000u), a2 = __uint_as_float(w1 << 16), a3 = __uint_as_float(w1 & 0xffff0000u); s += (a0 * a0 + a1 * a1) + (a2 * a2 + a3 * a3); }
            s = wave_sum(s);
            if (lane < 16) ssq[(size_t)(m0 + q) * 16 + lane] = (lane == 0) ? s : 0.f; }
    }
}

typedef short bf16x8 __attribute__((ext_vector_type(8)));
typedef float f32x16 __attribute__((ext_vector_type(16)));
__device__ __forceinline__ unsigned pkbf(float lo, float hi) { const f32x2_t v = {lo, hi}; const bf16x2_t b = __builtin_convertvector(v, bf16x2_t); return __builtin_bit_cast(unsigned, b); }
constexpr int ATT_KS = 0, ATT_KSTR = 144, ATT_VT = 384 * 144, ATT_VSTR = 192, ATT_BIAS = ATT_VT + 384 * 192;
typedef short v4i16_t __attribute__((ext_vector_type(4)));
__device__ __forceinline__ void attn_mfma(const GAS bf16* proj, GAS bf16* part, GAS float* lse, int TOKG, const GAS float* qgain, const GAS float* kgain, const GAS float* rel_bias,
                                          unsigned char* lds, int tid, int lane, int wave, int bid, int G) {
    LAS unsigned char* L = (LAS unsigned char*)lds;
    const int nunits = (TOKG / SEQ) * 16 * 96;
    const int c = lane & 31, hh = lane >> 5, c8 = tid & 7, rp2 = tid >> 3;
    const int vtl = (4 * (lane >> 5) + ((lane & 15) >> 2)) * ATT_VSTR + (16 * ((lane >> 4) & 1) + 4 * (lane & 3)) * 2;
    float kg[8];
#pragma unroll
    for (int e = 0; e < 8; ++e) kg[e] = kgain[c8 * 8 + e];
#define ATT_DEC(u_, P) const int P##i = (u_) & 31, P##pbh = (u_) >> 5, P##p = P##pbh % 3, P##bh = P##pbh / 3, P##h = P##bh & 15, P##bl = P##bh >> 4, P##dsh = 2 * P##p, \
        P##r = P##i & ((1 << P##dsh) - 1), P##m0 = (P##i >> P##dsh) * 256; const size_t P##rowb = (size_t)P##bl * SEQ;
    v4u kwr[6], vwr[6], qwr[4];
#define ATT_ISSUE(u_) do { ATT_DEC(u_, n_) \
        _Pragma("unroll") for (int it = 0; it < 6; ++it) { const int kk_ = 2 * rp2 + 128 * (it >> 1) + (it & 1); int m_ = n_m0 - 128 + kk_; m_ = m_ < 0 ? 0 : m_; \
            const GAS bf16* rp_ = proj + (n_rowb + ((size_t)m_ << n_dsh) + n_r) * PW + n_h * 64 + c8 * 8; kwr[it] = *(const GAS v4u*)(rp_ + 4096); vwr[it] = *(const GAS v4u*)(rp_ + 5120); } \
        { const GAS bf16* qp_ = proj + (n_rowb + ((size_t)(n_m0 + 32 * wave + c) << n_dsh) + n_r) * PW + 3072 + n_h * 64 + 8 * hh; \
          _Pragma("unroll") for (int s = 0; s < 4; ++s) qwr[s] = *(const GAS v4u*)(qp_ + 16 * s); } } while (0)
    LAS int* bkt = (LAS int*)(L + ATT_BIAS + 768);
    for (int e = tid; e < 3 * 129; e += 512) { const int pp = e / 129, dl = e - 129 * pp, dist = dl << (2 * pp); int bk;
        if (dist < 16) bk = dist; else { const float scl = logf((float)dist / 16.f) / logf(128.f); const int lg = 16 + (int)(scl * 16.f); bk = lg < 31 ? lg : 31; }
        bkt[e] = bk; }
    __syncthreads();
    if (bid < nunits) ATT_ISSUE(bid);
    for (int u = bid; u < nunits; u += G) {
        ATT_DEC(u, )
        __syncthreads();
        if (tid < 192) { float tv = -INFINITY; const int dl = 160 - tid;
            if (dl >= 0 && dl <= 128) tv = rel_bias[bkt[p * 129 + dl] * 16 + h] * 1.4426950408889634f;
            ((LAS float*)(L + ATT_BIAS))[tid] = tv; }
#pragma unroll
        for (int j = 0; j < 3; ++j) {
            const int kk0 = 2 * rp2 + 128 * j;
#pragma unroll
            for (int e2 = 0; e2 < 2; ++e2) { const int it = 2 * j + e2, kk = kk0 + e2;
                *(LAS v4u*)(L + ATT_KS + kk * ATT_KSTR + c8 * 16) = kwr[it];
                *(LAS v4u*)(L + ATT_VT + kk * ATT_VSTR + c8 * 16) = vwr[it]; }
        }
        const size_t orow = rowb + ((size_t)(m0 + 32 * wave + c) << dsh) + r;
        bf16x8 qf[4];
#pragma unroll
        for (int s = 0; s < 4; ++s) qf[s] = __builtin_bit_cast(bf16x8, qwr[s]);
        if (u + G < nunits) ATT_ISSUE(u + G);
        __syncthreads();
        f32x16 sc[5];
        const LAS float* tb = (const LAS float*)(L + ATT_BIAS) + (32 + 4 * hh - c);
        const int nskip = (m0 == 0 && wave < 4) ? 4 - wave : 0;
#pragma unroll
        for (int j = 0; j < 5; ++j) if (j >= nskip) {
#pragma unroll
            for (int e = 0; e < 16; ++e) sc[j][e] = tb[32 * j + (e & 3) + 8 * (e >> 2)];
#pragma unroll
            for (int s = 0; s < 4; ++s) { const bf16x8 kf = *(const LAS bf16x8*)(L + ATT_KS + (32 * wave + 32 * j + c) * ATT_KSTR + (16 * s + 8 * hh) * 2);
                sc[j] = __builtin_amdgcn_mfma_f32_32x32x16_bf16(kf, qf[s], sc[j], 0, 0, 0); } }
        float l = 0.f;
#pragma unroll
        for (int j = 0; j < 5; ++j) if (j >= nskip) {
#pragma unroll
            for (int e = 0; e < 16; ++e) { const float pe = __builtin_amdgcn_exp2f(sc[j][e]); sc[j][e] = pe; l += pe; } }
        l += __shfl_xor(l, 32);
        f32x16 o[2];
#pragma unroll
        for (int e = 0; e < 16; ++e) { o[0][e] = 0.f; o[1][e] = 0.f; }
#pragma unroll
        for (int j = 0; j < 5; ++j) if (j >= nskip)
#pragma unroll
            for (int s2 = 0; s2 < 2; ++s2) {
                v4u pw; pw.x = pkbf(sc[j][8 * s2 + 0], sc[j][8 * s2 + 1]); pw.y = pkbf(sc[j][8 * s2 + 2], sc[j][8 * s2 + 3]); pw.z = pkbf(sc[j][8 * s2 + 4], sc[j][8 * s2 + 5]); pw.w = pkbf(sc[j][8 * s2 + 6], sc[j][8 * s2 + 7]);
                const bf16x8 pf = __builtin_bit_cast(bf16x8, pw);
                const int kb = 32 * wave + 32 * j + 16 * s2;
#pragma unroll
                for (int dt = 0; dt < 2; ++dt) { const LAS unsigned char* vp = L + ATT_VT + vtl + kb * ATT_VSTR + 64 * dt;
                    const v4i16_t lo = __builtin_amdgcn_ds_read_tr16_b64_v4i16((LAS v4i16_t*)vp), hi = __builtin_amdgcn_ds_read_tr16_b64_v4i16((LAS v4i16_t*)(vp + 8 * ATT_VSTR));
                    bf16x8 vf; vf[0] = lo[0]; vf[1] = lo[1]; vf[2] = lo[2]; vf[3] = lo[3]; vf[4] = hi[0]; vf[5] = hi[1]; vf[6] = hi[2]; vf[7] = hi[3];
                    o[dt] = __builtin_amdgcn_mfma_f32_32x32x16_bf16(vf, pf, o[dt], 0, 0, 0); } }
        const float inv = __builtin_amdgcn_rcpf(l);
        GAS bf16* op = part + ((size_t)p * TOKG + orow) * 1024 + h * 64 + 4 * hh;
#pragma unroll
        for (int dt = 0; dt < 2; ++dt)
#pragma unroll
            for (int g4 = 0; g4 < 4; ++g4) { v2u w; w.x = pkbf(o[dt][4 * g4] * inv, o[dt][4 * g4 + 1] * inv); w.y = pkbf(o[dt][4 * g4 + 2] * inv, o[dt][4 * g4 + 3] * inv);
                *(GAS v2u*)(op + 32 * dt + 8 * g4) = w; }
        if (hh == 0) lse[((size_t)p * TOKG + orow) * 16 + h] = __logf(l);
    }
#undef ATT_DEC
#undef ATT_ISSUE
}
__device__ __forceinline__ void merge_conv(const GAS bf16* proj, const GAS bf16* part, const GAS float* lse, GAS bf16* y, int TOKG, const GAS float* convw, int lane, int gw, int ngw) {
    float cw[2][3][8];
#pragma unroll
    for (int i = 0; i < 2; ++i)
#pragma unroll
        for (int dt = 0; dt < 3; ++dt) { const f32x4 a = *(const GAS f32x4*)(convw + dt * 1024 + lane * 8 + 512 * i), b4 = *(const GAS f32x4*)(convw + dt * 1024 + lane * 8 + 512 * i + 4);
            cw[i][dt][0] = a.x; cw[i][dt][1] = a.y; cw[i][dt][2] = a.z; cw[i][dt][3] = a.w; cw[i][dt][4] = b4.x; cw[i][dt][5] = b4.y; cw[i][dt][6] = b4.z; cw[i][dt][7] = b4.w; }
    for (int it0 = 2 * gw; it0 < TOKG; it0 += 2 * ngw) {
        const int t = it0 & (SEQ - 1); const GAS bf16* prow = proj + (size_t)it0 * PW;
#pragma unroll
        for (int i = 0; i < 2; ++i) { const int c0 = lane * 8 + 512 * i;
            float u[4][8];
#pragma unroll
            for (int k = 0; k < 4; ++k) { const int tt = t - 2 + k;
                if (tt >= 0) { const GAS bf16* pr = prow + ((ptrdiff_t)k - 2) * PW; float gc[8], xa[8];
                    unpack8(*(const GAS v4u*)(pr + 1024 + c0), gc); unpack8(*(const GAS v4u*)(pr + 2048 + c0), xa);
#pragma unroll
                    for (int e = 0; e < 8; ++e) u[k][e] = gc[e] * xa[e]; }
                else {
#pragma unroll
                    for (int e = 0; e < 8; ++e) u[k][e] = 0.f; } }
#pragma unroll
            for (int q = 0; q < 2; ++q) { const GAS bf16* pq = prow + (size_t)q * PW;
                float gb[8], z[8], r[8]; unpack8(*(const GAS v4u*)(pq + c0), gb); unpack8(*(const GAS v4u*)(pq + 6144 + c0), z);
#pragma unroll
                for (int e = 0; e < 8; ++e) r[e] = gb[e] * (cw[i][0][e] * u[q][e] + cw[i][1][e] * u[q + 1][e] + cw[i][2][e] * u[q + 2][e]) * z[e];
                v4u o; o.x = pk2(r[0], r[1]); o.y = pk2(r[2], r[3]); o.z = pk2(r[4], r[5]); o.w = pk2(r[6], r[7]);
                *(GAS v4u*)(y + (size_t)(it0 + q) * MW + c0) = o; } }
#pragma unroll
        for (int q = 0; q < 2; ++q) { const int it = it0 + q; const GAS bf16* pq = prow + (size_t)q * PW;
#pragma unroll
            for (int i = 0; i < 2; ++i) { const int c0 = lane * 8 + 512 * i, h = c0 >> 6;
                const float l0 = lse[((size_t)0 * TOKG + it) * 16 + h], l1 = lse[((size_t)1 * TOKG + it) * 16 + h], l2 = lse[((size_t)2 * TOKG + it) * 16 + h];
                const float mx = fmaxf(l0, fmaxf(l1, l2)); float w0 = __expf(l0 - mx), w1 = __expf(l1 - mx), w2 = __expf(l2 - mx); const float inv = __builtin_amdgcn_rcpf(w0 + w1 + w2); w0 *= inv; w1 *= inv; w2 *= inv;
                float a0[8], a1[8], a2[8], z[8];
                unpack8(*(const GAS v4u*)(part + ((size_t)0 * TOKG + it) * 1024 + c0), a0); unpack8(*(const GAS v4u*)(part + ((size_t)1 * TOKG + it) * 1024 + c0), a1); unpack8(*(const GAS v4u*)(part + ((size_t)2 * TOKG + it) * 1024 + c0), a2);
                unpack8(*(const GAS v4u*)(pq + 6144 + 1024 + c0), z);
                float r[8];
#pragma unroll
                for (int e = 0; e < 8; ++e) r[e] = (w0 * a0[e] + w1 * a1[e] + w2 * a2[e]) * z[e];
                v4u o; o.x = pk2(r[0], r[1]); o.y = pk2(r[2], r[3]); o.z = pk2(r[4], r[5]); o.w = pk2(r[6], r[7]);
                *(GAS v4u*)(y + (size_t)it * MW + 1024 + c0) = o; } }
    }
}

typedef float f32x4h __attribute__((ext_vector_type(4)));
typedef float f32x2h __attribute__((ext_vector_type(2)));
#define MFMA16(a, b, c) __builtin_amdgcn_mfma_f32_16x16x32_bf16((a), (b), (c), 0, 0, 0)
constexpr float LOG2E = 1.4426950408889634f;
constexpr int HS = 144, HQS = 272, RUNC = 16;
constexpr int H1_KT = 0, H1_VT = 128 * HS, H1_SEG = 2 * 128 * HS, H1_DEC = H1_SEG + 4096;
constexpr int H3_QH = 0, H3_QM = 64 * HQS, H3_KM = 2 * 64 * HQS, H3_VT = 3 * 64 * HQS, H3_AM = H3_VT + 128 * HS, H3_SEG = H3_AM + 64 * HS, H3_RED = H3_SEG + 4096, H3_KT = H3_RED + 2048, H3_DEC = H3_KT + 128 * HS, H3_SL = H3_DEC + 512;
static_assert(H3_SL + 128 * HQS <= 150 * 1024, "HGRN LDS map");
__device__ __forceinline__ float lo16(unsigned w) { return __uint_as_float(w << 16); }
__device__ __forceinline__ float hi16(unsigned w) { return __uint_as_float(w & 0xffff0000u); }
__device__ __forceinline__ void hgrn_r1(const GAS bf16* proj, GAS float* RU, GAS float* RD, int TOKG, unsigned char* lds, int tid, int lane, int wave, int bid, int G) {
    LAS unsigned char* L = (LAS unsigned char*)lds;
    constexpr int KSET = 128 * HS + 512, VSET = 128 * HS + 4096, VS0 = 2 * KSET;
    static_assert(VS0 + 3 * VSET <= 128 * 1024, "r1 LDS map");
    const int nruns = (TOKG / SEQ) * 16 * (128 / RUNC);
    const int fr = lane & 15, fq = lane >> 4;
    unsigned rg[8], rv[8];
    unsigned voff[8];
#pragma unroll
    for (int i = 0; i < 8; ++i) voff[i] = (unsigned)((wave * 8 + i) * (PW * 2) + lane * 4);
    const __amdgpu_buffer_rsrc_t prs = __builtin_amdgcn_make_buffer_rsrc((void*)proj, 0, (int)((size_t)TOKG * PW * 2), 0x00020000);
#define H1_LOAD(u_) do { const int cch_ = (u_) & 127, seq_ = (u_) >> 7; const int so_ = (int)((((size_t)(seq_ >> 4) * SEQ + cch_ * 64) * PW + (seq_ & 15) * 128) * 2); \
        _Pragma("unroll") for (int i = 0; i < 8; ++i) { rg[i] = __builtin_amdgcn_raw_buffer_load_b32(prs, (int)voff[i], so_ + 4096, 0); rv[i] = __builtin_amdgcn_raw_buffer_load_b32(prs, (int)voff[i], so_ + 8192, 0); } } while (0)
    float f0[8], f1[8], run0, run1;
#define R1_P(c_, more_) do { v4u vv0_, vv1_; run0 = 0.f; run1 = 0.f; \
        _Pragma("unroll") for (int i = 0; i < 8; ++i) { const float g0 = lo16(rg[i]), g1 = hi16(rg[i]); run0 += g0; run1 += g1; f0[i] = __builtin_amdgcn_exp2f(g0); f1[i] = __builtin_amdgcn_exp2f(g1); } \
        vv0_.x = (rv[0] & 0xffffu) | (rv[1] << 16); vv0_.y = (rv[2] & 0xffffu) | (rv[3] << 16); vv0_.z = (rv[4] & 0xffffu) | (rv[5] << 16); vv0_.w = (rv[6] & 0xffffu) | (rv[7] << 16); \
        vv1_.x = (rv[0] >> 16) | (rv[1] & 0xffff0000u); vv1_.y = (rv[2] >> 16) | (rv[3] & 0xffff0000u); vv1_.z = (rv[4] >> 16) | (rv[5] & 0xffff0000u); vv1_.w = (rv[6] >> 16) | (rv[7] & 0xffff0000u); \
        if (more_) H1_LOAD(u0 + (c_) + 1); \
        LAS unsigned char* Lv_ = L + VS0 + ((c_) % 3) * VSET; \
        *(LAS f32x2h*)((LAS float*)(Lv_ + 128 * HS) + wave * 128 + 2 * lane) = (f32x2h){run0, run1}; \
        *(LAS v4u*)(Lv_ + (2 * lane) * HS + wave * 16) = vv0_; *(LAS v4u*)(Lv_ + (2 * lane + 1) * HS + wave * 16) = vv1_; } while (0)
#define R1_B(c_) do { const LAS float* sg_ = (const LAS float*)(L + VS0 + ((c_) % 3) * VSET + 128 * HS); LAS unsigned char* Lk_ = L + ((c_) & 1) * KSET; \
        float pre0 = 0.f, pre1 = 0.f, tot0 = 0.f, tot1 = 0.f; \
        _Pragma("unroll") for (int s8 = 0; s8 < 8; ++s8) { const f32x2h t = *(const LAS f32x2h*)(sg_ + s8 * 128 + 2 * lane); tot0 += t.x; tot1 += t.y; pre0 += (s8 < wave) ? t.x : 0.f; pre1 += (s8 < wave) ? t.y : 0.f; } \
        float w0[8], w1[8]; w0[7] = __builtin_amdgcn_exp2f(tot0 - (pre0 + run0)); w1[7] = __builtin_amdgcn_exp2f(tot1 - (pre1 + run1)); \
        _Pragma("unroll") for (int i = 6; i >= 0; --i) { w0[i] = w0[i + 1] * f0[i + 1]; w1[i] = w1[i + 1] * f1[i + 1]; } \
        v4u a_, b_; \
        a_.x = pkbf((1.f - f0[0]) * w0[0], (1.f - f0[1]) * w0[1]); a_.y = pkbf((1.f - f0[2]) * w0[2], (1.f - f0[3]) * w0[3]); a_.z = pkbf((1.f - f0[4]) * w0[4], (1.f - f0[5]) * w0[5]); a_.w = pkbf((1.f - f0[6]) * w0[6], (1.f - f0[7]) * w0[7]); \
        b_.x = pkbf((1.f - f1[0]) * w1[0], (1.f - f1[1]) * w1[1]); b_.y = pkbf((1.f - f1[2]) * w1[2], (1.f - f1[3]) * w1[3]); b_.z = pkbf((1.f - f1[4]) * w1[4], (1.f - f1[5]) * w1[5]); b_.w = pkbf((1.f - f1[6]) * w1[6], (1.f - f1[7]) * w1[7]); \
        *(LAS v4u*)(Lk_ + (2 * lane) * HS + wave * 16) = a_; *(LAS v4u*)(Lk_ + (2 * lane + 1) * HS + wave * 16) = b_; \
        sum0 += tot0; sum1 += tot1; \
        if (wave == 0) *(LAS f32x2h*)((LAS float*)(Lk_ + 128 * HS) + 2 * lane) = (f32x2h){__builtin_amdgcn_exp2f(tot0), __builtin_amdgcn_exp2f(tot1)}; } while (0)
    for (int run = ((G & 7) == 0) ? (bid & 7) * (G >> 3) + (bid >> 3) : bid; run < nruns; run += G) {
        const int u0 = run * RUNC;
        __syncthreads();
        H1_LOAD(u0);
        f32x4h acc[8];
#pragma unroll
        for (int nk = 0; nk < 8; ++nk) acc[nk] = (f32x4h){0.f, 0.f, 0.f, 0.f};
        float sum0 = 0.f, sum1 = 0.f;
        R1_P(0, true);
        __syncthreads();
        R1_B(0);
        for (int ci = 0; ci < RUNC; ++ci) {
            const bool nxt = ci + 1 < RUNC;
            if (nxt) R1_P(ci + 1, ci + 2 < RUNC);
            __syncthreads();
            { const LAS unsigned char* Lv = L + VS0 + (ci % 3) * VSET; const LAS unsigned char* Lk = L + (ci & 1) * KSET; const LAS float* decl = (const LAS float*)(Lk + 128 * HS);
              bf16x8 vf[2];
#pragma unroll
              for (int ks = 0; ks < 2; ++ks) vf[ks] = *(const LAS bf16x8*)(Lv + (16 * wave + fr) * HS + (32 * ks + 8 * fq) * 2);
#pragma unroll
              for (int nk = 0; nk < 8; ++nk) { const f32x4h dk = *(const LAS f32x4h*)(decl + 16 * nk + 4 * fq); acc[nk] = acc[nk] * dk;
#pragma unroll
                  for (int ks = 0; ks < 2; ++ks) { const bf16x8 kf = *(const LAS bf16x8*)(Lk + (16 * nk + fr) * HS + (32 * ks + 8 * fq) * 2); acc[nk] = MFMA16(kf, vf[ks], acc[nk]); } } }
            if (nxt) R1_B(ci + 1);
        }
        GAS float* sp = RU + (size_t)run * 16384 + (16 * wave + fr) * 128 + 4 * fq;
#pragma unroll
        for (int nk = 0; nk < 8; ++nk) *(GAS f32x4h*)(sp + 16 * nk) = acc[nk];
        if (wave == 0) *(GAS f32x2h*)(RD + (size_t)run * 128 + 2 * lane) = (f32x2h){__builtin_amdgcn_exp2f(sum0), __builtin_amdgcn_exp2f(sum1)};
    }
#undef R1_P
#undef R1_B
#undef H1_LOAD
}
__device__ __forceinline__ void hgrn_r3(const GAS bf16* proj, const GAS float* RU, const GAS float* RD, GAS bf16* y, int TOKG, const GAS float* ogain, unsigned char* lds, int tid, int lane, int wave, int bid, int G) {
    LAS unsigned char* L = (LAS unsigned char*)lds;
    LAS float* segtot = (LAS float*)(L + H3_SEG); LAS float* red = (LAS float*)(L + H3_RED); LAS float* decl = (LAS float*)(L + H3_DEC);
    const int nruns = (TOKG / SEQ) * 16 * (128 / RUNC);
    const int fr = lane & 15, fq = lane >> 4;
    unsigned rq[8], rg[8], rv[8];
    unsigned voff[8], zoff[4], yoff[4];
#pragma unroll
    for (int i = 0; i < 8; ++i) voff[i] = (unsigned)((wave * 8 + i) * (PW * 2) + lane * 4);
#pragma unroll
    for (int t2 = 0; t2 < 4; ++t2) { zoff[t2] = (unsigned)(((16 * t2 + fr) * PW + 16 * wave + 4 * fq) * 2); yoff[t2] = (unsigned)(((16 * t2 + fr) * MW + 16 * wave + 4 * fq) * 2); }
    const __amdgpu_buffer_rsrc_t prs = __builtin_amdgcn_make_buffer_rsrc((void*)proj, 0, (int)((size_t)TOKG * PW * 2), 0x00020000);
#define H3_LOAD(u_) do { const int cch_ = (u_) & 127, seq_ = (u_) >> 7; const int so_ = (int)((((size_t)(seq_ >> 4) * SEQ + cch_ * 64) * PW + (seq_ & 15) * 128) * 2); \
        _Pragma("unroll") for (int i = 0; i < 8; ++i) { rq[i] = __builtin_amdgcn_raw_buffer_load_b32(prs, (int)voff[i], so_, 0); rg[i] = __builtin_amdgcn_raw_buffer_load_b32(prs, (int)voff[i], so_ + 4096, 0); rv[i] = __builtin_amdgcn_raw_buffer_load_b32(prs, (int)voff[i], so_ + 8192, 0); } } while (0)
    for (int run = ((G & 7) == 0) ? (bid & 7) * (G >> 3) + (bid >> 3) : bid; run < nruns; run += G) {
        const int u0 = run * RUNC, seq = run / (128 / RUNC), rr = run - seq * (128 / RUNC), h = seq & 15, bl = seq >> 4;
        H3_LOAD(u0);
        const int v0 = 16 * wave + 4 * fq;
        const f32x4 og = *(const GAS f32x4*)(ogain + h * 128 + v0);
        f32x4h Sm[8];
#pragma unroll
        for (int nk = 0; nk < 8; ++nk) Sm[nk] = (f32x4h){0.f, 0.f, 0.f, 0.f};
        for (int r2 = 0; r2 < rr; ++r2) { const int rn = run - rr + r2;
            const GAS float* up = RU + (size_t)rn * 16384 + (16 * wave + fr) * 128 + 4 * fq; const GAS float* dp = RD + (size_t)rn * 128 + 4 * fq;
#pragma unroll
            for (int nk = 0; nk < 8; ++nk) { const f32x4h uu = *(const GAS f32x4h*)(up + 16 * nk), dd = *(const GAS f32x4h*)(dp + 16 * nk); Sm[nk] = Sm[nk] * dd + uu; } }
        for (int ci = 0; ci < RUNC; ++ci) {
            const int u = u0 + ci, cch = u & 127;
            const size_t rowc = (size_t)bl * SEQ + cch * 64;
            v2u zw[4];
            { const GAS char* zb = (const GAS char*)(proj + rowc * PW + 6144 + h * 128);
#pragma unroll
              for (int t2 = 0; t2 < 4; ++t2) zw[t2] = *(const GAS v2u*)(zb + zoff[t2]); }
            bf16x8 sf[4];
            { LAS unsigned char* sl = L + H3_SL + (16 * wave + fr) * HQS;
#pragma unroll
              for (int nk = 0; nk < 8; ++nk) { v2u w; w.x = pkbf(Sm[nk][0], Sm[nk][1]); w.y = pkbf(Sm[nk][2], Sm[nk][3]); *(LAS v2u*)(sl + (16 * nk + 4 * fq) * 2) = w; }
#pragma unroll
              for (int ks = 0; ks < 4; ++ks) sf[ks] = *(const LAS bf16x8*)(sl + (32 * ks + 8 * fq) * 2); }
            float f0[8], f1[8], qv0[8], qv1[8]; float run0 = 0.f, run1 = 0.f; v4u vv0, vv1;
            { float p0 = 1.f, p1 = 1.f;
#pragma unroll
              for (int i = 0; i < 8; ++i) { const float g0 = lo16(rg[i]), g1 = hi16(rg[i]); run0 += g0; run1 += g1; f0[i] = __builtin_amdgcn_exp2f(g0); f1[i] = __builtin_amdgcn_exp2f(g1);
                  p0 *= f0[i]; p1 *= f1[i]; qv0[i] = lo16(rq[i]) * p0; qv1[i] = hi16(rq[i]) * p1; } }
            vv0.x = (rv[0] & 0xffffu) | (rv[1] << 16); vv0.y = (rv[2] & 0xffffu) | (rv[3] << 16); vv0.z = (rv[4] & 0xffffu) | (rv[5] << 16); vv0.w = (rv[6] & 0xffffu) | (rv[7] << 16);
            vv1.x = (rv[0] >> 16) | (rv[1] & 0xffff0000u); vv1.y = (rv[2] >> 16) | (rv[3] & 0xffff0000u); vv1.z = (rv[4] >> 16) | (rv[5] & 0xffff0000u); vv1.w = (rv[6] >> 16) | (rv[7] & 0xffff0000u);
            if (ci + 1 < RUNC) H3_LOAD(u + 1);
            *(LAS f32x2h*)(segtot + wave * 128 + 2 * lane) = (f32x2h){run0, run1};
            *(LAS v4u*)(L + H3_VT + (2 * lane) * HS + wave * 16) = vv0; *(LAS v4u*)(L + H3_VT + (2 * lane + 1) * HS + wave * 16) = vv1;
            __syncthreads();
            { float pre0 = 0.f, pre1 = 0.f, gr0 = 0.f, gr1 = 0.f, tot0 = 0.f, tot1 = 0.f;
#pragma unroll
              for (int s8 = 0; s8 < 8; ++s8) { const f32x2h t = *(const LAS f32x2h*)(segtot + s8 * 128 + 2 * lane); tot0 += t.x; tot1 += t.y; pre0 += (s8 < wave) ? t.x : 0.f; pre1 += (s8 < wave) ? t.y : 0.f; if (s8 < 4) { gr0 += t.x; gr1 += t.y; } }
              unsigned kw0[4], kw1[4];
              const float eg0 = __builtin_amdgcn_exp2f(fminf(-gr0, 115.f)), eg1 = __builtin_amdgcn_exp2f(fminf(-gr1, 115.f)), tg0 = __builtin_amdgcn_exp2f(tot0 - gr0), tg1 = __builtin_amdgcn_exp2f(tot1 - gr1);
              const float ep0 = __builtin_amdgcn_exp2f(pre0), ep1 = __builtin_amdgcn_exp2f(pre1);
              float kv0[8], kv1[8], m0_ = __builtin_amdgcn_exp2f(fminf(gr0 - (pre0 + run0), 115.f)), m1_ = __builtin_amdgcn_exp2f(fminf(gr1 - (pre1 + run1), 115.f));
#pragma unroll
              for (int i = 7; i >= 0; --i) { const int s = wave * 8 + i;
                  const float qh0 = qv0[i] * ep0, qh1 = qv1[i] * ep1;
                  const float km0 = (1.f - f0[i]) * m0_, km1 = (1.f - f1[i]) * m1_;
                  *(LAS unsigned*)(L + H3_QH + s * HQS + lane * 4) = pkbf(qh0, qh1);
                  *(LAS unsigned*)(L + H3_QM + s * HQS + lane * 4) = pkbf(qh0 * eg0, qh1 * eg1);
                  *(LAS unsigned*)(L + H3_KM + s * HQS + lane * 4) = pkbf(km0, km1);
                  kv0[i] = km0 * tg0; kv1[i] = km1 * tg1; m0_ *= f0[i]; m1_ *= f1[i]; }
#pragma unroll
              for (int i = 0; i < 4; ++i) { kw0[i] = pkbf(kv0[2 * i], kv0[2 * i + 1]); kw1[i] = pkbf(kv1[2 * i], kv1[2 * i + 1]); }
              { v4u a, b; a.x = kw0[0]; a.y = kw0[1]; a.z = kw0[2]; a.w = kw0[3]; b.x = kw1[0]; b.y = kw1[1]; b.z = kw1[2]; b.w = kw1[3];
                *(LAS v4u*)(L + H3_KT + (2 * lane) * HS + wave * 16) = a; *(LAS v4u*)(L + H3_KT + (2 * lane + 1) * HS + wave * 16) = b; }
              if (wave == 0) *(LAS f32x2h*)(decl + 2 * lane) = (f32x2h){__builtin_amdgcn_exp2f(tot0), __builtin_amdgcn_exp2f(tot1)}; }
            __syncthreads();
            { const int tt = wave >> 1;
#pragma unroll
              for (int ss2 = 0; ss2 < 2; ++ss2) { const int ss = 2 * (wave & 1) + ss2; f32x4h a = {0.f, 0.f, 0.f, 0.f};
                  if (ss <= tt) {
#pragma unroll
                      for (int ks = 0; ks < 4; ++ks) { const bf16x8 kmf = *(const LAS bf16x8*)(L + H3_KM + (16 * ss + fr) * HQS + (32 * ks + 8 * fq) * 2);
                          const bf16x8 qmf = *(const LAS bf16x8*)(L + H3_QM + (16 * tt + fr) * HQS + (32 * ks + 8 * fq) * 2); a = MFMA16(kmf, qmf, a); } }
                  const int t = 16 * tt + fr, s0 = 16 * ss + 4 * fq;
                  v2u w; w.x = pkbf(s0 <= t ? a[0] : 0.f, s0 + 1 <= t ? a[1] : 0.f); w.y = pkbf(s0 + 2 <= t ? a[2] : 0.f, s0 + 3 <= t ? a[3] : 0.f);
                  *(LAS v2u*)(L + H3_AM + t * HS + s0 * 2) = w; } }
            f32x4h acc[4];
#pragma unroll
            for (int t2 = 0; t2 < 4; ++t2) acc[t2] = (f32x4h){0.f, 0.f, 0.f, 0.f};
#pragma unroll
            for (int t2 = 0; t2 < 4; ++t2)
#pragma unroll
                for (int ks = 0; ks < 4; ++ks) { const bf16x8 qf = *(const LAS bf16x8*)(L + H3_QH + (16 * t2 + fr) * HQS + (32 * ks + 8 * fq) * 2); acc[t2] = MFMA16(sf[ks], qf, acc[t2]); }
            bf16x8 vf[2];
#pragma unroll
            for (int ks = 0; ks < 2; ++ks) vf[ks] = *(const LAS bf16x8*)(L + H3_VT + (16 * wave + fr) * HS + (32 * ks + 8 * fq) * 2);
#pragma unroll
            for (int nk = 0; nk < 8; ++nk) { const f32x4h dk = *(const LAS f32x4h*)(decl + 16 * nk + 4 * fq); Sm[nk] = Sm[nk] * dk;
#pragma unroll
                for (int ks = 0; ks < 2; ++ks) { const bf16x8 kf = *(const LAS bf16x8*)(L + H3_KT + (16 * nk + fr) * HS + (32 * ks + 8 * fq) * 2); Sm[nk] = MFMA16(kf, vf[ks], Sm[nk]); } }
            __syncthreads();
#pragma unroll
            for (int t2 = 0; t2 < 4; ++t2)
#pragma unroll
                for (int ks = 0; ks < 2; ++ks) { const bf16x8 af = *(const LAS bf16x8*)(L + H3_AM + (16 * t2 + fr) * HS + (32 * ks + 8 * fq) * 2); acc[t2] = MFMA16(vf[ks], af, acc[t2]); }
#pragma unroll
            for (int t2 = 0; t2 < 4; ++t2) { float ss = acc[t2][0] * acc[t2][0] + acc[t2][1] * acc[t2][1] + acc[t2][2] * acc[t2][2] + acc[t2][3] * acc[t2][3];
                ss += __shfl_xor(ss, 16); ss += __shfl_xor(ss, 32); if (fq == 0) red[(16 * t2 + fr) * 8 + wave] = ss; }
            __syncthreads();
#pragma unroll
            for (int t2 = 0; t2 < 4; ++t2) { const int t = 16 * t2 + fr; float tot = 0.f;
#pragma unroll
                for (int w8 = 0; w8 < 2; ++w8) { const f32x4h pr = *(const LAS f32x4h*)(red + t * 8 + 4 * w8); tot += (pr[0] + pr[1]) + (pr[2] + pr[3]); }
                const float rstd = rsqrtf(tot * (1.f / 128.f) + EPS);
                v2u w; w.x = pkbf(acc[t2][0] * rstd * og.x * lo16(zw[t2].x), acc[t2][1] * rstd * og.y * hi16(zw[t2].x));
                w.y = pkbf(acc[t2][2] * rstd * og.z * lo16(zw[t2].y), acc[t2][3] * rstd * og.w * hi16(zw[t2].y));
                *(GAS v2u*)((GAS char*)(y + rowc * MW + h * 128) + yoff[t2]) = w; }
        }
    }
#undef H3_LOAD
}

#define XB_TMO      128
#define XB_XCNT(j)  (256  + 64 * (j))
#define XB_XSUB(j)  (1280 + 64 * (j))
#define XB_XGEN(j)  (2304 + 64 * (j))
#define XB_TOP      3328
#define XB_TOPGEN   3392
#define XCD_BAR_WORDS 3456
#define XB_SPIN_CAP (1u << 18)

__device__ __forceinline__ unsigned xb_ld(unsigned* p)              { return __hip_atomic_load(p, __ATOMIC_RELAXED, __HIP_MEMORY_SCOPE_AGENT); }
__device__ __forceinline__ unsigned xb_add(unsigned* p, unsigned v) { return __hip_atomic_fetch_add(p, v, __ATOMIC_RELAXED, __HIP_MEMORY_SCOPE_AGENT); }
__device__ __forceinline__ unsigned xb_xcc_id() { return (unsigned)__builtin_amdgcn_s_getreg((3 << 11) | 20) & 0xFu; }
#define XB_SPIN(cond, bar) do { unsigned _sp = 0; while (cond) { __builtin_amdgcn_s_sleep(1); \
    if ((++_sp & 255u) == 0u) { if (xb_ld(&(bar)[XB_TMO])) break; if (_sp > XB_SPIN_CAP) { atomicAdd(&(bar)[XB_TMO], 1u); break; } } } } while (0)

struct XcdBarrier {
    unsigned* bar; unsigned x;
    volatile LAS unsigned* st;
};

__device__ __forceinline__ XcdBarrier xcd_barrier_post(unsigned* bar, volatile LAS unsigned* st) {
    XcdBarrier b; b.bar = bar; b.x = xb_xcc_id(); b.st = st;
    if (threadIdx.x == 0) (void)xb_add(&bar[XB_XCNT(b.x)], 1u);
    return b;
}
__device__ __forceinline__ void xcd_barrier_complete(unsigned* bar, unsigned x, unsigned& nloc, unsigned& nx) {
    const unsigned G = gridDim.x * gridDim.y * gridDim.z;
    unsigned sum, cnt, mine, sp = 0u;
    for (;;) {
        sum = 0u; cnt = 0u; mine = 0u;
#pragma unroll
        for (unsigned j = 0; j < 16; ++j) { const unsigned c = xb_ld(&bar[XB_XCNT(j)]); sum += c; cnt += (c > 0u) ? 1u : 0u; mine = (j == x) ? c : mine; }
        if (sum == G) break;
        __builtin_amdgcn_s_sleep(1);
        if ((++sp & 255u) == 0u) { if (xb_ld(&bar[XB_TMO])) break; if (sp > XB_SPIN_CAP) { atomicAdd(&bar[XB_TMO], 1u); break; } }
    }
    nloc = mine > 0u ? mine : 1u; nx = cnt > 0u ? cnt : 1u;
}

__device__ __forceinline__ void xcd_barrier(const XcdBarrier& b) {
    asm volatile("s_waitcnt vmcnt(0)" ::: "memory");
    __syncthreads();
    if (threadIdx.x == 0) {
        unsigned* bar = b.bar;
        __builtin_amdgcn_s_waitcnt(0);
        unsigned nloc = b.st[0], nx = b.st[1];
        if (nloc == 0u) { xcd_barrier_complete(bar, b.x, nloc, nx); b.st[0] = nloc; b.st[1] = nx; }
        const unsigned old = xb_add(&bar[XB_XSUB(b.x)], 1u);
        const unsigned gen = old / nloc;
        if (old + 1u == (gen + 1u) * nloc) {
            __builtin_amdgcn_fence(__ATOMIC_RELEASE, "agent");
            asm volatile("s_waitcnt vmcnt(0)" ::: "memory");
            const unsigned og = xb_add(&bar[XB_TOP], 1u);
            const unsigned tg = og / nx;
            if (og + 1u == (tg + 1u) * nx) xb_add(&bar[XB_TOPGEN], 1u);
            else XB_SPIN(xb_ld(&bar[XB_TOPGEN]) == tg, bar);
            __builtin_amdgcn_fence(__ATOMIC_ACQUIRE, "agent");
            xb_add(&bar[XB_XGEN(b.x)], 1u);
            asm volatile("s_waitcnt vmcnt(0)" ::: "memory");
        } else {
            XB_SPIN(xb_ld(&bar[XB_XGEN(b.x)]) == gen, bar);
            __builtin_amdgcn_fence(__ATOMIC_ACQUIRE, "agent");
            asm volatile("s_waitcnt vmcnt(0)" ::: "memory");
        }
    }
    __syncthreads();
}

__device__ __forceinline__ unsigned long long ldptr(LAS unsigned long long* tab, int i) { asm volatile("" ::: "memory"); const unsigned long long v = tab[i];
    const unsigned lo = __builtin_amdgcn_readfirstlane((unsigned)v), hi = __builtin_amdgcn_readfirstlane((unsigned)(v >> 32)); return ((unsigned long long)hi << 32) | lo; }
struct Args { const float* in[13]; float* out; unsigned char* ws; int ngroups; int pad; };
struct Ctx { int layer, g, NG, TOKG, j, even, tid, lane, wave, G, bid, gw, ngw; GAS unsigned char* wsb; GAS bf16 *Wt_in, *Wt_out, *proj, *ybuf, *xn, *xres; GAS float *lbtab, *ssq; size_t row0; };
__device__ __forceinline__ Ctx load_ctx(LAS unsigned long long* ptab) {
    Ctx c; const int step = (int)ldptr(ptab, 16); c.NG = (int)ldptr(ptab, 15); c.layer = step / c.NG; c.g = step - c.layer * c.NG; c.TOKG = NTOK / c.NG; c.j = c.layer >> 1; c.even = !(c.layer & 1);
    int tid_raw = threadIdx.x; asm volatile("" : "+v"(tid_raw)); c.tid = tid_raw; c.lane = c.tid & 63; c.wave = __builtin_amdgcn_readfirstlane(c.tid >> 6);
    c.G = gridDim.x; c.bid = blockIdx.x; c.gw = c.bid * 8 + c.wave; c.ngw = c.G * 8;
    c.wsb = (GAS unsigned char*)ldptr(ptab, 14);
    c.Wt_in = (GAS bf16*)(c.wsb + WS_WIN); c.Wt_out = (GAS bf16*)(c.wsb + WS_WOUT); c.lbtab = (GAS float*)(c.wsb + WS_MISC); c.proj = (GAS bf16*)(c.wsb + WS_PROJ);
    c.ybuf = (GAS bf16*)(c.wsb + WS_PROJ + (size_t)c.TOKG * (PW * 2)); c.xn = (GAS bf16*)(c.wsb + WS_PROJ + (size_t)c.TOKG * (PW * 2 + MW * 2));
    c.xres = (GAS bf16*)(c.wsb + WS_PROJ + (size_t)c.TOKG * (PW * 2 + MW * 2 + AUX_PER_TOK)); c.ssq = (GAS float*)(c.wsb + WS_SSQ);
    c.row0 = (size_t)c.g * c.TOKG; return c;
}
#define ARGP(i) ((const GAS float*)ldptr(ptab, (i)))
__global__ void __launch_bounds__(512, 2) fwd(Args a) {
    extern __shared__ __attribute__((aligned(16))) unsigned char lds[];
    cg::grid_group grid = cg::this_grid();
    LAS unsigned long long* ptab = (LAS unsigned long long*)((LAS unsigned char*)lds + PTAB_OFF);
    if (threadIdx.x == 0) {
#pragma unroll
        for (int i = 0; i < 13; ++i) ptab[i] = (unsigned long long)a.in[i];
        ptab[13] = (unsigned long long)a.out; ptab[14] = (unsigned long long)a.ws; ptab[15] = (unsigned long long)a.ngroups; ptab[16] = 0ull;
        ((LAS unsigned*)(ptab + 24))[0] = 0u; ((LAS unsigned*)(ptab + 24))[1] = 0u; }
    __syncthreads();
    (void)xcd_barrier_post((unsigned*)(ldptr(ptab, 14) + WS_BAR), (volatile LAS unsigned*)(ptab + 24));
#define GSYNC() do { XcdBarrier b_; b_.bar = (unsigned*)(ldptr(ptab, 14) + WS_BAR); b_.x = xb_xcc_id(); b_.st = (volatile LAS unsigned*)(ptab + 24); xcd_barrier(b_); } while (0)
    for (;;) {
        if ((int)ldptr(ptab, 16) < (int)ldptr(ptab, 15)) {
            const Ctx c = load_ctx(ptab);
            if (c.g == 0) {
                LAS float* scr = (LAS float*)((LAS unsigned char*)lds + c.wave * 16384);
                constexpr int I_IN = (D / 64) * (PW / 32), I_OUT = (MW / 64) * (D / 32);
                for (int it = c.gw; it < I_IN + I_OUT; it += c.ngw) {
                    if (it < I_IN) transpose_item(ARGP(2), D, PW, ARGP(1), c.Wt_in, scr, it, c.lane, 1);
                    else transpose_item(ARGP(6), MW, D, nullptr, c.Wt_out, scr, it - I_IN, c.lane, 0);
                }
            }
            init_rows(ARGP(0) + c.row0 * D, c.xres + c.row0 * D, c.ssq + c.row0 * 16, c.TOKG, c.gw, c.ngw, c.lane);
        }
        if ((int)ldptr(ptab, 16) == 0) grid.sync();
        else if ((int)ldptr(ptab, 16) < (int)ldptr(ptab, 15)) GSYNC();
        {
            const Ctx c = load_ctx(ptab);
            LAS float* qkl = (LAS float*)((LAS unsigned char*)lds + 131072);
            if (c.even && c.tid < 128) qkl[c.tid] = (c.tid < 64) ? ARGP(4)[c.j * 64 + c.tid] * (0.125f * 1.4426950408889634f) : ARGP(5)[c.j * 64 + c.tid - 64];
            pg8::Gemm gm{(const pg8::bf16_t*)(c.xres + c.row0 * D), (const pg8::bf16_t*)c.Wt_in, c.TOKG, PW, D}; pg8::StaticOrder S; S.init(c.TOKG, PW, c.G, c.bid);
            LAS float* rsl = qkl + 128;
            { pg8::Unit u0; if (S.next(0, u0) && c.tid < 256) { const GAS f32x4* pp = (const GAS f32x4*)(c.ssq + (c.row0 + (size_t)u0.pm * 256 + c.tid) * 16);
                const f32x4 a0 = pp[0], a1 = pp[1], a2 = pp[2], a3 = pp[3]; const float s = ((a0.x + a0.y) + (a0.z + a0.w)) + ((a1.x + a1.y) + (a1.z + a1.w)) + ((a2.x + a2.y) + (a2.z + a2.w)) + ((a3.x + a3.y) + (a3.z + a3.w));
                rsl[c.tid] = rsqrtf(s * (1.f / D) + EPS); } }
            __syncthreads();
            EpiProj E{c.proj, c.even ? 0 : 1, c.lbtab, qkl, rsl};
            pg8::gemm_phase<EpiProj, pg8::StaticOrder, true, true>((PG8_LAS unsigned char*)lds, gm, S, E);
            if (c.g == 0 && c.layer > 0) {
                const GAS float* w_out = (c.even ? ARGP(6) : ARGP(12)) + (size_t)c.j * MW * D;
                LAS float* scr = (LAS float*)((LAS unsigned char*)lds + c.wave * 16384);
                for (int it = c.gw; it < (MW / 64) * (D / 32); it += c.ngw) transpose_item(w_out, MW, D, nullptr, c.Wt_out, scr, it, c.lane, 0);
            }
        }
        GSYNC();
        {
            const Ctx c = load_ctx(ptab);
            if (__builtin_amdgcn_readfirstlane(c.tid) >= 256) __builtin_amdgcn_s_setprio(1);
            if (c.even) {
                attn_mfma(c.proj, c.xn, (GAS float*)(c.xn + (size_t)c.TOKG * 3072), c.TOKG, ARGP(4) + c.j * 64, ARGP(5) + c.j * 64, ARGP(7), lds, c.tid, c.lane, c.wave, c.bid, c.G);
            } else {
                hgrn_r1(c.proj, (GAS float*)c.xn, (GAS float*)(c.wsb + WS_RD), c.TOKG, lds, c.tid, c.lane, c.wave, c.bid, c.G);
            }
            __builtin_amdgcn_s_setprio(0);
        }
        GSYNC();
        {
            const Ctx c = load_ctx(ptab);
            if (__builtin_amdgcn_readfirstlane(c.tid) >= 256) __builtin_amdgcn_s_setprio(1);
            if (c.even) merge_conv(c.proj, c.xn, (const GAS float*)(c.xn + (size_t)c.TOKG * 3072), c.ybuf, c.TOKG, ARGP(3) + c.j * 3 * 1024, c.lane, c.gw, c.ngw);
            else hgrn_r3(c.proj, (const GAS float*)c.xn, (const GAS float*)(c.wsb + WS_RD), c.ybuf, c.TOKG, ARGP(11) + c.j * MW, lds, c.tid, c.lane, c.wave, c.bid, c.G);
            __builtin_amdgcn_s_setprio(0);
        }
        GSYNC();
        {
            const Ctx c = load_ctx(ptab);
            pg8::Gemm gm{(const pg8::bf16_t*)c.ybuf, (const pg8::bf16_t*)c.Wt_out, c.TOKG, D, MW}; pg8::StaticOrder S; S.init(c.TOKG, D, c.G, c.bid);
            EpiRes E{ARGP(0) + c.row0 * D, c.xres + c.row0 * D, (GAS float*)ARGP(13) + c.row0 * D, c.ssq + c.row0 * 16, c.layer == 0 ? 1 : 0, c.layer == 3 ? 1 : 0};
            pg8::gemm_phase<EpiRes, pg8::StaticOrder, true, true>((PG8_LAS unsigned char*)lds, gm, S, E);
            if (c.g == c.NG - 1 && c.layer < 3) {
                const int nl = c.layer + 1, nj = nl >> 1, nev = !(nl & 1);
                const GAS float* w_in = (nev ? ARGP(2) : ARGP(9)) + (size_t)nj * D * PW; const GAS float* ln = (nev ? ARGP(1) : ARGP(8)) + (size_t)nj * D;
                LAS float* scr = (LAS float*)((LAS unsigned char*)lds + c.wave * 16384);
                for (int it = c.gw; it < (D / 64) * (PW / 32); it += c.ngw) transpose_item(w_in, D, PW, ln, c.Wt_in, scr, it, c.lane, nev);
                if (!nev && c.bid == 0) { const GAS float* lbp = ARGP(10);
                    for (int col = c.tid; col < 2048; col += 512) c.lbtab[col] = (nj == 0) ? 0.f : 1.f / (1.f + expf(lbp[col] - lbp[2048 + col])); }
            }
        }
        { const int st_ = (int)ldptr(ptab, 16), ng_ = (int)ldptr(ptab, 15); if (st_ % ng_ == ng_ - 1) GSYNC(); }
        const int step = (int)ldptr(ptab, 16), nsteps = 4 * (int)ldptr(ptab, 15);
        __syncthreads();
        if (threadIdx.x == 0) ptab[16] = (unsigned long long)(step + 1);
        __syncthreads();
        if (step + 1 >= nsteps) break;
    }
}

extern "C" void kernel_launch(void* const* d_in, const int* in_sizes, int n_in, void* d_out, int out_size, void* d_ws, size_t ws_size, hipStream_t stream) {
    static int grid = 0;
    if (grid == 0) {
        int dev = 0, cus = 0, per_cu = 0;
        if (hipGetDevice(&dev) != hipSuccess || hipDeviceGetAttribute(&cus, hipDeviceAttributeMultiprocessorCount, dev) != hipSuccess) { fprintf(stderr, "kernel_launch: device query failed\n"); grid = -1; return; }
        if (hipFuncSetAttribute((const void*)fwd, hipFuncAttributeMaxDynamicSharedMemorySize, LDS_BYTES) != hipSuccess) { fprintf(stderr, "kernel_launch: hipFuncSetAttribute failed\n"); grid = -1; return; }
        if (hipOccupancyMaxActiveBlocksPerMultiprocessor(&per_cu, (const void*)fwd, 512, LDS_BYTES) != hipSuccess || per_cu < 1) fprintf(stderr, "kernel_launch: occupancy query reports %d\n", per_cu);
        (void)hipGetLastError();
        grid = cus;
    }
    if (grid < 0) return;
    Args a{};
    for (int i = 0; i < 13; ++i) a.in[i] = (const float*)d_in[i];
    a.out = (float*)d_out; a.ws = (unsigned char*)d_ws;
    a.ngroups = (ws_size >= (size_t)508 * MiB) ? 2 : 4;
    if (hipMemsetAsync((char*)d_ws + WS_BAR, 0, 16384, stream) != hipSuccess) { fprintf(stderr, "kernel_launch: memset failed\n"); return; }
    void* args[] = {&a};
    hipError_t e = hipLaunchCooperativeKernel((const void*)fwd, dim3(grid), dim3(512), args, LDS_BYTES, stream);
    if (e != hipSuccess) fprintf(stderr, "kernel_launch: cooperative launch failed: %s (grid %d)\n", hipGetErrorString(e), grid);
}
```

```cpp
#include <hip/hip_runtime.h>
#include <hip/hip_cooperative_groups.h>
#include <cstdio>
#include <cstdint>
namespace cg = cooperative_groups;
namespace pg8 {
#define PG8_LAS __attribute__((address_space(3)))
typedef unsigned short bf16_t;
typedef short bf16x8 __attribute__((ext_vector_type(8)));
typedef float f32x4 __attribute__((ext_vector_type(4)));
typedef unsigned u32x4 __attribute__((ext_vector_type(4)));
constexpr int BM = 256, BK = 64, HALF = 128, HTB = HALF * BK * 2  , STAGE_BYTES = 8 * HTB, NXCD = 8, WGM = 8;

__host__ __device__ __forceinline__ int lds_byte(int r, int c) { const int st = (r >> 4) * 2 + (c >> 5), rr = r & 15, cc = c & 31, ob = rr * 64 + cc * 2; return st * 1024 + (ob ^ (((ob >> 9) & 1) << 5)); }
__host__ __device__ __forceinline__ void stage_rc(int b, int& R, int& C) { const int st = b / 1024, sb = b % 1024, swz = sb ^ (((sb >> 9) & 1) << 5); R = (st >> 1) * 16 + swz / 64; C = (st & 1) * 32 + (swz % 64) / 2; }
__host__ __device__ __forceinline__ int perm32(int rho) { const int n = rho >> 4, i = rho & 15; return 8 * (i >> 2) + 4 * n + (i & 3); }

struct Unit { int pm, pn; };
struct Gemm { const bf16_t* A; const bf16_t* Bt; int M, N, K; };

struct StaticOrder {
    int nM, nN, nwg, G, c;
    __host__ __device__ void init(int M, int N, int G_, int c_) { nM = M / BM; nN = N / BM; nwg = nM * nN; G = G_; c = c_; }
    __host__ __device__ bool next(int i, Unit& u) const {
        const long L = (long)i * G + c; if (L >= nwg) return false;
        int wgid = (int)L; { const int q = nwg / NXCD, r = nwg % NXCD, xcd = wgid % NXCD, off = wgid / NXCD; wgid = (xcd < r ? xcd * (q + 1) : r * (q + 1) + (xcd - r) * q) + off; }
        const int nig = WGM * nN, gid = wgid / nig, fm = gid * WGM, gsz = (nM - fm) < WGM ? (nM - fm) : WGM;
        u.pm = fm + ((wgid % nig) % gsz); u.pn = (wgid % nig) / gsz; return true;
    }
    __device__ __forceinline__ void a_ready(const Unit&) const {}
    __device__ __forceinline__ void done(const Unit&) const {}
};

__device__ __forceinline__ unsigned cvt_pk_bf16(float lo, float hi) { unsigned r; asm volatile("v_cvt_pk_bf16_f32 %0, %1, %2" : "=v"(r) : "v"(lo), "v"(hi)); return r; }
template <class Epi, class Sched, bool ALIGN_EPI = false, bool SP2 = false>
__device__ __forceinline__ void gemm_phase(PG8_LAS unsigned char* lds, const Gemm g, const Sched& S, const Epi& E) {
    int tid_raw = threadIdx.x; asm volatile("" : "+v"(tid_raw)); const int tid = tid_raw, wid = __builtin_amdgcn_readfirstlane(tid >> 6), lane = tid & 63, wr = wid >> 2, wc = wid & 3, fr = lane & 15, fq = lane >> 4;
    const int K = g.K, nt = K / BK;
    unsigned voffA[2], voffB[2];
#pragma unroll
    for (int i = 0; i < 2; ++i) { int R, C; stage_rc(tid * 16 + i * 8192, R, C); const int Rb = Epi::PERM ? ((R & ~31) + perm32(R & 31)) : R;
        voffA[i] = (unsigned)(R * K + C) * 2u; voffB[i] = (unsigned)(Rb * K + C) * 2u; }
    const size_t kstep = (size_t)(BK * 2);
    const size_t hstep = (size_t)HALF * K * 2;
    const size_t tstep = 2 * hstep;
    const unsigned ldsw = (unsigned)wid * 1024u;
    const int aoff = lds_byte(wr * 64 + fr, fq * 8), boff = lds_byte(wc * 32 + fr, fq * 8);
#define PG8_SA(b, h) (((b) * 2 + (h)) * HTB)
#define PG8_SB(b, h) ((4 + (b) * 2 + (h)) * HTB)
#define PG8_STAGE(bufoff, gbase, voff) do { _Pragma("unroll") for (int _i = 0; _i < 2; ++_i) \
        __builtin_amdgcn_global_load_lds((const unsigned*)((const char*)(gbase) + (voff)[_i]), (PG8_LAS unsigned*)(lds + (bufoff) + ldsw + _i * 8192), 16, 0, 0); } while (0)
#define PG8_LDA(dst, b, h) do { _Pragma("unroll") for (int m = 0; m < 4; ++m) _Pragma("unroll") for (int k = 0; k < 2; ++k) dst[m][k] = *(const PG8_LAS bf16x8*)(lds + PG8_SA(b, h) + aoff + m * 2048 + k * 1024); } while (0)
#define PG8_LDB(dst, b, h) do { _Pragma("unroll") for (int n = 0; n < 2; ++n) _Pragma("unroll") for (int k = 0; k < 2; ++k) dst[n][k] = *(const PG8_LAS bf16x8*)(lds + PG8_SB(b, h) + boff + n * 2048 + k * 1024); } while (0)
#define PG8_MMA(ai, bj, At, Bt) do { __builtin_amdgcn_s_setprio(1); _Pragma("unroll") for (int m = 0; m < 4; ++m) _Pragma("unroll") for (int n = 0; n < 2; ++n) _Pragma("unroll") for (int k = 0; k < 2; ++k) \
        acc[ai][bj][m][n] = __builtin_amdgcn_mfma_f32_16x16x32_bf16(Bt[n][k], At[m][k], acc[ai][bj][m][n], 0, 0, 0); __builtin_amdgcn_s_setprio(0); } while (0)
#define PG8_WAIT_V(n) asm volatile("s_waitcnt vmcnt(" #n ")" ::: "memory")
#define PG8_WAIT_L(n) asm volatile("s_waitcnt lgkmcnt(" #n ")" ::: "memory")
#define PG8_WAIT_VR(rx) do { static_assert(Epi::NVM == 0 || Epi::NVM == 16, "relaxed wait is written for 16 epilogue stores"); const int rx_ = __builtin_amdgcn_readfirstlane(rx); asm volatile("s_cmp_lg_u32 %0, 0\n\ts_cbranch_scc1 .Lrelax%=\n\ts_waitcnt vmcnt(8)\n.Lrelax%=:\n\ts_waitcnt vmcnt(24)" :: "s"(rx_) : "scc", "memory"); } while (0)
#define PG8_BAR __builtin_amdgcn_s_barrier()
#define PG8_SCHED __builtin_amdgcn_sched_barrier(0)
    Unit cur, nxt; int ui = 0;
    if (!S.next(0, cur)) return;
    f32x4 acc[2][2][4][2];
#pragma unroll
    for (int a = 0; a < 2; ++a)
#pragma unroll
        for (int b = 0; b < 2; ++b)
#pragma unroll
            for (int m = 0; m < 4; ++m)
#pragma unroll
                for (int n = 0; n < 2; ++n) acc[a][b][m][n] = (f32x4){0.f, 0.f, 0.f, 0.f};
    bf16x8 At[4][2], B0[2][2], B1[2][2];
    const char* cA = (const char*)g.A + (size_t)cur.pm * tstep; const char* cB = (const char*)g.Bt + (size_t)cur.pn * tstep;
    S.a_ready(cur);
    if constexpr (SP2) {
        PG8_STAGE(PG8_SB(0, 0), cB, voffB); PG8_STAGE(PG8_SB(0, 1), cB + hstep, voffB); PG8_STAGE(PG8_SA(0, 0), cA, voffA); PG8_STAGE(PG8_SA(0, 1), cA + hstep, voffA);
        if (wr == 1) PG8_BAR;
        PG8_WAIT_V(2); PG8_BAR;
        PG8_STAGE(PG8_SB(1, 0), cB + kstep, voffB); PG8_STAGE(PG8_SA(1, 0), cA + kstep, voffA); PG8_STAGE(PG8_SB(1, 1), cB + hstep + kstep, voffB);
        PG8_WAIT_V(6); PG8_BAR;
    } else {
        PG8_STAGE(PG8_SB(0, 0), cB, voffB); PG8_STAGE(PG8_SA(0, 0), cA, voffA); PG8_STAGE(PG8_SB(0, 1), cB + hstep, voffB); PG8_STAGE(PG8_SA(0, 1), cA + hstep, voffA);
        if (wr == 1) PG8_BAR;
        PG8_WAIT_V(4); PG8_BAR;
        PG8_STAGE(PG8_SB(1, 0), cB + kstep, voffB); PG8_STAGE(PG8_SA(1, 0), cA + kstep, voffA); PG8_STAGE(PG8_SB(1, 1), cB + hstep + kstep, voffB);
        PG8_WAIT_V(6); PG8_BAR;
    }
    for (;;) {
        const bool has_next = S.next(ui + 1, nxt);
        const char* nA = has_next ? (const char*)g.A + (size_t)nxt.pm * tstep : cA; const char* nB = has_next ? (const char*)g.Bt + (size_t)nxt.pn * tstep : cB;
        for (int t = 0; t < nt; t += 2) {
            const bool last = (t == nt - 2);
            const char* a1 = cA + (size_t)(t + 1) * kstep;
            const char* a2 = last ? nA : cA + (size_t)(t + 2) * kstep; const char* b2 = last ? nB : cB + (size_t)(t + 2) * kstep;
            const char* a3 = a2 + kstep; const char* b3 = b2 + kstep;
            if (last && has_next) S.a_ready(nxt);
            if constexpr (SP2) {
            PG8_LDB(B0, 0, 0); PG8_LDB(B1, 0, 1); PG8_SCHED; PG8_LDA(At, 0, 0); PG8_STAGE(PG8_SA(1, 1), a1 + hstep, voffA);
            PG8_WAIT_VR((Epi::NVM > 0 && ui > 0 && t == 0) ? 1 : 0);
            PG8_WAIT_L(0); PG8_BAR; PG8_MMA(0, 0, At, B0); PG8_MMA(0, 1, At, B1); PG8_BAR; PG8_SCHED;
            PG8_LDA(At, 0, 1); PG8_STAGE(PG8_SB(0, 0), b2, voffB); PG8_STAGE(PG8_SB(0, 1), b2 + hstep, voffB); PG8_STAGE(PG8_SA(0, 0), a2, voffA);
            PG8_WAIT_VR((Epi::NVM > 0 && ui > 0 && t == 0) ? 1 : 0);
            PG8_WAIT_L(0); PG8_BAR; PG8_MMA(1, 0, At, B0); PG8_MMA(1, 1, At, B1); PG8_BAR; PG8_SCHED;
            PG8_LDB(B0, 1, 0); PG8_LDB(B1, 1, 1); PG8_SCHED; PG8_LDA(At, 1, 0); PG8_STAGE(PG8_SA(0, 1), a2 + hstep, voffA);
            PG8_WAIT_V(8); PG8_WAIT_L(0); PG8_BAR; PG8_MMA(0, 0, At, B0); PG8_MMA(0, 1, At, B1); PG8_BAR; PG8_SCHED;
            PG8_LDA(At, 1, 1); PG8_STAGE(PG8_SB(1, 0), b3, voffB); PG8_STAGE(PG8_SB(1, 1), b3 + hstep, voffB); PG8_STAGE(PG8_SA(1, 0), a3, voffA);
            PG8_WAIT_V(8); PG8_WAIT_L(0); PG8_BAR; PG8_MMA(1, 0, At, B0); PG8_MMA(1, 1, At, B1); PG8_BAR; PG8_SCHED;
            } else {
            PG8_LDB(B0, 0, 0); PG8_SCHED; PG8_LDA(At, 0, 0); PG8_STAGE(PG8_SA(1, 1), a1 + hstep, voffA);
            PG8_WAIT_L(8); PG8_BAR; PG8_WAIT_L(0); PG8_MMA(0, 0, At, B0); PG8_BAR; PG8_SCHED;
            PG8_LDB(B1, 0, 1); PG8_STAGE(PG8_SB(0, 0), b2, voffB);
            PG8_BAR; PG8_WAIT_L(0); PG8_MMA(0, 1, At, B1); PG8_BAR;
            PG8_LDA(At, 0, 1); PG8_STAGE(PG8_SA(0, 0), a2, voffA);
            PG8_BAR; PG8_WAIT_L(0); PG8_MMA(1, 0, At, B0); PG8_BAR; PG8_SCHED;
            PG8_STAGE(PG8_SB(0, 1), b2 + hstep, voffB);
            PG8_WAIT_V(6); PG8_BAR; PG8_MMA(1, 1, At, B1); PG8_BAR;
            PG8_LDB(B0, 1, 0); PG8_SCHED; PG8_LDA(At, 1, 0); PG8_STAGE(PG8_SA(0, 1), a2 + hstep, voffA);
            PG8_WAIT_L(8); PG8_BAR; PG8_WAIT_L(0); PG8_MMA(0, 0, At, B0); PG8_BAR; PG8_SCHED;
            PG8_LDB(B1, 1, 1); PG8_STAGE(PG8_SB(1, 0), b3, voffB);
            PG8_BAR; PG8_WAIT_L(0); PG8_MMA(0, 1, At, B1); PG8_BAR;
            PG8_LDA(At, 1, 1); PG8_STAGE(PG8_SA(1, 0), a3, voffA);
            PG8_BAR; PG8_WAIT_L(0); PG8_MMA(1, 0, At, B0); PG8_BAR; PG8_SCHED;
            PG8_STAGE(PG8_SB(1, 1), b3 + hstep, voffB);
            PG8_WAIT_V(6); PG8_BAR; PG8_MMA(1, 1, At, B1); PG8_BAR;
            }
        }
        if constexpr (ALIGN_EPI) { if (wr == 0) PG8_BAR; }
        if constexpr (!Epi::AFTER_DRAIN) { E(acc, cur, wr, wc, fr, fq); S.done(cur); }
        if (!has_next) break;
#pragma unroll
        for (int a = 0; a < 2; ++a)
#pragma unroll
            for (int b = 0; b < 2; ++b)
#pragma unroll
                for (int m = 0; m < 4; ++m)
#pragma unroll
                    for (int n = 0; n < 2; ++n) acc[a][b][m][n] = (f32x4){0.f, 0.f, 0.f, 0.f};
        cur = nxt; cA = nA; cB = nB; ++ui;
        if constexpr (ALIGN_EPI) { if (wr == 1) PG8_BAR; }
    }
    PG8_WAIT_V(0);
    if constexpr (!ALIGN_EPI) { if (wr == 0) PG8_BAR; }
    PG8_BAR;
    if constexpr (Epi::AFTER_DRAIN) { E.fused(acc, cur, wr, wc, fr, fq, lds, wid, lane); S.done(cur); }
#undef PG8_SA
#undef PG8_SB
#undef PG8_STAGE
#undef PG8_LDA
#undef PG8_LDB
#undef PG8_MMA
#undef PG8_WAIT_V
#undef PG8_WAIT_L
#undef PG8_WAIT_VR
#undef PG8_BAR
#undef PG8_SCHED
}
}

constexpr int D = 1024, SEQ = 8192, NBATCH = 4, NTOK = NBATCH * SEQ, PW = 8192, MW = 2048;
constexpr float EPS = 1e-6f;
constexpr size_t MiB = 1u << 20;
constexpr size_t WS_WIN = 0, WS_WOUT = 16 * MiB, WS_MISC = 20 * MiB, WS_RD = 20 * MiB + 65536, WS_BAR = 20 * MiB + 524288, WS_SSQ = 21 * MiB, WS_PROJ = 24 * MiB;
constexpr size_t AUX_PER_TOK = 6400;
constexpr int LDS_BYTES = 159744, PTAB_OFF = 155648;
typedef unsigned short bf16;
typedef unsigned v4u __attribute__((ext_vector_type(4)));
typedef unsigned v2u __attribute__((ext_vector_type(2)));
typedef float f32x4 __attribute__((ext_vector_type(4)));
#define LAS __attribute__((address_space(3)))
#define GAS __attribute__((address_space(1)))

__device__ __forceinline__ float bf2f(unsigned short b) { return __uint_as_float(((unsigned)b) << 16); }
__device__ __forceinline__ unsigned f2bf(float f) { unsigned u = __float_as_uint(f); return (u + 0x7fffu + ((u >> 16) & 1u)) >> 16; }
typedef __bf16 bf16x2_t __attribute__((ext_vector_type(2)));
typedef float f32x2_t __attribute__((ext_vector_type(2)));
__device__ __forceinline__ unsigned pk2(float lo, float hi) { const f32x2_t v = {lo, hi}; const bf16x2_t b = __builtin_convertvector(v, bf16x2_t); return __builtin_bit_cast(unsigned, b); }
__device__ __forceinline__ float wave_sum(float v) {
#pragma unroll
    for (int o = 1; o < 64; o <<= 1) v += __shfl_xor(v, o);
    return v;
}
__device__ __forceinline__ float wave_max(float v) {
#pragma unroll
    for (int o = 1; o < 64; o <<= 1) v = fmaxf(v, __shfl_xor(v, o));
    return v;
}
__device__ __forceinline__ float silu_f(float x) { return x * __builtin_amdgcn_rcpf(1.f + __builtin_amdgcn_exp2f(x * -1.4426950408889634f)); }
__device__ __forceinline__ void unpack8(const v4u w, float (&f)[8]) {
    f[0] = __uint_as_float(w.x << 16); f[1] = __uint_as_float(w.x & 0xffff0000u);
    f[2] = __uint_as_float(w.y << 16); f[3] = __uint_as_float(w.y & 0xffff0000u);
    f[4] = __uint_as_float(w.z << 16); f[5] = __uint_as_float(w.z & 0xffff0000u);
    f[6] = __uint_as_float(w.w << 16); f[7] = __uint_as_float(w.w & 0xffff0000u);
}

struct EpiProj {
    static constexpr bool PERM = true, AFTER_DRAIN = false; static constexpr int NVM = 16;
    GAS pg8::bf16_t* O; int odd; const GAS float* lb; const LAS float* qk; const LAS float* rstd;
    __device__ __forceinline__ void operator()(const pg8::f32x4 (&acc)[2][2][4][2], const pg8::Unit& u, int wr, int wc, int fr, int fq) const {
        const int row0 = u.pm * 256 + wr * 64 + fr, col0 = u.pn * 256 + wc * 32 + 8 * fq;
        float rsr[2][4];
#pragma unroll
        for (int ai = 0; ai < 2; ++ai)
#pragma unroll
            for (int m = 0; m < 4; ++m) rsr[ai][m] = rstd[wr * 64 + fr + ai * 128 + m * 16];
        if (!odd && u.pn >= 12 && u.pn < 20) {
            const LAS float* gt = qk + ((u.pn >= 16) ? 64 : 0) + 8 * fq;
            pg8::f32x4 gv[2][2];
#pragma unroll
            for (int bj = 0; bj < 2; ++bj)
#pragma unroll
                for (int n = 0; n < 2; ++n) gv[bj][n] = *(const LAS pg8::f32x4*)(gt + 32 * bj + 4 * n);
            const int ncol = u.pn * 256 + 64 * wc + 8 * fq;
#pragma unroll
            for (int ai = 0; ai < 2; ++ai)
#pragma unroll
                for (int m = 0; m < 4; ++m) { float ss = 0.f;
#pragma unroll
                    for (int bj = 0; bj < 2; ++bj)
#pragma unroll
                        for (int n = 0; n < 2; ++n) { const pg8::f32x4 v = acc[ai][bj][m][n] * rsr[ai][m]; ss += (v[0] * v[0] + v[1] * v[1]) + (v[2] * v[2] + v[3] * v[3]); }
                    ss += __shfl_xor(ss, 16); ss += __shfl_xor(ss, 32);
                    const float rs = rsqrtf(ss * (1.f / 64.f) + EPS);
                    GAS pg8::bf16_t* rowp = O + (size_t)(row0 + ai * 128 + m * 16) * PW + ncol;
#pragma unroll
                    for (int bj = 0; bj < 2; ++bj) { const pg8::f32x4 v0 = acc[ai][bj][m][0] * (rs * rsr[ai][m]) * gv[bj][0], v1 = acc[ai][bj][m][1] * (rs * rsr[ai][m]) * gv[bj][1];
                        pg8::u32x4 w; w.x = pg8::cvt_pk_bf16(v0[0], v0[1]); w.y = pg8::cvt_pk_bf16(v0[2], v0[3]); w.z = pg8::cvt_pk_bf16(v1[0], v1[1]); w.w = pg8::cvt_pk_bf16(v1[2], v1[3]);
                        *(GAS pg8::u32x4*)(rowp + 32 * bj) = w; } }
            return;
        }
        int act;
        if (!odd) act = (u.pn >= 24) ? 1 : 0; else act = (u.pn < 8) ? 1 : (u.pn < 16 ? 2 : (u.pn < 24 ? 0 : 1));
        pg8::f32x4 lbv[2][2];
#pragma unroll
        for (int bj = 0; bj < 2; ++bj)
#pragma unroll
            for (int n = 0; n < 2; ++n) lbv[bj][n] = (act == 2) ? *(const GAS pg8::f32x4*)(lb + (col0 - 2048) + bj * 128 + 4 * n) : (pg8::f32x4){0.f, 0.f, 0.f, 0.f};
#pragma unroll
        for (int ai = 0; ai < 2; ++ai)
#pragma unroll
            for (int m = 0; m < 4; ++m) { GAS pg8::bf16_t* rowp = O + (size_t)(row0 + ai * 128 + m * 16) * PW + col0;
#pragma unroll
                for (int bj = 0; bj < 2; ++bj) { pg8::f32x4 v0 = acc[ai][bj][m][0] * rsr[ai][m], v1 = acc[ai][bj][m][1] * rsr[ai][m];
                    if (act == 1) {
#pragma unroll
                        for (int e = 0; e < 4; ++e) { v0[e] = silu_f(v0[e]); v1[e] = silu_f(v1[e]); } }
                    else if (act == 2) {
#pragma unroll
                        for (int e = 0; e < 4; ++e) { const float s0 = __builtin_amdgcn_rcpf(1.f + __builtin_amdgcn_exp2f(v0[e] * -1.4426950408889634f)), s1 = __builtin_amdgcn_rcpf(1.f + __builtin_amdgcn_exp2f(v1[e] * -1.4426950408889634f));
                            v0[e] = __builtin_amdgcn_logf(lbv[bj][0][e] + (1.f - lbv[bj][0][e]) * s0); v1[e] = __builtin_amdgcn_logf(lbv[bj][1][e] + (1.f - lbv[bj][1][e]) * s1);     } }
                    pg8::u32x4 w; w.x = pg8::cvt_pk_bf16(v0[0], v0[1]); w.y = pg8::cvt_pk_bf16(v0[2], v0[3]); w.z = pg8::cvt_pk_bf16(v1[0], v1[1]); w.w = pg8::cvt_pk_bf16(v1[2], v1[3]);
                    *(GAS pg8::u32x4*)(rowp + bj * 128) = w; } }
    }
};
struct EpiRes {
    static constexpr bool PERM = true, AFTER_DRAIN = false; static constexpr int NVM = 0;
    const GAS float* base32; GAS bf16* xres; GAS float* out32; GAS float* ssq; int first, last;
    __device__ __forceinline__ void operator()(const pg8::f32x4 (&acc)[2][2][4][2], const pg8::Unit& u, int wr, int wc, int fr, int fq) const {
        const int row0 = u.pm * 256 + wr * 64 + fr, col0 = u.pn * 256 + wc * 32 + 8 * fq;
#pragma unroll
        for (int ai = 0; ai < 2; ++ai)
#pragma unroll
            for (int m = 0; m < 4; ++m) { const int row = row0 + ai * 128 + m * 16; const size_t off = (size_t)row * D + col0; float ss = 0.f;
#pragma unroll
                for (int bj = 0; bj < 2; ++bj) { const size_t o = off + bj * 128; pg8::f32x4 b0, b1;
                    if (first) { b0 = *(const GAS pg8::f32x4*)(base32 + o); b1 = *(const GAS pg8::f32x4*)(base32 + o + 4); }
                    else { const v4u w = *(const GAS v4u*)(xres + o);
                        b0 = (pg8::f32x4){__uint_as_float(w.x << 16), __uint_as_float(w.x & 0xffff0000u), __uint_as_float(w.y << 16), __uint_as_float(w.y & 0xffff0000u)};
                        b1 = (pg8::f32x4){__uint_as_float(w.z << 16), __uint_as_float(w.z & 0xffff0000u), __uint_as_float(w.w << 16), __uint_as_float(w.w & 0xffff0000u)}; }
                    const pg8::f32x4 x0 = b0 + acc[ai][bj][m][0], x1 = b1 + acc[ai][bj][m][1];
                    if (last) { *(GAS pg8::f32x4*)(out32 + o) = x0; *(GAS pg8::f32x4*)(out32 + o + 4) = x1; }
                    else { v4u w; w.x = pg8::cvt_pk_bf16(x0[0], x0[1]); w.y = pg8::cvt_pk_bf16(x0[2], x0[3]); w.z = pg8::cvt_pk_bf16(x1[0], x1[1]); w.w = pg8::cvt_pk_bf16(x1[2], x1[3]); *(GAS v4u*)(xres + o) = w;
                        const float r0 = __uint_as_float(w.x << 16), r1 = __uint_as_float(w.x & 0xffff0000u), r2 = __uint_as_float(w.y << 16), r3 = __uint_as_float(w.y & 0xffff0000u);
                        const float r4 = __uint_as_float(w.z << 16), r5 = __uint_as_float(w.z & 0xffff0000u), r6 = __uint_as_float(w.w << 16), r7 = __uint_as_float(w.w & 0xffff0000u);
                        ss += ((r0 * r0 + r1 * r1) + (r2 * r2 + r3 * r3)) + ((r4 * r4 + r5 * r5) + (r6 * r6 + r7 * r7)); } }
                if (!last) { ss += __shfl_xor(ss, 16); ss += __shfl_xor(ss, 32); if (fq == 0) ssq[(size_t)row * 16 + u.pn * 4 + wc] = ss; } }
    }
};

__device__ __forceinline__ void transpose_item(const GAS float* W, int K, int N, const GAS float* gain, GAS bf16* WT, LAS float* scr, int item, int lane, int remap) {
    const int nblk = N / 32, kb = item / nblk, nb = item % nblk, k0 = 64 * kb, n0 = 32 * nb;
    int ns = n0;
    if (remap && n0 >= 3072 && n0 < 5120) { const int T = (n0 - 3072) >> 8, rho = (n0 - 3072) & 255; ns = 3072 + 256 * T + 64 * ((rho >> 5) & 3) + 32 * (rho >> 7); }
#pragma unroll 8
    for (int i = 0; i < 32; ++i) { const int kk = 2 * i + (lane >> 5); float w = W[(size_t)(k0 + kk) * N + ns + (lane & 31)]; if (gain) w *= gain[k0 + kk]; scr[kk * 33 + (lane & 31)] = w; }
    asm volatile("s_waitcnt lgkmcnt(0)" ::: "memory");
    const int c = lane & 7;
#pragma unroll
    for (int j = 0; j < 4; ++j) { const int n = (lane >> 3) + 8 * j; const LAS float* s = scr + (8 * c) * 33 + n;
        v4u o; o.x = pk2(s[0 * 33], s[1 * 33]); o.y = pk2(s[2 * 33], s[3 * 33]); o.z = pk2(s[4 * 33], s[5 * 33]); o.w = pk2(s[6 * 33], s[7 * 33]);
        *(GAS v4u*)(WT + (size_t)(n0 + n) * K + k0 + 8 * c) = o; }
    asm volatile("s_waitcnt lgkmcnt(0)" ::: "memory");
}
__device__ __forceinline__ void init_rows(const GAS float* x, GAS bf16* xres, GAS float* ssq, int nrows, int gw, int ngw, int lane) {
    for (int m0 = 2 * gw; m0 < nrows; m0 += 2 * ngw) {
        f32x4 v[2][4];
#pragma unroll
        for (int q = 0; q < 2; ++q) { const GAS f32x4* xr = (const GAS f32x4*)(x + (size_t)(m0 + q) * D) + lane;
#pragma unroll
            for (int j = 0; j < 4; ++j) v[q][j] = xr[64 * j]; }
#pragma unroll
        for (int q = 0; q < 2; ++q) { float s = 0.f; GAS unsigned long long* o8 = (GAS unsigned long long*)(xres + (size_t)(m0 + q) * D) + lane;
#pragma unroll
            for (int j = 0; j < 4; ++j) { const unsigned w0 = pk2(v[q][j].x, v[q][j].y), w1 = pk2(v[q][j].z, v[q][j].w); o8[64 * j] = (unsigned long long)w0 | ((unsigned long long)w1 << 32);
                const float a0 = __uint_as_float(w0 << 16), a1 = __uint_as_float(w0 & 0xffff0000u), a2 = __uint_as_float(w1 << 16), a3 = __uint_as_float(w1 & 0xffff0000u); s += (a0 * a0 + a1 * a1) + (a2 * a2 + a3 * a3); }
            s = wave_sum(s);
            if (lane < 16) ssq[(size_t)(m0 + q) * 16 + lane] = (lane == 0) ? s : 0.f; }
    }
}

typedef short bf16x8 __attribute__((ext_vector_type(8)));
typedef float f32x16 __attribute__((ext_vector_type(16)));
__device__ __forceinline__ unsigned pkbf(float lo, float hi) { const f32x2_t v = {lo, hi}; const bf16x2_t b = __builtin_convertvector(v, bf16x2_t); return __builtin_bit_cast(unsigned, b); }
constexpr int ATT_KS = 0, ATT_KSTR = 144, ATT_VT = 384 * 144, ATT_VSTR = 192, ATT_BIAS = ATT_VT + 384 * 192;
typedef short v4i16_t __attribute__((ext_vector_type(4)));
__device__ __forceinline__ void attn_mfma(const GAS bf16* proj, GAS bf16* part, GAS float* lse, int TOKG, const GAS float* qgain, const GAS float* kgain, const GAS float* rel_bias,
                                          unsigned char* lds, int tid, int lane, int wave, int bid, int G) {
    LAS unsigned char* L = (LAS unsigned char*)lds;
    const int nunits = (TOKG / SEQ) * 16 * 96;
    const int c = lane & 31, hh = lane >> 5, c8 = tid & 7, rp2 = tid >> 3;
    const int vtl = (4 * (lane >> 5) + ((lane & 15) >> 2)) * ATT_VSTR + (16 * ((lane >> 4) & 1) + 4 * (lane & 3)) * 2;
    float kg[8];
#pragma unroll
    for (int e = 0; e < 8; ++e) kg[e] = kgain[c8 * 8 + e];
#define ATT_DEC(u_, P) const int P##i = (u_) & 31, P##pbh = (u_) >> 5, P##p = P##pbh % 3, P##bh = P##pbh / 3, P##h = P##bh & 15, P##bl = P##bh >> 4, P##dsh = 2 * P##p, \
        P##r = P##i & ((1 << P##dsh) - 1), P##m0 = (P##i >> P##dsh) * 256; const size_t P##rowb = (size_t)P##bl * SEQ;
    v4u kwr[6], vwr[6], qwr[4];
#define ATT_ISSUE(u_) do { ATT_DEC(u_, n_) \
        _Pragma("unroll") for (int it = 0; it < 6; ++it) { const int kk_ = 2 * rp2 + 128 * (it >> 1) + (it & 1); int m_ = n_m0 - 128 + kk_; m_ = m_ < 0 ? 0 : m_; \
            const GAS bf16* rp_ = proj + (n_rowb + ((size_t)m_ << n_dsh) + n_r) * PW + n_h * 64 + c8 * 8; kwr[it] = *(const GAS v4u*)(rp_ + 4096); vwr[it] = *(const GAS v4u*)(rp_ + 5120); } \
        { const GAS bf16* qp_ = proj + (n_rowb + ((size_t)(n_m0 + 32 * wave + c) << n_dsh) + n_r) * PW + 3072 + n_h * 64 + 8 * hh; \
          _Pragma("unroll") for (int s = 0; s < 4; ++s) qwr[s] = *(const GAS v4u*)(qp_ + 16 * s); } } while (0)
    LAS int* bkt = (LAS int*)(L + ATT_BIAS + 768);
    for (int e = tid; e < 3 * 129; e += 512) { const int pp = e / 129, dl = e - 129 * pp, dist = dl << (2 * pp); int bk;
        if (dist < 16) bk = dist; else { const float scl = logf((float)dist / 16.f) / logf(128.f); const int lg = 16 + (int)(scl * 16.f); bk = lg < 31 ? lg : 31; }
        bkt[e] = bk; }
    __syncthreads();
    if (bid < nunits) ATT_ISSUE(bid);
    for (int u = bid; u < nunits; u += G) {
        ATT_DEC(u, )
        __syncthreads();
        if (tid < 192) { float tv = -INFINITY; const int dl = 160 - tid;
            if (dl >= 0 && dl <= 128) tv = rel_bias[bkt[p * 129 + dl] * 16 + h] * 1.4426950408889634f;
            ((LAS float*)(L + ATT_BIAS))[tid] = tv; }
#pragma unroll
        for (int j = 0; j < 3; ++j) {
            const int kk0 = 2 * rp2 + 128 * j;
#pragma unroll
            for (int e2 = 0; e2 < 2; ++e2) { const int it = 2 * j + e2, kk = kk0 + e2;
                *(LAS v4u*)(L + ATT_KS + kk * ATT_KSTR + c8 * 16) = kwr[it];
                *(LAS v4u*)(L + ATT_VT + kk * ATT_VSTR + c8 * 16) = vwr[it]; }
        }
        const size_t orow = rowb + ((size_t)(m0 + 32 * wave + c) << dsh) + r;
        bf16x8 qf[4];
#pragma unroll
        for (int s = 0; s < 4; ++s) qf[s] = __builtin_bit_cast(bf16x8, qwr[s]);
        if (u + G < nunits) ATT_ISSUE(u + G);
        __syncthreads();
        f32x16 sc[5];
        const LAS float* tb = (const LAS float*)(L + ATT_BIAS) + (32 + 4 * hh - c);
        const int nskip = (m0 == 0 && wave < 4) ? 4 - wave : 0;
#pragma unroll
        for (int j = 0; j < 5; ++j) if (j >= nskip) {
#pragma unroll
            for (int e = 0; e < 16; ++e) sc[j][e] = tb[32 * j + (e & 3) + 8 * (e >> 2)];
#pragma unroll
            for (int s = 0; s < 4; ++s) { const bf16x8 kf = *(const LAS bf16x8*)(L + ATT_KS + (32 * wave + 32 * j + c) * ATT_KSTR + (16 * s + 8 * hh) * 2);
                sc[j] = __builtin_amdgcn_mfma_f32_32x32x16_bf16(kf, qf[s], sc[j], 0, 0, 0); } }
        float l = 0.f;
#pragma unroll
        for (int j = 0; j < 5; ++j) if (j >= nskip) {
#pragma unroll
            for (int e = 0; e < 16; ++e) { const float pe = __builtin_amdgcn_exp2f(sc[j][e]); sc[j][e] = pe; l += pe; } }
        l += __shfl_xor(l, 32);
        f32x16 o[2];
#pragma unroll
        for (int e = 0; e < 16; ++e) { o[0][e] = 0.f; o[1][e] = 0.f; }
#pragma unroll
        for (int j = 0; j < 5; ++j) if (j >= nskip)
#pragma unroll
            for (int s2 = 0; s2 < 2; ++s2) {
                v4u pw; pw.x = pkbf(sc[j][8 * s2 + 0], sc[j][8 * s2 + 1]); pw.y = pkbf(sc[j][8 * s2 + 2], sc[j][8 * s2 + 3]); pw.z = pkbf(sc[j][8 * s2 + 4], sc[j][8 * s2 + 5]); pw.w = pkbf(sc[j][8 * s2 + 6], sc[j][8 * s2 + 7]);
                const bf16x8 pf = __builtin_bit_cast(bf16x8, pw);
                const int kb = 32 * wave + 32 * j + 16 * s2;
#pragma unroll
                for (int dt = 0; dt < 2; ++dt) { const LAS unsigned char* vp = L + ATT_VT + vtl + kb * ATT_VSTR + 64 * dt;
                    const v4i16_t lo = __builtin_amdgcn_ds_read_tr16_b64_v4i16((LAS v4i16_t*)vp), hi = __builtin_amdgcn_ds_read_tr16_b64_v4i16((LAS v4i16_t*)(vp + 8 * ATT_VSTR));
                    bf16x8 vf; vf[0] = lo[0]; vf[1] = lo[1]; vf[2] = lo[2]; vf[3] = lo[3]; vf[4] = hi[0]; vf[5] = hi[1]; vf[6] = hi[2]; vf[7] = hi[3];
                    o[dt] = __builtin_amdgcn_mfma_f32_32x32x16_bf16(vf, pf, o[dt], 0, 0, 0); } }
        const float inv = __builtin_amdgcn_rcpf(l);
        GAS bf16* op = part + ((size_t)p * TOKG + orow) * 1024 + h * 64 + 4 * hh;
#pragma unroll
        for (int dt = 0; dt < 2; ++dt)
#pragma unroll
            for (int g4 = 0; g4 < 4; ++g4) { v2u w; w.x = pkbf(o[dt][4 * g4] * inv, o[dt][4 * g4 + 1] * inv); w.y = pkbf(o[dt][4 * g4 + 2] * inv, o[dt][4 * g4 + 3] * inv);
                *(GAS v2u*)(op + 32 * dt + 8 * g4) = w; }
        if (hh == 0) lse[((size_t)p * TOKG + orow) * 16 + h] = __logf(l);
    }
#undef ATT_DEC
#undef ATT_ISSUE
}
__device__ __forceinline__ void merge_conv(const GAS bf16* proj, const GAS bf16* part, const GAS float* lse, GAS bf16* y, int TOKG, const GAS float* convw, int lane, int gw, int ngw) {
    float cw[2][3][8];
#pragma unroll
    for (int i = 0; i < 2; ++i)
#pragma unroll
        for (int dt = 0; dt < 3; ++dt) { const f32x4 a = *(const GAS f32x4*)(convw + dt * 1024 + lane * 8 + 512 * i), b4 = *(const GAS f32x4*)(convw + dt * 1024 + lane * 8 + 512 * i + 4);
            cw[i][dt][0] = a.x; cw[i][dt][1] = a.y; cw[i][dt][2] = a.z; cw[i][dt][3] = a.w; cw[i][dt][4] = b4.x; cw[i][dt][5] = b4.y; cw[i][dt][6] = b4.z; cw[i][dt][7] = b4.w; }
    for (int it0 = 2 * gw; it0 < TOKG; it0 += 2 * ngw) {
        const int t = it0 & (SEQ - 1); const GAS bf16* prow = proj + (size_t)it0 * PW;
#pragma unroll
        for (int i = 0; i < 2; ++i) { const int c0 = lane * 8 + 512 * i;
            float u[4][8];
#pragma unroll
            for (int k = 0; k < 4; ++k) { const int tt = t - 2 + k;
                if (tt >= 0) { const GAS bf16* pr = prow + ((ptrdiff_t)k - 2) * PW; float gc[8], xa[8];
                    unpack8(*(const GAS v4u*)(pr + 1024 + c0), gc); unpack8(*(const GAS v4u*)(pr + 2048 + c0), xa);
#pragma unroll
                    for (int e = 0; e < 8; ++e) u[k][e] = gc[e] * xa[e]; }
                else {
#pragma unroll
                    for (int e = 0; e < 8; ++e) u[k][e] = 0.f; } }
#pragma unroll
            for (int q = 0; q < 2; ++q) { const GAS bf16* pq = prow + (size_t)q * PW;
                float gb[8], z[8], r[8]; unpack8(*(const GAS v4u*)(pq + c0), gb); unpack8(*(const GAS v4u*)(pq + 6144 + c0), z);
#pragma unroll
                for (int e = 0; e < 8; ++e) r[e] = gb[e] * (cw[i][0][e] * u[q][e] + cw[i][1][e] * u[q + 1][e] + cw[i][2][e] * u[q + 2][e]) * z[e];
                v4u o; o.x = pk2(r[0], r[1]); o.y = pk2(r[2], r[3]); o.z = pk2(r[4], r[5]); o.w = pk2(r[6], r[7]);
                *(GAS v4u*)(y + (size_t)(it0 + q) * MW + c0) = o; } }
#pragma unroll
        for (int q = 0; q < 2; ++q) { const int it = it0 + q; const GAS bf16* pq = prow + (size_t)q * PW;
#pragma unroll
            for (int i = 0; i < 2; ++i) { const int c0 = lane * 8 + 512 * i, h = c0 >> 6;
                const float l0 = lse[((size_t)0 * TOKG + it) * 16 + h], l1 = lse[((size_t)1 * TOKG + it) * 16 + h], l2 = lse[((size_t)2 * TOKG + it) * 16 + h];
                const float mx = fmaxf(l0, fmaxf(l1, l2)); float w0 = __expf(l0 - mx), w1 = __expf(l1 - mx), w2 = __expf(l2 - mx); const float inv = __builtin_amdgcn_rcpf(w0 + w1 + w2); w0 *= inv; w1 *= inv; w2 *= inv;
                float a0[8], a1[8], a2[8], z[8];
                unpack8(*(const GAS v4u*)(part + ((size_t)0 * TOKG + it) * 1024 + c0), a0); unpack8(*(const GAS v4u*)(part + ((size_t)1 * TOKG + it) * 1024 + c0), a1); unpack8(*(const GAS v4u*)(part + ((size_t)2 * TOKG + it) * 1024 + c0), a2);
                unpack8(*(const GAS v4u*)(pq + 6144 + 1024 + c0), z);
                float r[8];
#pragma unroll
                for (int e = 0; e < 8; ++e) r[e] = (w0 * a0[e] + w1 * a1[e] + w2 * a2[e]) * z[e];
                v4u o; o.x = pk2(r[0], r[1]); o.y = pk2(r[2], r[3]); o.z = pk2(r[4], r[5]); o.w = pk2(r[6], r[7]);
                *(GAS v4u*)(y + (size_t)it * MW + 1024 + c0) = o; } }
    }
}

typedef float f32x4h __attribute__((ext_vector_type(4)));
typedef float f32x2h __attribute__((ext_vector_type(2)));
#define MFMA16(a, b, c) __builtin_amdgcn_mfma_f32_16x16x32_bf16((a), (b), (c), 0, 0, 0)
constexpr float LOG2E = 1.4426950408889634f;
constexpr int HS = 144, HQS = 272, RUNC = 16;
constexpr int H1_KT = 0, H1_VT = 128 * HS, H1_SEG = 2 * 128 * HS, H1_DEC = H1_SEG + 4096;
constexpr int H3_QH = 0, H3_QM = 64 * HQS, H3_KM = 2 * 64 * HQS, H3_VT = 3 * 64 * HQS, H3_AM = H3_VT + 128 * HS, H3_SEG = H3_AM + 64 * HS, H3_RED = H3_SEG + 4096, H3_KT = H3_RED + 2048, H3_DEC = H3_KT + 128 * HS, H3_SL = H3_DEC + 512;
static_assert(H3_SL + 128 * HQS <= 150 * 1024, "HGRN LDS map");
__device__ __forceinline__ float lo16(unsigned w) { return __uint_as_float(w << 16); }
__device__ __forceinline__ float hi16(unsigned w) { return __uint_as_float(w & 0xffff0000u); }
__device__ __forceinline__ void hgrn_r1(const GAS bf16* proj, GAS float* RU, GAS float* RD, int TOKG, unsigned char* lds, int tid, int lane, int wave, int bid, int G) {
    LAS unsigned char* L = (LAS unsigned char*)lds;
    constexpr int KSET = 128 * HS + 512, VSET = 128 * HS + 4096, VS0 = 2 * KSET;
    static_assert(VS0 + 3 * VSET <= 128 * 1024, "r1 LDS map");
    const int nruns = (TOKG / SEQ) * 16 * (128 / RUNC);
    const int fr = lane & 15, fq = lane >> 4;
    unsigned rg[8], rv[8];
    unsigned voff[8];
#pragma unroll
    for (int i = 0; i < 8; ++i) voff[i] = (unsigned)((wave * 8 + i) * (PW * 2) + lane * 4);
    const __amdgpu_buffer_rsrc_t prs = __builtin_amdgcn_make_buffer_rsrc((void*)proj, 0, (int)((size_t)TOKG * PW * 2), 0x00020000);
#define H1_LOAD(u_) do { const int cch_ = (u_) & 127, seq_ = (u_) >> 7; const int so_ = (int)((((size_t)(seq_ >> 4) * SEQ + cch_ * 64) * PW + (seq_ & 15) * 128) * 2); \
        _Pragma("unroll") for (int i = 0; i < 8; ++i) { rg[i] = __builtin_amdgcn_raw_buffer_load_b32(prs, (int)voff[i], so_ + 4096, 0); rv[i] = __builtin_amdgcn_raw_buffer_load_b32(prs, (int)voff[i], so_ + 8192, 0); } } while (0)
    float f0[8], f1[8], run0, run1;
#define R1_P(c_, more_) do { v4u vv0_, vv1_; run0 = 0.f; run1 = 0.f; \
        _Pragma("unroll") for (int i = 0; i < 8; ++i) { const float g0 = lo16(rg[i]), g1 = hi16(rg[i]); run0 += g0; run1 += g1; f0[i] = __builtin_amdgcn_exp2f(g0); f1[i] = __builtin_amdgcn_exp2f(g1); } \
        vv0_.x = (rv[0] & 0xffffu) | (rv[1] << 16); vv0_.y = (rv[2] & 0xffffu) | (rv[3] << 16); vv0_.z = (rv[4] & 0xffffu) | (rv[5] << 16); vv0_.w = (rv[6] & 0xffffu) | (rv[7] << 16); \
        vv1_.x = (rv[0] >> 16) | (rv[1] & 0xffff0000u); vv1_.y = (rv[2] >> 16) | (rv[3] & 0xffff0000u); vv1_.z = (rv[4] >> 16) | (rv[5] & 0xffff0000u); vv1_.w = (rv[6] >> 16) | (rv[7] & 0xffff0000u); \
        if (more_) H1_LOAD(u0 + (c_) + 1); \
        LAS unsigned char* Lv_ = L + VS0 + ((c_) % 3) * VSET; \
        *(LAS f32x2h*)((LAS float*)(Lv_ + 128 * HS) + wave * 128 + 2 * lane) = (f32x2h){run0, run1}; \
        *(LAS v4u*)(Lv_ + (2 * lane) * HS + wave * 16) = vv0_; *(LAS v4u*)(Lv_ + (2 * lane + 1) * HS + wave * 16) = vv1_; } while (0)
#define R1_B(c_) do { const LAS float* sg_ = (const LAS float*)(L + VS0 + ((c_) % 3) * VSET + 128 * HS); LAS unsigned char* Lk_ = L + ((c_) & 1) * KSET; \
        float pre0 = 0.f, pre1 = 0.f, tot0 = 0.f, tot1 = 0.f; \
        _Pragma("unroll") for (int s8 = 0; s8 < 8; ++s8) { const f32x2h t = *(const LAS f32x2h*)(sg_ + s8 * 128 + 2 * lane); tot0 += t.x; tot1 += t.y; pre0 += (s8 < wave) ? t.x : 0.f; pre1 += (s8 < wave) ? t.y : 0.f; } \
        float w0[8], w1[8]; w0[7] = __builtin_amdgcn_exp2f(tot0 - (pre0 + run0)); w1[7] = __builtin_amdgcn_exp2f(tot1 - (pre1 + run1)); \
        _Pragma("unroll") for (int i = 6; i >= 0; --i) { w0[i] = w0[i + 1] * f0[i + 1]; w1[i] = w1[i + 1] * f1[i + 1]; } \
        v4u a_, b_; \
        a_.x = pkbf((1.f - f0[0]) * w0[0], (1.f - f0[1]) * w0[1]); a_.y = pkbf((1.f - f0[2]) * w0[2], (1.f - f0[3]) * w0[3]); a_.z = pkbf((1.f - f0[4]) * w0[4], (1.f - f0[5]) * w0[5]); a_.w = pkbf((1.f - f0[6]) * w0[6], (1.f - f0[7]) * w0[7]); \
        b_.x = pkbf((1.f - f1[0]) * w1[0], (1.f - f1[1]) * w1[1]); b_.y = pkbf((1.f - f1[2]) * w1[2], (1.f - f1[3]) * w1[3]); b_.z = pkbf((1.f - f1[4]) * w1[4], (1.f - f1[5]) * w1[5]); b_.w = pkbf((1.f - f1[6]) * w1[6], (1.f - f1[7]) * w1[7]); \
        *(LAS v4u*)(Lk_ + (2 * lane) * HS + wave * 16) = a_; *(LAS v4u*)(Lk_ + (2 * lane + 1) * HS + wave * 16) = b_; \
        sum0 += tot0; sum1 += tot1; \
        if (wave == 0) *(LAS f32x2h*)((LAS float*)(Lk_ + 128 * HS) + 2 * lane) = (f32x2h){__builtin_amdgcn_exp2f(tot0), __builtin_amdgcn_exp2f(tot1)}; } while (0)
    for (int run = bid; run < nruns; run += G) {
        if ((run & (128 / RUNC - 1)) == 128 / RUNC - 1) continue;
        const int u0 = run * RUNC;
        __syncthreads();
        H1_LOAD(u0);
        f32x4h acc[8];
#pragma unroll
        for (int nk = 0; nk < 8; ++nk) acc[nk] = (f32x4h){0.f, 0.f, 0.f, 0.f};
        float sum0 = 0.f, sum1 = 0.f;
        R1_P(0, true);
        __syncthreads();
        R1_B(0);
        for (int ci = 0; ci < RUNC; ++ci) {
            const bool nxt = ci + 1 < RUNC;
            if (nxt) R1_P(ci + 1, ci + 2 < RUNC);
            __syncthreads();
            { const LAS unsigned char* Lv = L + VS0 + (ci % 3) * VSET; const LAS unsigned char* Lk = L + (ci & 1) * KSET; const LAS float* decl = (const LAS float*)(Lk + 128 * HS);
              bf16x8 vf[2];
#pragma unroll
              for (int ks = 0; ks < 2; ++ks) vf[ks] = *(const LAS bf16x8*)(Lv + (16 * wave + fr) * HS + (32 * ks + 8 * fq) * 2);
#pragma unroll
              for (int nk = 0; nk < 8; ++nk) { const f32x4h dk = *(const LAS f32x4h*)(decl + 16 * nk + 4 * fq); acc[nk] = acc[nk] * dk;
#pragma unroll
                  for (int ks = 0; ks < 2; ++ks) { const bf16x8 kf = *(const LAS bf16x8*)(Lk + (16 * nk + fr) * HS + (32 * ks + 8 * fq) * 2); acc[nk] = MFMA16(kf, vf[ks], acc[nk]); } } }
            if (nxt) R1_B(ci + 1);
        }
        GAS float* sp = RU + (size_t)run * 16384 + (16 * wave + fr) * 128 + 4 * fq;
#pragma unroll
        for (int nk = 0; nk < 8; ++nk) *(GAS f32x4h*)(sp + 16 * nk) = acc[nk];
        if (wave == 0) *(GAS f32x2h*)(RD + (size_t)run * 128 + 2 * lane) = (f32x2h){__builtin_amdgcn_exp2f(sum0), __builtin_amdgcn_exp2f(sum1)};
    }
#undef R1_P
#undef R1_B
#undef H1_LOAD
}
__device__ __forceinline__ void hgrn_r3(const GAS bf16* proj, const GAS float* RU, const GAS float* RD, GAS bf16* y, int TOKG, const GAS float* ogain, unsigned char* lds, int tid, int lane, int wave, int bid, int G) {
    LAS unsigned char* L = (LAS unsigned char*)lds;
    LAS float* segtot = (LAS float*)(L + H3_SEG); LAS float* red = (LAS float*)(L + H3_RED); LAS float* decl = (LAS float*)(L + H3_DEC);
    const int nruns = (TOKG / SEQ) * 16 * (128 / RUNC);
    const int fr = lane & 15, fq = lane >> 4;
    unsigned rq[8], rg[8], rv[8];
    unsigned voff[8], zoff[4], yoff[4];
#pragma unroll
    for (int i = 0; i < 8; ++i) voff[i] = (unsigned)((wave * 8 + i) * (PW * 2) + lane * 4);
#pragma unroll
    for (int t2 = 0; t2 < 4; ++t2) { zoff[t2] = (unsigned)(((16 * t2 + fr) * PW + 16 * wave + 4 * fq) * 2); yoff[t2] = (unsigned)(((16 * t2 + fr) * MW + 16 * wave + 4 * fq) * 2); }
    const __amdgpu_buffer_rsrc_t prs = __builtin_amdgcn_make_buffer_rsrc((void*)proj, 0, (int)((size_t)TOKG * PW * 2), 0x00020000);
#define H3_LOAD(u_) do { const int cch_ = (u_) & 127, seq_ = (u_) >> 7; const int so_ = (int)((((size_t)(seq_ >> 4) * SEQ + cch_ * 64) * PW + (seq_ & 15) * 128) * 2); \
        _Pragma("unroll") for (int i = 0; i < 8; ++i) { rq[i] = __builtin_amdgcn_raw_buffer_load_b32(prs, (int)voff[i], so_, 0); rg[i] = __builtin_amdgcn_raw_buffer_load_b32(prs, (int)voff[i], so_ + 4096, 0); rv[i] = __builtin_amdgcn_raw_buffer_load_b32(prs, (int)voff[i], so_ + 8192, 0); } } while (0)
    for (int run = bid; run < nruns; run += G) {
        const int u0 = run * RUNC, seq = run / (128 / RUNC), rr = run - seq * (128 / RUNC), h = seq & 15, bl = seq >> 4;
        H3_LOAD(u0);
        const int v0 = 16 * wave + 4 * fq;
        const f32x4 og = *(const GAS f32x4*)(ogain + h * 128 + v0);
        f32x4h Sm[8];
#pragma unroll
        for (int nk = 0; nk < 8; ++nk) Sm[nk] = (f32x4h){0.f, 0.f, 0.f, 0.f};
        for (int r2 = 0; r2 < rr; ++r2) { const int rn = run - rr + r2;
            const GAS float* up = RU + (size_t)rn * 16384 + (16 * wave + fr) * 128 + 4 * fq; const GAS float* dp = RD + (size_t)rn * 128 + 4 * fq;
#pragma unroll
            for (int nk = 0; nk < 8; ++nk) { const f32x4h uu = *(const GAS f32x4h*)(up + 16 * nk), dd = *(const GAS f32x4h*)(dp + 16 * nk); Sm[nk] = Sm[nk] * dd + uu; } }
        for (int ci = 0; ci < RUNC; ++ci) {
            const int u = u0 + ci, cch = u & 127;
            const size_t rowc = (size_t)bl * SEQ + cch * 64;
            v2u zw[4];
            { const GAS char* zb = (const GAS char*)(proj + rowc * PW + 6144 + h * 128);
#pragma unroll
              for (int t2 = 0; t2 < 4; ++t2) zw[t2] = *(const GAS v2u*)(zb + zoff[t2]); }
            bf16x8 sf[4];
            { LAS unsigned char* sl = L + H3_SL + (16 * wave + fr) * HQS;
#pragma unroll
              for (int nk = 0; nk < 8; ++nk) { v2u w; w.x = pkbf(Sm[nk][0], Sm[nk][1]); w.y = pkbf(Sm[nk][2], Sm[nk][3]); *(LAS v2u*)(sl + (16 * nk + 4 * fq) * 2) = w; }
#pragma unroll
              for (int ks = 0; ks < 4; ++ks) sf[ks] = *(const LAS bf16x8*)(sl + (32 * ks + 8 * fq) * 2); }
            float f0[8], f1[8], qv0[8], qv1[8]; float run0 = 0.f, run1 = 0.f; v4u vv0, vv1;
            { float p0 = 1.f, p1 = 1.f;
#pragma unroll
              for (int i = 0; i < 8; ++i) { const float g0 = lo16(rg[i]), g1 = hi16(rg[i]); run0 += g0; run1 += g1; f0[i] = __builtin_amdgcn_exp2f(g0); f1[i] = __builtin_amdgcn_exp2f(g1);
                  p0 *= f0[i]; p1 *= f1[i]; qv0[i] = lo16(rq[i]) * p0; qv1[i] = hi16(rq[i]) * p1; } }
            vv0.x = (rv[0] & 0xffffu) | (rv[1] << 16); vv0.y = (rv[2] & 0xffffu) | (rv[3] << 16); vv0.z = (rv[4] & 0xffffu) | (rv[5] << 16); vv0.w = (rv[6] & 0xffffu) | (rv[7] << 16);
            vv1.x = (rv[0] >> 16) | (rv[1] & 0xffff0000u); vv1.y = (rv[2] >> 16) | (rv[3] & 0xffff0000u); vv1.z = (rv[4] >> 16) | (rv[5] & 0xffff0000u); vv1.w = (rv[6] >> 16) | (rv[7] & 0xffff0000u);
            if (ci + 1 < RUNC) H3_LOAD(u + 1);
            *(LAS f32x2h*)(segtot + wave * 128 + 2 * lane) = (f32x2h){run0, run1};
            *(LAS v4u*)(L + H3_VT + (2 * lane) * HS + wave * 16) = vv0; *(LAS v4u*)(L + H3_VT + (2 * lane + 1) * HS + wave * 16) = vv1;
            __syncthreads();
            { float pre0 = 0.f, pre1 = 0.f, gr0 = 0.f, gr1 = 0.f, tot0 = 0.f, tot1 = 0.f;
#pragma unroll
              for (int s8 = 0; s8 < 8; ++s8) { const f32x2h t = *(const LAS f32x2h*)(segtot + s8 * 128 + 2 * lane); tot0 += t.x; tot1 += t.y; pre0 += (s8 < wave) ? t.x : 0.f; pre1 += (s8 < wave) ? t.y : 0.f; if (s8 < 4) { gr0 += t.x; gr1 += t.y; } }
              unsigned kw0[4], kw1[4];
              const float eg0 = __builtin_amdgcn_exp2f(fminf(-gr0, 115.f)), eg1 = __builtin_amdgcn_exp2f(fminf(-gr1, 115.f)), tg0 = __builtin_amdgcn_exp2f(tot0 - gr0), tg1 = __builtin_amdgcn_exp2f(tot1 - gr1);
              const float ep0 = __builtin_amdgcn_exp2f(pre0), ep1 = __builtin_amdgcn_exp2f(pre1);
              float kv0[8], kv1[8], m0_ = __builtin_amdgcn_exp2f(fminf(gr0 - (pre0 + run0), 115.f)), m1_ = __builtin_amdgcn_exp2f(fminf(gr1 - (pre1 + run1), 115.f));
#pragma unroll
              for (int i = 7; i >= 0; --i) { const int s = wave * 8 + i;
                  const float qh0 = qv0[i] * ep0, qh1 = qv1[i] * ep1;
                  const float km0 = (1.f - f0[i]) * m0_, km1 = (1.f - f1[i]) * m1_;
                  *(LAS unsigned*)(L + H3_QH + s * HQS + lane * 4) = pkbf(qh0, qh1);
                  *(LAS unsigned*)(L + H3_QM + s * HQS + lane * 4) = pkbf(qh0 * eg0, qh1 * eg1);
                  *(LAS unsigned*)(L + H3_KM + s * HQS + lane * 4) = pkbf(km0, km1);
                  kv0[i] = km0 * tg0; kv1[i] = km1 * tg1; m0_ *= f0[i]; m1_ *= f1[i]; }
#pragma unroll
              for (int i = 0; i < 4; ++i) { kw0[i] = pkbf(kv0[2 * i], kv0[2 * i + 1]); kw1[i] = pkbf(kv1[2 * i], kv1[2 * i + 1]); }
              { v4u a, b; a.x = kw0[0]; a.y = kw0[1]; a.z = kw0[2]; a.w = kw0[3]; b.x = kw1[0]; b.y = kw1[1]; b.z = kw1[2]; b.w = kw1[3];
                *(LAS v4u*)(L + H3_KT + (2 * lane) * HS + wave * 16) = a; *(LAS v4u*)(L + H3_KT + (2 * lane + 1) * HS + wave * 16) = b; }
              if (wave == 0) *(LAS f32x2h*)(decl + 2 * lane) = (f32x2h){__builtin_amdgcn_exp2f(tot0), __builtin_amdgcn_exp2f(tot1)}; }
            __syncthreads();
            { const int tt = wave >> 1;
#pragma unroll
              for (int ss2 = 0; ss2 < 2; ++ss2) { const int ss = 2 * (wave & 1) + ss2; f32x4h a = {0.f, 0.f, 0.f, 0.f};
                  if (ss <= tt) {
#pragma unroll
                      for (int ks = 0; ks < 4; ++ks) { const bf16x8 kmf = *(const LAS bf16x8*)(L + H3_KM + (16 * ss + fr) * HQS + (32 * ks + 8 * fq) * 2);
                          const bf16x8 qmf = *(const LAS bf16x8*)(L + H3_QM + (16 * tt + fr) * HQS + (32 * ks + 8 * fq) * 2); a = MFMA16(kmf, qmf, a); } }
                  const int t = 16 * tt + fr, s0 = 16 * ss + 4 * fq;
                  v2u w; w.x = pkbf(s0 <= t ? a[0] : 0.f, s0 + 1 <= t ? a[1] : 0.f); w.y = pkbf(s0 + 2 <= t ? a[2] : 0.f, s0 + 3 <= t ? a[3] : 0.f);
                  *(LAS v2u*)(L + H3_AM + t * HS + s0 * 2) = w; } }
            f32x4h acc[4];
#pragma unroll
            for (int t2 = 0; t2 < 4; ++t2) acc[t2] = (f32x4h){0.f, 0.f, 0.f, 0.f};
#pragma unroll
            for (int t2 = 0; t2 < 4; ++t2)
#pragma unroll
                for (int ks = 0; ks < 4; ++ks) { const bf16x8 qf = *(const LAS bf16x8*)(L + H3_QH + (16 * t2 + fr) * HQS + (32 * ks + 8 * fq) * 2); acc[t2] = MFMA16(sf[ks], qf, acc[t2]); }
            bf16x8 vf[2];
#pragma unroll
            for (int ks = 0; ks < 2; ++ks) vf[ks] = *(const LAS bf16x8*)(L + H3_VT + (16 * wave + fr) * HS + (32 * ks + 8 * fq) * 2);
#pragma unroll
            for (int nk = 0; nk < 8; ++nk) { const f32x4h dk = *(const LAS f32x4h*)(decl + 16 * nk + 4 * fq); Sm[nk] = Sm[nk] * dk;
#pragma unroll
                for (int ks = 0; ks < 2; ++ks) { const bf16x8 kf = *(const LAS bf16x8*)(L + H3_KT + (16 * nk + fr) * HS + (32 * ks + 8 * fq) * 2); Sm[nk] = MFMA16(kf, vf[ks], Sm[nk]); } }
            __syncthreads();
#pragma unroll
            for (int t2 = 0; t2 < 4; ++t2)
#pragma unroll
                for (int ks = 0; ks < 2; ++ks) { const bf16x8 af = *(const LAS bf16x8*)(L + H3_AM + (16 * t2 + fr) * HS + (32 * ks + 8 * fq) * 2); acc[t2] = MFMA16(vf[ks], af, acc[t2]); }
#pragma unroll
            for (int t2 = 0; t2 < 4; ++t2) { float ss = acc[t2][0] * acc[t2][0] + acc[t2][1] * acc[t2][1] + acc[t2][2] * acc[t2][2] + acc[t2][3] * acc[t2][3];
                ss += __shfl_xor(ss, 16); ss += __shfl_xor(ss, 32); if (fq == 0) red[(16 * t2 + fr) * 8 + wave] = ss; }
            __syncthreads();
#pragma unroll
            for (int t2 = 0; t2 < 4; ++t2) { const int t = 16 * t2 + fr; float tot = 0.f;
#pragma unroll
                for (int w8 = 0; w8 < 2; ++w8) { const f32x4h pr = *(const LAS f32x4h*)(red + t * 8 + 4 * w8); tot += (pr[0] + pr[1]) + (pr[2] + pr[3]); }
                const float rstd = rsqrtf(tot * (1.f / 128.f) + EPS);
                v2u w; w.x = pkbf(acc[t2][0] * rstd * og.x * lo16(zw[t2].x), acc[t2][1] * rstd * og.y * hi16(zw[t2].x));
                w.y = pkbf(acc[t2][2] * rstd * og.z * lo16(zw[t2].y), acc[t2][3] * rstd * og.w * hi16(zw[t2].y));
                *(GAS v2u*)((GAS char*)(y + rowc * MW + h * 128) + yoff[t2]) = w; }
        }
    }
#undef H3_LOAD
}

#define XB_TMO      128
#define XB_XCNT(j)  (256  + 64 * (j))
#define XB_XSUB(j)  (1280 + 64 * (j))
#define XB_XGEN(j)  (2304 + 64 * (j))
#define XB_TOP      3328
#define XB_TOPGEN   3392
#define XCD_BAR_WORDS 3456
#define XB_SPIN_CAP (1u << 18)

__device__ __forceinline__ unsigned xb_ld(unsigned* p)              { return __hip_atomic_load(p, __ATOMIC_RELAXED, __HIP_MEMORY_SCOPE_AGENT); }
__device__ __forceinline__ unsigned xb_add(unsigned* p, unsigned v) { return __hip_atomic_fetch_add(p, v, __ATOMIC_RELAXED, __HIP_MEMORY_SCOPE_AGENT); }
__device__ __forceinline__ unsigned xb_xcc_id() { return (unsigned)__builtin_amdgcn_s_getreg((3 << 11) | 20) & 0xFu; }
#define XB_SPIN(cond, bar) do { unsigned _sp = 0; while (cond) { __builtin_amdgcn_s_sleep(1); \
    if ((++_sp & 255u) == 0u) { if (xb_ld(&(bar)[XB_TMO])) break; if (_sp > XB_SPIN_CAP) { atomicAdd(&(bar)[XB_TMO], 1u); break; } } } } while (0)

struct XcdBarrier {
    unsigned* bar; unsigned x;
    volatile LAS unsigned* st;
};

__device__ __forceinline__ XcdBarrier xcd_barrier_post(unsigned* bar, volatile LAS unsigned* st) {
    XcdBarrier b; b.bar = bar; b.x = xb_xcc_id(); b.st = st;
    if (threadIdx.x == 0) (void)xb_add(&bar[XB_XCNT(b.x)], 1u);
    return b;
}
__device__ __forceinline__ void xcd_barrier_complete(unsigned* bar, unsigned x, unsigned& nloc, unsigned& nx) {
    const unsigned G = gridDim.x * gridDim.y * gridDim.z;
    unsigned sum, cnt, mine, sp = 0u;
    for (;;) {
        sum = 0u; cnt = 0u; mine = 0u;
#pragma unroll
        for (unsigned j = 0; j < 16; ++j) { const unsigned c = xb_ld(&bar[XB_XCNT(j)]); sum += c; cnt += (c > 0u) ? 1u : 0u; mine = (j == x) ? c : mine; }
        if (sum == G) break;
        __builtin_amdgcn_s_sleep(1);
        if ((++sp & 255u) == 0u) { if (xb_ld(&bar[XB_TMO])) break; if (sp > XB_SPIN_CAP) { atomicAdd(&bar[XB_TMO], 1u); break; } }
    }
    nloc = mine > 0u ? mine : 1u; nx = cnt > 0u ? cnt : 1u;
}

__device__ __forceinline__ void xcd_barrier(const XcdBarrier& b) {
    asm volatile("s_waitcnt vmcnt(0)" ::: "memory");
    __syncthreads();
    if (threadIdx.x == 0) {
        unsigned* bar = b.bar;
        __builtin_amdgcn_s_waitcnt(0);
        unsigned nloc = b.st[0], nx = b.st[1];
        if (nloc == 0u) { xcd_barrier_complete(bar, b.x, nloc, nx); b.st[0] = nloc; b.st[1] = nx; }
        const unsigned old = xb_add(&bar[XB_XSUB(b.x)], 1u);
        const unsigned gen = old / nloc;
        if (old + 1u == (gen + 1u) * nloc) {
            __builtin_amdgcn_fence(__ATOMIC_RELEASE, "agent");
            asm volatile("s_waitcnt vmcnt(0)" ::: "memory");
            const unsigned og = xb_add(&bar[XB_TOP], 1u);
            const unsigned tg = og / nx;
            if (og + 1u == (tg + 1u) * nx) xb_add(&bar[XB_TOPGEN], 1u);
            else XB_SPIN(xb_ld(&bar[XB_TOPGEN]) == tg, bar);
            __builtin_amdgcn_fence(__ATOMIC_ACQUIRE, "agent");
            xb_add(&bar[XB_XGEN(b.x)], 1u);
            asm volatile("s_waitcnt vmcnt(0)" ::: "memory");
        } else {
            XB_SPIN(xb_ld(&bar[XB_XGEN(b.x)]) == gen, bar);
            __builtin_amdgcn_fence(__ATOMIC_ACQUIRE, "agent");
            asm volatile("s_waitcnt vmcnt(0)" ::: "memory");
        }
    }
    __syncthreads();
}

__device__ __forceinline__ unsigned long long ldptr(LAS unsigned long long* tab, int i) { asm volatile("" ::: "memory"); const unsigned long long v = tab[i];
    const unsigned lo = __builtin_amdgcn_readfirstlane((unsigned)v), hi = __builtin_amdgcn_readfirstlane((unsigned)(v >> 32)); return ((unsigned long long)hi << 32) | lo; }
struct Args { const float* in[13]; float* out; unsigned char* ws; int ngroups; int pad; };
struct Ctx { int layer, g, NG, TOKG, j, even, tid, lane, wave, G, bid, gw, ngw; GAS unsigned char* wsb; GAS bf16 *Wt_in, *Wt_out, *proj, *ybuf, *xn, *xres; GAS float *lbtab, *ssq; size_t row0; };
__device__ __forceinline__ Ctx load_ctx(LAS unsigned long long* ptab) {
    Ctx c; const int step = (int)ldptr(ptab, 16); c.NG = (int)ldptr(ptab, 15); c.layer = step / c.NG; c.g = step - c.layer * c.NG; c.TOKG = NTOK / c.NG; c.j = c.layer >> 1; c.even = !(c.layer & 1);
    int tid_raw = threadIdx.x; asm volatile("" : "+v"(tid_raw)); c.tid = tid_raw; c.lane = c.tid & 63; c.wave = __builtin_amdgcn_readfirstlane(c.tid >> 6);
    c.G = gridDim.x; c.bid = blockIdx.x; c.gw = c.bid * 8 + c.wave; c.ngw = c.G * 8;
    c.wsb = (GAS unsigned char*)ldptr(ptab, 14);
    c.Wt_in = (GAS bf16*)(c.wsb + WS_WIN); c.Wt_out = (GAS bf16*)(c.wsb + WS_WOUT); c.lbtab = (GAS float*)(c.wsb + WS_MISC); c.proj = (GAS bf16*)(c.wsb + WS_PROJ);
    c.ybuf = (GAS bf16*)(c.wsb + WS_PROJ + (size_t)c.TOKG * (PW * 2)); c.xn = (GAS bf16*)(c.wsb + WS_PROJ + (size_t)c.TOKG * (PW * 2 + MW * 2));
    c.xres = (GAS bf16*)(c.wsb + WS_PROJ + (size_t)c.TOKG * (PW * 2 + MW * 2 + AUX_PER_TOK)); c.ssq = (GAS float*)(c.wsb + WS_SSQ);
    c.row0 = (size_t)c.g * c.TOKG; return c;
}
#define ARGP(i) ((const GAS float*)ldptr(ptab, (i)))
__global__ void __launch_bounds__(512, 2) fwd(Args a) {
    extern __shared__ __attribute__((aligned(16))) unsigned char lds[];
    cg::grid_group grid = cg::this_grid();
    LAS unsigned long long* ptab = (LAS unsigned long long*)((LAS unsigned char*)lds + PTAB_OFF);
    if (threadIdx.x == 0) {
#pragma unroll
        for (int i = 0; i < 13; ++i) ptab[i] = (unsigned long long)a.in[i];
        ptab[13] = (unsigned long long)a.out; ptab[14] = (unsigned long long)a.ws; ptab[15] = (unsigned long long)a.ngroups; ptab[16] = 0ull;
        ((LAS unsigned*)(ptab + 24))[0] = 0u; ((LAS unsigned*)(ptab + 24))[1] = 0u; }
    __syncthreads();
    (void)xcd_barrier_post((unsigned*)(ldptr(ptab, 14) + WS_BAR), (volatile LAS unsigned*)(ptab + 24));
#define GSYNC() do { XcdBarrier b_; b_.bar = (unsigned*)(ldptr(ptab, 14) + WS_BAR); b_.x = xb_xcc_id(); b_.st = (volatile LAS unsigned*)(ptab + 24); xcd_barrier(b_); } while (0)
    for (;;) {
        if ((int)ldptr(ptab, 16) < (int)ldptr(ptab, 15)) {
            const Ctx c = load_ctx(ptab);
            if (c.g == 0) {
                LAS float* scr = (LAS float*)((LAS unsigned char*)lds + c.wave * 16384);
                constexpr int I_IN = (D / 64) * (PW / 32), I_OUT = (MW / 64) * (D / 32);
                for (int it = c.gw; it < I_IN + I_OUT; it += c.ngw) {
                    if (it < I_IN) transpose_item(ARGP(2), D, PW, ARGP(1), c.Wt_in, scr, it, c.lane, 1);
                    else transpose_item(ARGP(6), MW, D, nullptr, c.Wt_out, scr, it - I_IN, c.lane, 0);
                }
            }
            init_rows(ARGP(0) + c.row0 * D, c.xres + c.row0 * D, c.ssq + c.row0 * 16, c.TOKG, c.gw, c.ngw, c.lane);
        }
        if ((int)ldptr(ptab, 16) == 0) grid.sync();
        else if ((int)ldptr(ptab, 16) < (int)ldptr(ptab, 15)) GSYNC();
        {
            const Ctx c = load_ctx(ptab);
            LAS float* qkl = (LAS float*)((LAS unsigned char*)lds + 131072);
            if (c.even && c.tid < 128) qkl[c.tid] = (c.tid < 64) ? ARGP(4)[c.j * 64 + c.tid] * (0.125f * 1.4426950408889634f) : ARGP(5)[c.j * 64 + c.tid - 64];
            pg8::Gemm gm{(const pg8::bf16_t*)(c.xres + c.row0 * D), (const pg8::bf16_t*)c.Wt_in, c.TOKG, PW, D}; pg8::StaticOrder S; S.init(c.TOKG, PW, c.G, c.bid);
            LAS float* rsl = qkl + 128;
            { pg8::Unit u0; if (S.next(0, u0) && c.tid < 256) { const GAS f32x4* pp = (const GAS f32x4*)(c.ssq + (c.row0 + (size_t)u0.pm * 256 + c.tid) * 16);
                const f32x4 a0 = pp[0], a1 = pp[1], a2 = pp[2], a3 = pp[3]; const float s = ((a0.x + a0.y) + (a0.z + a0.w)) + ((a1.x + a1.y) + (a1.z + a1.w)) + ((a2.x + a2.y) + (a2.z + a2.w)) + ((a3.x + a3.y) + (a3.z + a3.w));
                rsl[c.tid] = rsqrtf(s * (1.f / D) + EPS); } }
            __syncthreads();
            EpiProj E{c.proj, c.even ? 0 : 1, c.lbtab, qkl, rsl};
            pg8::gemm_phase<EpiProj, pg8::StaticOrder, true, true>((PG8_LAS unsigned char*)lds, gm, S, E);
            if (c.g == 0 && c.layer > 0) {
                const GAS float* w_out = (c.even ? ARGP(6) : ARGP(12)) + (size_t)c.j * MW * D;
                LAS float* scr = (LAS float*)((LAS unsigned char*)lds + c.wave * 16384);
                for (int it = c.gw; it < (MW / 64) * (D / 32); it += c.ngw) transpose_item(w_out, MW, D, nullptr, c.Wt_out, scr, it, c.lane, 0);
            }
        }
        GSYNC();
        {
            const Ctx c = load_ctx(ptab);
            if (__builtin_amdgcn_readfirstlane(c.tid) >= 256) __builtin_amdgcn_s_setprio(1);
            if (c.even) {
                attn_mfma(c.proj, c.xn, (GAS float*)(c.xn + (size_t)c.TOKG * 3072), c.TOKG, ARGP(4) + c.j * 64, ARGP(5) + c.j * 64, ARGP(7), lds, c.tid, c.lane, c.wave, c.bid, c.G);
            } else {
                hgrn_r1(c.proj, (GAS float*)c.xn, (GAS float*)(c.wsb + WS_RD), c.TOKG, lds, c.tid, c.lane, c.wave, c.bid, c.G);
            }
            __builtin_amdgcn_s_setprio(0);
        }
        GSYNC();
        {
            const Ctx c = load_ctx(ptab);
            if (__builtin_amdgcn_readfirstlane(c.tid) >= 256) __builtin_amdgcn_s_setprio(1);
            if (c.even) merge_conv(c.proj, c.xn, (const GAS float*)(c.xn + (size_t)c.TOKG * 3072), c.ybuf, c.TOKG, ARGP(3) + c.j * 3 * 1024, c.lane, c.gw, c.ngw);
            else hgrn_r3(c.proj, (const GAS float*)c.xn, (const GAS float*)(c.wsb + WS_RD), c.ybuf, c.TOKG, ARGP(11) + c.j * MW, lds, c.tid, c.lane, c.wave, c.bid, c.G);
            __builtin_amdgcn_s_setprio(0);
        }
        GSYNC();
        {
            const Ctx c = load_ctx(ptab);
            pg8::Gemm gm{(const pg8::bf16_t*)c.ybuf, (const pg8::bf16_t*)c.Wt_out, c.TOKG, D, MW}; pg8::StaticOrder S; S.init(c.TOKG, D, c.G, c.bid);
            EpiRes E{ARGP(0) + c.row0 * D, c.xres + c.row0 * D, (GAS float*)ARGP(13) + c.row0 * D, c.ssq + c.row0 * 16, c.layer == 0 ? 1 : 0, c.layer == 3 ? 1 : 0};
            pg8::gemm_phase<EpiRes, pg8::StaticOrder, true, true>((PG8_LAS unsigned char*)lds, gm, S, E);
            if (c.g == c.NG - 1 && c.layer < 3) {
                const int nl = c.layer + 1, nj = nl >> 1, nev = !(nl & 1);
                const GAS float* w_in = (nev ? ARGP(2) : ARGP(9)) + (size_t)nj * D * PW; const GAS float* ln = (nev ? ARGP(1) : ARGP(8)) + (size_t)nj * D;
                LAS float* scr = (LAS float*)((LAS unsigned char*)lds + c.wave * 16384);
                for (int it = c.gw; it < (D / 64) * (PW / 32); it += c.ngw) transpose_item(w_in, D, PW, ln, c.Wt_in, scr, it, c.lane, nev);
                if (!nev && c.bid == 0) { const GAS float* lbp = ARGP(10);
                    for (int col = c.tid; col < 2048; col += 512) c.lbtab[col] = (nj == 0) ? 0.f : 1.f / (1.f + expf(lbp[col] - lbp[2048 + col])); }
            }
        }
        { const int st_ = (int)ldptr(ptab, 16), ng_ = (int)ldptr(ptab, 15); if (st_ % ng_ == ng_ - 1) GSYNC(); }
        const int step = (int)ldptr(ptab, 16), nsteps = 4 * (int)ldptr(ptab, 15);
        __syncthreads();
        if (threadIdx.x == 0) ptab[16] = (unsigned long long)(step + 1);
        __syncthreads();
        if (step + 1 >= nsteps) break;
    }
}

extern "C" void kernel_launch(void* const* d_in, const int* in_sizes, int n_in, void* d_out, int out_size, void* d_ws, size_t ws_size, hipStream_t stream) {
    static int grid = 0;
    if (grid == 0) {
        int dev = 0, cus = 0, per_cu = 0;
        if (hipGetDevice(&dev) != hipSuccess || hipDeviceGetAttribute(&cus, hipDeviceAttributeMultiprocessorCount, dev) != hipSuccess) { fprintf(stderr, "kernel_launch: device query failed\n"); grid = -1; return; }
        if (hipFuncSetAttribute((const void*)fwd, hipFuncAttributeMaxDynamicSharedMemorySize, LDS_BYTES) != hipSuccess) { fprintf(stderr, "kernel_launch: hipFuncSetAttribute failed\n"); grid = -1; return; }
        if (hipOccupancyMaxActiveBlocksPerMultiprocessor(&per_cu, (const void*)fwd, 512, LDS_BYTES) != hipSuccess || per_cu < 1) fprintf(stderr, "kernel_launch: occupancy query reports %d\n", per_cu);
        (void)hipGetLastError();
        grid = cus;
    }
    if (grid < 0) return;
    Args a{};
    for (int i = 0; i < 13; ++i) a.in[i] = (const float*)d_in[i];
    a.out = (float*)d_out; a.ws = (unsigned char*)d_ws;
    a.ngroups = (ws_size >= (size_t)508 * MiB) ? 2 : 4;
    if (hipMemsetAsync((char*)d_ws + WS_BAR, 0, 16384, stream) != hipSuccess) { fprintf(stderr, "kernel_launch: memset failed\n"); return; }
    void* args[] = {&a};
    hipError_t e = hipLaunchCooperativeKernel((const void*)fwd, dim3(grid), dim3(512), args, LDS_BYTES, stream);
    if (e != hipSuccess) fprintf(stderr, "kernel_launch: cooperative launch failed: %s (grid %d)\n", hipGetErrorString(e), grid);
}
```
